# Optimizing an MI355X kernel written in HIP

```python
import jax, jax.numpy as jnp
from jax import lax
import numpy as np

D_MODEL = 1024
BATCH = 16
SEQ = 2048
DEPTH = 2

CHUNK = 64
N_A_LAYERS = DEPTH // 2
N_B_LAYERS = DEPTH - N_A_LAYERS
N_HEADS = 8
HEAD_DIM = D_MODEL // N_HEADS
ATTN_W = N_HEADS * HEAD_DIM
IDX_HEADS = 8
IDX_DIM = 64
TOPK_MAX = 256
A_QBLOCK = CHUNK
B_QBLOCK = 128
ROPE_THETA = 10000.0
N_EXPERTS = 16
N_GROUPS = 4
EXPERTS_PER_GROUP = N_EXPERTS // N_GROUPS
MOE_TOP_K = 2
D_FF_EXPERT = D_MODEL // 4
DEEPNORM_ALPHA = (2 * DEPTH) ** 0.25
DEEPNORM_BETA = (8 * DEPTH) ** -0.25
LN_EPS = 1e-5
A_SPLITS = (ATTN_W, 2 * ATTN_W, 3 * ATTN_W, 3 * ATTN_W + IDX_HEADS * IDX_DIM,
            3 * ATTN_W + IDX_HEADS * IDX_DIM + IDX_DIM)
A_IN_WIDTH = A_SPLITS[-1] + IDX_HEADS

kernel_name = 'yoco_dsa_stickbreaking_groupmoe_deepnorm'


def layer_norm(x, g, b):
    xf = x.astype(jnp.float32)
    mu = xf.mean(-1, keepdims=True)
    var = jnp.square(xf - mu).mean(-1, keepdims=True)
    y = (xf - mu) * lax.rsqrt(var + LN_EPS) * g.astype(jnp.float32) + b.astype(jnp.float32)
    return y.astype(x.dtype)


def rope_tables(seq, dim):
    inv = 1.0 / (ROPE_THETA ** (jnp.arange(0, dim, 2, dtype=jnp.float32) / dim))
    ang = jnp.arange(seq, dtype=jnp.float32)[:, None] * inv[None, :]
    return jnp.cos(ang), jnp.sin(ang)


def apply_rope(x, cos, sin):
    x1, x2 = jnp.split(x.astype(jnp.float32), 2, axis=-1)
    c = cos[None, :, None, :]
    s = sin[None, :, None, :]
    return jnp.concatenate([x1 * c - x2 * s, x1 * s + x2 * c], axis=-1).astype(x.dtype)


def dsa_mixer(h, w_in, w_out):
    B, S, _ = h.shape
    proj = h @ w_in
    q, k, v, qi, ki, wi = jnp.split(proj, A_SPLITS, axis=-1)
    q = q.reshape(B, S, N_HEADS, HEAD_DIM)
    k = k.reshape(B, S, N_HEADS, HEAD_DIM)
    v = v.reshape(B, S, N_HEADS, HEAD_DIM)
    qi = qi.reshape(B, S, IDX_HEADS, IDX_DIM)
    ki = ki.reshape(B, S, 1, IDX_DIM)
    cos, sin = rope_tables(S, HEAD_DIM)
    q = apply_rope(q, cos, sin)
    k = apply_rope(k, cos, sin)
    ci, si = rope_tables(S, IDX_DIM)
    qi = apply_rope(qi, ci, si)
    ki = apply_rope(ki, ci, si)[:, :, 0]
    wi = wi.astype(jnp.float32) * IDX_HEADS ** -0.5
    topk = min(TOPK_MAX, S // 4)
    s_chunk = jnp.arange(S) // CHUNK

    def block(i):
        t0 = i * A_QBLOCK
        q_b = lax.dynamic_slice_in_dim(q, t0, A_QBLOCK, axis=1)
        qi_b = lax.dynamic_slice_in_dim(qi, t0, A_QBLOCK, axis=1)
        wi_b = lax.dynamic_slice_in_dim(wi, t0, A_QBLOCK, axis=1)
        t_chunk = (t0 + jnp.arange(A_QBLOCK)) // CHUNK
        adm = s_chunk[None, :] <= t_chunk[:, None]
        rel = jax.nn.relu(jnp.einsum('bthd,bsd->bths', qi_b, ki).astype(jnp.float32) * IDX_DIM ** -0.5)
        score = jnp.einsum('bth,bths->bts', wi_b, rel)
        score = jnp.where(adm[None], score, -jnp.inf)
        _, idx = lax.top_k(score, topk)
        valid = (idx // CHUNK) <= t_chunk[None, :, None]
        k_sel = jax.vmap(lambda kb, ib: kb[ib])(k, idx)
        v_sel = jax.vmap(lambda vb, ib: vb[ib])(v, idx)
        logits = jnp.einsum('bthd,btkhd->bhtk', q_b, k_sel).astype(jnp.float32) * HEAD_DIM ** -0.5
        logits = jnp.where(valid[:, None], logits, -jnp.inf)
        p = jax.nn.softmax(logits, axis=-1).astype(v.dtype)
        return jnp.einsum('bhtk,btkhd->bthd', p, v_sel)

    o = lax.map(block, jnp.arange(S // A_QBLOCK))
    o = jnp.moveaxis(o, 0, 1).reshape(B, S, ATTN_W)
    return o @ w_out


def stick_breaking_mixer(h, w_q, k_sb, v_sb, w_out):
    B, S, _ = h.shape
    q = (h @ w_q).reshape(B, S, N_HEADS, HEAD_DIM)
    outs = []
    for i in range(S // B_QBLOCK):
        t0 = i * B_QBLOCK
        t1 = t0 + B_QBLOCK
        z = jnp.einsum('bthd,bshd->bhts', q[:, t0:t1], k_sb[:, :t1]).astype(jnp.float32) * HEAD_DIM ** -0.5
        causal = jnp.arange(t1)[None, :] < jnp.arange(t0, t1)[:, None]
        log_1mb = jnp.where(causal, jax.nn.log_sigmoid(-z), 0.0)
        suffix = lax.cumsum(log_1mb, axis=3, reverse=True) - log_1mb
        a = jnp.where(causal, jnp.exp(jax.nn.log_sigmoid(z) + suffix), 0.0)
        outs.append(jnp.einsum('bhts,bshd->bthd', a.astype(v_sb.dtype), v_sb[:, :t1]))
    o = jnp.concatenate(outs, axis=1).reshape(B, S, ATTN_W)
    return o @ w_out


def grouped_moe(h, router_w, router_bias, w_gate, w_up, w_down):
    B, S, D = h.shape
    xf = h.reshape(-1, D)
    probs = jax.nn.softmax((xf @ router_w).astype(jnp.float32), axis=-1)
    sel = probs + router_bias.astype(jnp.float32)
    grouped = sel.reshape(-1, N_GROUPS, EXPERTS_PER_GROUP)
    gscore = lax.top_k(grouped, 2)[0].sum(-1)
    g = jnp.argmax(gscore, axis=-1)
    in_group = jnp.take_along_axis(grouped, g[:, None, None], axis=1)[:, 0]
    _, local = lax.top_k(in_group, MOE_TOP_K)
    eidx = g[:, None] * EXPERTS_PER_GROUP + local
    w = jnp.take_along_axis(probs, eidx, axis=1)
    w = w / w.sum(-1, keepdims=True)
    gates = (jax.nn.one_hot(eidx, N_EXPERTS, dtype=jnp.float32) * w[..., None]).sum(1)
    gates = gates.astype(xf.dtype)
    y = jnp.zeros_like(xf)
    for e in range(N_EXPERTS):
        he = jax.nn.silu(xf @ w_gate[e]) * (xf @ w_up[e])
        y = y + gates[:, e:e + 1] * (he @ w_down[e])
    return y.reshape(B, S, D)


def setup_inputs(seed: int = 0) -> dict:
    key = jax.random.key(seed)
    ks = jax.random.split(key, 14)
    f32 = jnp.float32
    x = jax.random.normal(ks[0], (BATCH, SEQ, D_MODEL), f32)
    a_col = jnp.ones((A_IN_WIDTH,), f32).at[2 * ATTN_W:3 * ATTN_W].set(DEEPNORM_BETA)
    a_w_in = jax.random.normal(ks[1], (N_A_LAYERS, D_MODEL, A_IN_WIDTH), f32) * D_MODEL ** -0.5 * a_col
    a_w_out = jax.random.normal(ks[2], (N_A_LAYERS, ATTN_W, D_MODEL), f32) * ATTN_W ** -0.5 * DEEPNORM_BETA
    b_w_q = jax.random.normal(ks[3], (N_B_LAYERS, D_MODEL, ATTN_W), f32) * D_MODEL ** -0.5
    kv_col = jnp.ones((2 * ATTN_W,), f32).at[ATTN_W:].set(DEEPNORM_BETA)
    b_w_kv = jax.random.normal(ks[4], (D_MODEL, 2 * ATTN_W), f32) * D_MODEL ** -0.5 * kv_col
    b_w_out = jax.random.normal(ks[5], (N_B_LAYERS, ATTN_W, D_MODEL), f32) * ATTN_W ** -0.5 * DEEPNORM_BETA
    router_w = jax.random.normal(ks[6], (D_MODEL, N_EXPERTS), f32) * D_MODEL ** -0.5
    router_bias = 0.01 * jax.random.normal(ks[7], (N_EXPERTS,), f32)
    exp_w_gate = jax.random.normal(ks[8], (DEPTH, N_EXPERTS, D_MODEL, D_FF_EXPERT), f32) * D_MODEL ** -0.5
    exp_w_up = jax.random.normal(ks[9], (DEPTH, N_EXPERTS, D_MODEL, D_FF_EXPERT), f32) * D_MODEL ** -0.5 * DEEPNORM_BETA
    exp_w_down = jax.random.normal(ks[10], (DEPTH, N_EXPERTS, D_FF_EXPERT, D_MODEL), f32) * D_FF_EXPERT ** -0.5 * DEEPNORM_BETA
    ln_g = 1.0 + 0.01 * jax.random.normal(ks[11], (DEPTH, 2, D_MODEL), f32)
    ln_b = 0.01 * jax.random.normal(ks[12], (DEPTH, 2, D_MODEL), f32)
    return {'x': x, 'a_w_in': a_w_in, 'a_w_out': a_w_out, 'b_w_q': b_w_q, 'b_w_kv': b_w_kv,
            'b_w_out': b_w_out, 'router_w': router_w, 'router_bias': router_bias,
            'exp_w_gate': exp_w_gate, 'exp_w_up': exp_w_up, 'exp_w_down': exp_w_down,
            'ln_g': ln_g, 'ln_b': ln_b}


def reference(x, a_w_in, a_w_out, b_w_q, b_w_kv, b_w_out, router_w, router_bias,
              exp_w_gate, exp_w_up, exp_w_down, ln_g, ln_b):
    B, S, _ = x.shape
    h = x
    k_sb = None
    v_sb = None
    for layer in range(DEPTH):
        if layer < N_A_LAYERS:
            mix = dsa_mixer(h, a_w_in[layer], a_w_out[layer])
        else:
            if layer == N_A_LAYERS:
                kv = h @ b_w_kv
                k_sb, v_sb = jnp.split(kv, 2, axis=-1)
                k_sb = k_sb.reshape(B, S, N_HEADS, HEAD_DIM)
                v_sb = v_sb.reshape(B, S, N_HEADS, HEAD_DIM)
            j = layer - N_A_LAYERS
            mix = stick_breaking_mixer(h, b_w_q[j], k_sb, v_sb, b_w_out[j])
        h = layer_norm(DEEPNORM_ALPHA * h + mix, ln_g[layer, 0], ln_b[layer, 0])
        ffn = grouped_moe(h, router_w, router_bias, exp_w_gate[layer], exp_w_up[layer], exp_w_down[layer])
        h = layer_norm(DEEPNORM_ALPHA * h + ffn, ln_g[layer, 1], ln_b[layer, 1])
    return h
```

```cpp
#include <hip/hip_runtime.h>
#include <cstdio>
#include <cstdint>
#include <cstring>

#ifndef MK_N_LAUNCHES
#define MK_N_LAUNCHES 1
#endif

#define LAS __attribute__((address_space(3)))
#define DI __device__ __forceinline__
typedef unsigned short bf16_t;
typedef short bf16x8 __attribute__((ext_vector_type(8)));
typedef short s16x4 __attribute__((ext_vector_type(4)));
typedef float f32x2 __attribute__((ext_vector_type(2)));
typedef float f32x4 __attribute__((ext_vector_type(4)));
typedef float f32x16 __attribute__((ext_vector_type(16)));
typedef unsigned u32x2 __attribute__((ext_vector_type(2)));
typedef unsigned u32x4 __attribute__((ext_vector_type(4)));
typedef unsigned long long u64;

constexpr int NB = 16, SEQ = 2048, DM = 1024, NTOK = NB * SEQ, NH = 8, HD = 128;
constexpr int AIN = 3656, NIN = 3840;
constexpr int NEXP = 16, FFE = 256, LISTCAP = NTOK;
constexpr int TOPK = 256;
constexpr float LN_EPS = 1e-5f;
constexpr float DN_ALPHA = 1.41421356237309515f;
constexpr int NPH = 16;
constexpr int LDS_BYTES = 160 * 1024;
constexpr int MISC_OFF = LDS_BYTES - 1024;

constexpr size_t MiB = 1u << 20;
constexpr size_t WS_CTL = 0, CTL_BYTES = 64 * 1024;
constexpr size_t WS_WAIN = 1 * MiB;
constexpr size_t WS_WAOUT = WS_WAIN + (size_t)NIN * DM * 2;
constexpr size_t WS_WBQKV = WS_WAOUT + 2 * MiB;
constexpr size_t WS_WBOUT = WS_WBQKV + 6 * MiB;
constexpr size_t WS_WGU = WS_WBOUT + 2 * MiB;
constexpr size_t WS_WD = WS_WGU + 32 * MiB;
constexpr size_t WS_ROPE = WS_WD + 16 * MiB;
constexpr size_t WS_MOE = WS_ROPE + 2 * MiB;
constexpr size_t WS_XB = WS_MOE + 4 * MiB;
constexpr size_t WS_R1 = WS_XB + 64 * MiB;
constexpr size_t WS_HF = WS_R1 + 192 * MiB;
constexpr size_t WS_XB8 = WS_HF + 128 * MiB;
constexpr size_t WS_END = WS_XB8 + 32 * MiB;
constexpr size_t WS_SCL = WS_ROPE + 1536 * 1024;
constexpr size_t SCL_SA = 0, SCL_SBIN = 128 * 1024, SCL_SBQKV = 144 * 1024, SCL_SBGU = 160 * 1024;
constexpr size_t R1_HE = 128 * MiB;
constexpr size_t HF_QI = 0, HF_KI = 32 * MiB, HF_WI = 36 * MiB, HF_MASK = 40 * MiB;
constexpr int CW_BAR = 0;
constexpr int CW_CNT = 4096;

DI unsigned cvt_pk_bf16(float lo, float hi) { unsigned r; asm volatile("v_cvt_pk_bf16_f32 %0, %1, %2" : "=v"(r) : "v"(lo), "v"(hi)); return r; }
DI float bf2f(bf16_t b) { return __uint_as_float(((unsigned)b) << 16); }
#define DPPF0(x, ctrl) __uint_as_float(__builtin_amdgcn_update_dpp(0u, __float_as_uint(x), ctrl, 0xf, 0xf, true))
DI float wave_sum(float v) {
    v += DPPF0(v, 0xB1); v += DPPF0(v, 0x4E); v += DPPF0(v, 0x141); v += DPPF0(v, 0x140);
    const float r0 = __uint_as_float(__builtin_amdgcn_readlane(__float_as_uint(v), 0)), r1 = __uint_as_float(__builtin_amdgcn_readlane(__float_as_uint(v), 16));
    const float r2 = __uint_as_float(__builtin_amdgcn_readlane(__float_as_uint(v), 32)), r3 = __uint_as_float(__builtin_amdgcn_readlane(__float_as_uint(v), 48));
    return (r0 + r1) + (r2 + r3);
}
DI float wave_max(float v) {
#pragma unroll
    for (int d = 32; d >= 1; d >>= 1) v = fmaxf(v, __shfl_xor(v, d));
    return v;
}
DI float wave_min(float v) {
#pragma unroll
    for (int d = 32; d >= 1; d >>= 1) v = fminf(v, __shfl_xor(v, d));
    return v;
}
#define LDS_WAIT() asm volatile("s_waitcnt lgkmcnt(0)" ::: "memory")

#define XB_TMO      128
#define XB_XCNT(j)  (256  + 64 * (j))
#define XB_XSUB(j)  (1280 + 64 * (j))
#define XB_XGEN(j)  (2304 + 64 * (j))
#define XB_TOP      3328
#define XB_TOPGEN   3392
#define XCD_BAR_WORDS 3456
#define XB_SPIN_CAP (1u << 22)

DI unsigned xb_ld(unsigned* p)              { return __hip_atomic_load(p, __ATOMIC_RELAXED, __HIP_MEMORY_SCOPE_AGENT); }
DI unsigned xb_add(unsigned* p, unsigned v) { return __hip_atomic_fetch_add(p, v, __ATOMIC_RELAXED, __HIP_MEMORY_SCOPE_AGENT); }
DI unsigned xb_xcc_id() { return (unsigned)__builtin_amdgcn_s_getreg((3 << 11) | 20) & 0xFu; }
#define XB_SPIN(cond, bar) do { unsigned _sp = 0; while (cond) { __builtin_amdgcn_s_sleep(1); \
    if ((++_sp & 255u) == 0u) { if (xb_ld(&(bar)[XB_TMO])) break; if (_sp > XB_SPIN_CAP) { atomicAdd(&(bar)[XB_TMO], 1u); break; } } } } while (0)

struct XcdBarrier { unsigned* bar; unsigned x; volatile LAS unsigned* st; };

DI XcdBarrier xcd_barrier_post(unsigned* bar, volatile LAS unsigned* st) {
    XcdBarrier b; b.bar = bar; b.x = xb_xcc_id(); b.st = st;
    if (threadIdx.x == 0) (void)xb_add(&bar[XB_XCNT(b.x)], 1u);
    return b;
}
DI void xcd_barrier_complete(unsigned* bar, unsigned x, unsigned& nloc, unsigned& nx) {
    const unsigned G = gridDim.x * gridDim.y * gridDim.z;
    unsigned sum, cnt, mine, sp = 0u;
    for (;;) {
        sum = 0u; cnt = 0u; mine = 0u;
#pragma unroll
        for (unsigned j = 0; j < 16; ++j) { const unsigned c = xb_ld(&bar[XB_XCNT(j)]); sum += c; cnt += (c > 0u) ? 1u : 0u; mine = (j == x) ? c : mine; }
        if (sum == G) break;
        __builtin_amdgcn_s_sleep(1);
        if ((++sp & 255u) == 0u) { if (xb_ld(&bar[XB_TMO])) break; if (sp > XB_SPIN_CAP) { atomicAdd(&bar[XB_TMO], 1u); break; } }
    }
    nloc = mine > 0u ? mine : 1u; nx = cnt > 0u ? cnt : 1u;
}
DI void xcd_barrier(const XcdBarrier& b) {
    asm volatile("s_waitcnt vmcnt(0)" ::: "memory");
    __syncthreads();
    if (threadIdx.x == 0) {
        unsigned* bar = b.bar;
        __builtin_amdgcn_s_waitcnt(0);
        unsigned nloc = b.st[0], nx = b.st[1];
        if (nloc == 0u) { xcd_barrier_complete(bar, b.x, nloc, nx); b.st[0] = nloc; b.st[1] = nx; }
        const unsigned old = xb_add(&bar[XB_XSUB(b.x)], 1u);
        const unsigned gen = old / nloc;
        if (old + 1u == (gen + 1u) * nloc) {
            __builtin_amdgcn_fence(__ATOMIC_RELEASE, "agent");
            asm volatile("s_waitcnt vmcnt(0)" ::: "memory");
            const unsigned og = xb_add(&bar[XB_TOP], 1u);
            const unsigned tg = og / nx;
            if (og + 1u == (tg + 1u) * nx) xb_add(&bar[XB_TOPGEN], 1u);
            else XB_SPIN(xb_ld(&bar[XB_TOPGEN]) == tg, bar);
            __builtin_amdgcn_fence(__ATOMIC_ACQUIRE, "agent");
            xb_add(&bar[XB_XGEN(b.x)], 1u);
            asm volatile("s_waitcnt vmcnt(0)" ::: "memory");
        } else {
            XB_SPIN(xb_ld(&bar[XB_XGEN(b.x)]) == gen, bar);
            __builtin_amdgcn_fence(__ATOMIC_ACQUIRE, "agent");
            asm volatile("s_waitcnt vmcnt(0)" ::: "memory");
        }
    }
    __syncthreads();
}

namespace pg8 {
constexpr int BM = 256, BK = 64, HALF = 128, HTB = HALF * BK * 2, STAGE_BYTES = 8 * HTB, NXCD = 8, WGM = 8;
DI int lds_byte(int r, int c) { const int st = (r >> 4) * 2 + (c >> 5), rr = r & 15, cc = c & 31, ob = rr * 64 + cc * 2; return st * 1024 + (ob ^ (((ob >> 9) & 1) << 5)); }
DI void stage_rc(int b, int& R, int& C) { const int st = b / 1024, sb = b % 1024, swz = sb ^ (((sb >> 9) & 1) << 5); R = (st >> 1) * 16 + swz / 64; C = (st & 1) * 32 + (swz % 64) / 2; }
DI int perm32(int rho) { const int n = rho >> 4, i = rho & 15; return 8 * (i >> 2) + 4 * n + (i & 3); }

struct Unit { int pm, pn, e, rb; };

DI int xcd_remap(int wgid, int nwg) { const int q = nwg / NXCD, r = nwg % NXCD, xcd = wgid % NXCD, off = wgid / NXCD; return (xcd < r ? xcd * (q + 1) : r * (q + 1) + (xcd - r) * q) + off; }

struct SchedDense {
    static constexpr bool GATHER = false;
    const bf16_t* A; const bf16_t* Bt; int K; int nM, nN, nwg, G, c; const float* sA = nullptr; const float* sB = nullptr;
    DI void init(const bf16_t* A_, const bf16_t* Bt_, int M, int N, int K_, int G_, int c_) { A = A_; Bt = Bt_; K = K_; nM = M / BM; nN = N / BM; nwg = nM * nN; G = G_; c = c_; }
    DI bool next(int i, Unit& u) const {
        const long L = (long)i * G + c; if (L >= nwg) return false;
        const int wgid = xcd_remap((int)L, nwg);
        const int nig = WGM * nN, gid = wgid / nig, fm = gid * WGM, gsz = (nM - fm) < WGM ? (nM - fm) : WGM;
        u.pm = fm + ((wgid % nig) % gsz); u.pn = (wgid % nig) / gsz; u.e = 0; u.rb = 0; return true;
    }
    DI const char* abase(const Unit& u) const { return (const char*)A + (size_t)u.pm * BM * K * 2; }
    DI const char* bbase(const Unit& u) const { return (const char*)Bt + (size_t)u.pn * BM * K * 2; }
    DI float scale_a(const Unit& u, int r) const { return sA[u.pm * BM + r]; }
    DI const float* scale_b(const Unit& u) const { return sB + u.pn * BM; }
    DI void aoffs(const Unit&, int tid, unsigned (&v)[2][2]) const {
#pragma unroll
        for (int i = 0; i < 2; ++i) { int R, C; stage_rc(tid * 16 + i * 8192, R, C); v[0][i] = (unsigned)(R * K + C) * 2u; v[1][i] = v[0][i] + (unsigned)(HALF * K) * 2u; }
    }
};
struct SchedMoe {
    static constexpr bool GATHER = true;
    const bf16_t* A; const bf16_t* Bt; int K, nN; size_t bstride; const LAS int* tab; const int* list; int gather; int G, c; const float* sA = nullptr; const float* sB = nullptr;
    DI bool next(int i, Unit& u) const {
        const int total = tab[16] * nN; const long L = (long)i * G + c; if (L >= total) return false;
        const int wgid = xcd_remap((int)L, total);
        const int rt = wgid / nN; u.pn = wgid % nN; u.pm = rt;
        int e = 0;
#pragma unroll 1
        for (; e < 15; ++e) if (rt < tab[e + 1]) break;
        u.e = e; u.rb = (rt - tab[e]) * BM; return true;
    }
    DI const char* abase(const Unit& u) const { return gather ? (const char*)A : (const char*)A + (size_t)u.pm * BM * K * 2; }
    DI const char* bbase(const Unit& u) const { return (const char*)Bt + (size_t)u.e * bstride + (size_t)u.pn * BM * K * 2; }
    DI float scale_a(const Unit& u, int r) const { const int cnt = tab[17 + u.e]; int rr = u.rb + r; rr = rr < cnt ? rr : cnt - 1; return sA[list[(size_t)u.e * LISTCAP + rr] >> 1]; }
    DI const float* scale_b(const Unit& u) const { return sB + u.e * 512 + u.pn * BM; }
    DI void aoffs(const Unit& u, int tid, unsigned (&v)[2][2]) const {
        const int cnt = tab[17 + u.e];
#pragma unroll
        for (int i = 0; i < 2; ++i) { int R, C; stage_rc(tid * 16 + i * 8192, R, C);
#pragma unroll
            for (int h = 0; h < 2; ++h) {
                int row = R + h * HALF;
                if (gather) { int r = u.rb + row; r = r < cnt ? r : cnt - 1; row = list[(size_t)u.e * LISTCAP + r] >> 1; }
                v[h][i] = (unsigned)(row * K + C) * 2u; } }
    }
};

typedef int i32x4 __attribute__((ext_vector_type(4)));
template <class Epi, class Sched, bool INT8 = false>
DI void gemm_phase(LAS unsigned char* lds, const Sched& S, const Epi& E) {
    const int tid = threadIdx.x, wid = __builtin_amdgcn_readfirstlane(tid >> 6), lane = tid & 63, wr = wid >> 2, wc = wid & 3, fr = lane & 15, fq = lane >> 4;
    const int K = S.K, nt = K / BK;
    unsigned voffB[2], vA[2][2], vN[2][2];
#pragma unroll
    for (int i = 0; i < 2; ++i) { int R, C; stage_rc(tid * 16 + i * 8192, R, C); const int Rb = Epi::PERM ? ((R & ~31) + perm32(R & 31)) : R; voffB[i] = (unsigned)(Rb * K + C) * 2u; }
    const size_t kstep = (size_t)(BK * 2);
    const size_t hstep = (size_t)HALF * K * 2;
    const unsigned ldsw = (unsigned)wid * 1024u;
    const int aoff = lds_byte(wr * 64 + fr, fq * 8), boff = lds_byte(wc * 32 + fr, fq * 8);
#define PG8_SA(b, h) (((b) * 2 + (h)) * HTB)
#define PG8_SB(b, h) ((4 + (b) * 2 + (h)) * HTB)
#define PG8_STAGE(bufoff, gbase, voff) do { _Pragma("unroll") for (int _i = 0; _i < 2; ++_i) \
        __builtin_amdgcn_global_load_lds((const unsigned*)((const char*)(gbase) + (voff)[_i]), (LAS unsigned*)(lds + (bufoff) + ldsw + _i * 8192), 16, 0, 0); } while (0)
#define PG8_LDA(dst, b, h) do { _Pragma("unroll") for (int m = 0; m < 4; ++m) _Pragma("unroll") for (int k = 0; k < 2; ++k) dst[m][k] = *(const LAS bf16x8*)(lds + PG8_SA(b, h) + aoff + m * 2048 + k * 1024); } while (0)
#define PG8_LDB(dst, b, h) do { _Pragma("unroll") for (int n = 0; n < 2; ++n) _Pragma("unroll") for (int k = 0; k < 2; ++k) dst[n][k] = *(const LAS bf16x8*)(lds + PG8_SB(b, h) + boff + n * 2048 + k * 1024); } while (0)
#define PG8_MMA(ai, bj, At, Bt) do { __builtin_amdgcn_s_setprio(1); _Pragma("unroll") for (int m = 0; m < 4; ++m) _Pragma("unroll") for (int n = 0; n < 2; ++n) _Pragma("unroll") for (int k = 0; k < 2; ++k) { \
        if constexpr (INT8) acc[ai][bj][m][n] = __builtin_bit_cast(f32x4, __builtin_amdgcn_mfma_i32_16x16x64_i8(__builtin_bit_cast(i32x4, Bt[n][k]), __builtin_bit_cast(i32x4, At[m][k]), __builtin_bit_cast(i32x4, acc[ai][bj][m][n]), 0, 0, 0)); \
        else acc[ai][bj][m][n] = __builtin_amdgcn_mfma_f32_16x16x32_bf16(Bt[n][k], At[m][k], acc[ai][bj][m][n], 0, 0, 0); } __builtin_amdgcn_s_setprio(0); } while (0)
#define PG8_WAIT_V(n) asm volatile("s_waitcnt vmcnt(" #n ")" ::: "memory")
#define PG8_WAIT_L(n) asm volatile("s_waitcnt lgkmcnt(" #n ")" ::: "memory")
#define PG8_BAR __builtin_amdgcn_s_barrier()
#define PG8_SCHED __builtin_amdgcn_sched_barrier(0)
    Unit cur, nxt; int ui = 0;
    if (!S.next(0, cur)) return;
    f32x4 acc[2][2][4][2];
#pragma unroll
    for (int a = 0; a < 2; ++a)
#pragma unroll
        for (int b = 0; b < 2; ++b)
#pragma unroll
            for (int m = 0; m < 4; ++m)
#pragma unroll
                for (int n = 0; n < 2; ++n) acc[a][b][m][n] = (f32x4){0.f, 0.f, 0.f, 0.f};
    bf16x8 At[4][2], B0[2][2], B1[2][2];
    const char* cA = S.abase(cur); const char* cB = S.bbase(cur);
    S.aoffs(cur, tid, vA);
    PG8_STAGE(PG8_SB(0, 0), cB, voffB); PG8_STAGE(PG8_SA(0, 0), cA, vA[0]); PG8_STAGE(PG8_SB(0, 1), cB + hstep, voffB); PG8_STAGE(PG8_SA(0, 1), cA, vA[1]);
    if (wr == 1) PG8_BAR;
    PG8_WAIT_V(4); PG8_BAR;
    PG8_STAGE(PG8_SB(1, 0), cB + kstep, voffB); PG8_STAGE(PG8_SA(1, 0), cA + kstep, vA[0]); PG8_STAGE(PG8_SB(1, 1), cB + hstep + kstep, voffB);
    PG8_WAIT_V(6); PG8_BAR;
    for (;;) {
        const bool has_next = S.next(ui + 1, nxt);
        const char* nA = has_next ? S.abase(nxt) : cA; const char* nB = has_next ? S.bbase(nxt) : cB;
        if (Sched::GATHER) { if (has_next) S.aoffs(nxt, tid, vN); else { vN[0][0] = vA[0][0]; vN[0][1] = vA[0][1]; vN[1][0] = vA[1][0]; vN[1][1] = vA[1][1]; } }
        for (int t = 0; t < nt; t += 2) {
            const bool last = (t == nt - 2);
            const char* a1 = cA + (size_t)(t + 1) * kstep;
            const char* a2 = last ? nA : cA + (size_t)(t + 2) * kstep; const char* b2 = last ? nB : cB + (size_t)(t + 2) * kstep;
            const char* a3 = a2 + kstep; const char* b3 = b2 + kstep;
            unsigned o2[2][2];
#pragma unroll
            for (int h = 0; h < 2; ++h)
#pragma unroll
                for (int i = 0; i < 2; ++i) o2[h][i] = (Sched::GATHER && last) ? vN[h][i] : vA[h][i];
            PG8_LDB(B0, 0, 0); PG8_SCHED; PG8_LDA(At, 0, 0); PG8_STAGE(PG8_SA(1, 1), a1, vA[1]);
            PG8_WAIT_L(8); PG8_BAR; PG8_WAIT_L(0); PG8_MMA(0, 0, At, B0); PG8_BAR; PG8_SCHED;
            PG8_LDB(B1, 0, 1); PG8_STAGE(PG8_SB(0, 0), b2, voffB);
            PG8_BAR; PG8_WAIT_L(0); PG8_MMA(0, 1, At, B1); PG8_BAR;
            PG8_LDA(At, 0, 1); PG8_STAGE(PG8_SA(0, 0), a2, o2[0]);
            PG8_BAR; PG8_WAIT_L(0); PG8_MMA(1, 0, At, B0); PG8_BAR; PG8_SCHED;
            PG8_STAGE(PG8_SB(0, 1), b2 + hstep, voffB);
            PG8_WAIT_V(6); PG8_BAR; PG8_MMA(1, 1, At, B1); PG8_BAR;
            PG8_LDB(B0, 1, 0); PG8_SCHED; PG8_LDA(At, 1, 0); PG8_STAGE(PG8_SA(0, 1), a2, o2[1]);
            PG8_WAIT_L(8); PG8_BAR; PG8_WAIT_L(0); PG8_MMA(0, 0, At, B0); PG8_BAR; PG8_SCHED;
            PG8_LDB(B1, 1, 1); PG8_STAGE(PG8_SB(1, 0), b3, voffB);
            PG8_BAR; PG8_WAIT_L(0); PG8_MMA(0, 1, At, B1); PG8_BAR;
            PG8_LDA(At, 1, 1); PG8_STAGE(PG8_SA(1, 0), a3, o2[0]);
            PG8_BAR; PG8_WAIT_L(0); PG8_MMA(1, 0, At, B0); PG8_BAR; PG8_SCHED;
            PG8_STAGE(PG8_SB(1, 1), b3 + hstep, voffB);
            PG8_WAIT_V(6); PG8_BAR; PG8_MMA(1, 1, At, B1); PG8_BAR;
        }
        if constexpr (INT8) {
            const int rb_ = wr * 64 + fr, cb_ = wc * 32 + (Epi::PERM ? 8 * fq : 4 * fq); const float* sbp = S.scale_b(cur);
            float ra[2][4]; f32x4 cs[2][2];
#pragma unroll
            for (int a = 0; a < 2; ++a)
#pragma unroll
                for (int m = 0; m < 4; ++m) ra[a][m] = S.scale_a(cur, rb_ + a * HALF + m * 16);
#pragma unroll
            for (int b = 0; b < 2; ++b)
#pragma unroll
                for (int n = 0; n < 2; ++n) cs[b][n] = *(const f32x4*)(sbp + cb_ + b * HALF + (Epi::PERM ? 4 * n : 16 * n));
#pragma unroll
            for (int a = 0; a < 2; ++a)
#pragma unroll
                for (int b = 0; b < 2; ++b)
#pragma unroll
                    for (int m = 0; m < 4; ++m)
#pragma unroll
                        for (int n = 0; n < 2; ++n) { const i32x4 v_ = __builtin_bit_cast(i32x4, acc[a][b][m][n]);
                            acc[a][b][m][n] = (f32x4){(float)v_[0], (float)v_[1], (float)v_[2], (float)v_[3]} * ra[a][m] * cs[b][n]; }
        }
        E(acc, cur, wr, wc, fr, fq);
        if (!has_next) break;
#pragma unroll
        for (int a = 0; a < 2; ++a)
#pragma unroll
            for (int b = 0; b < 2; ++b)
#pragma unroll
                for (int m = 0; m < 4; ++m)
#pragma unroll
                    for (int n = 0; n < 2; ++n) acc[a][b][m][n] = (f32x4){0.f, 0.f, 0.f, 0.f};
        cur = nxt; cA = nA; cB = nB; ++ui;
        if (Sched::GATHER) { vA[0][0] = vN[0][0]; vA[0][1] = vN[0][1]; vA[1][0] = vN[1][0]; vA[1][1] = vN[1][1]; }
    }
    PG8_WAIT_V(0);
    if (wr == 0) PG8_BAR;
    PG8_BAR;
#undef PG8_SA
#undef PG8_SB
#undef PG8_STAGE
#undef PG8_LDA
#undef PG8_LDB
#undef PG8_MMA
#undef PG8_WAIT_V
#undef PG8_WAIT_L
#undef PG8_BAR
#undef PG8_SCHED
}

DI u32x4 pack8(f32x4 a, f32x4 b) { u32x4 w; w.x = cvt_pk_bf16(a[0], a[1]); w.y = cvt_pk_bf16(a[2], a[3]); w.z = cvt_pk_bf16(b[0], b[1]); w.w = cvt_pk_bf16(b[2], b[3]); return w; }

struct EpiF32 {
    static constexpr bool PERM = false;
    float* C; int ldc;
    DI void operator()(const f32x4 (&acc)[2][2][4][2], const Unit& u, int wr, int wc, int fr, int fq) const {
        const int row0 = u.pm * BM + wr * 64 + fr, col0 = u.pn * BM + wc * 32 + 4 * fq;
#pragma unroll
        for (int ai = 0; ai < 2; ++ai)
#pragma unroll
            for (int m = 0; m < 4; ++m) { float* rowp = C + (size_t)(row0 + ai * HALF + m * 16) * ldc + col0;
#pragma unroll
                for (int bj = 0; bj < 2; ++bj)
#pragma unroll
                    for (int n = 0; n < 2; ++n) *(f32x4*)(rowp + bj * HALF + n * 16) = acc[ai][bj][m][n]; }
    }
};
struct EpiBf16Split {
    static constexpr bool PERM = true;
    bf16_t* O; int ldc; int split_cols; size_t split_stride;
    DI void operator()(const f32x4 (&acc)[2][2][4][2], const Unit& u, int wr, int wc, int fr, int fq) const {
        const int row0 = u.pm * BM + wr * 64 + fr; int colt = u.pn * BM; bf16_t* base = O;
        { const int t = colt / split_cols; base += (size_t)t * split_stride; colt -= t * split_cols; }
        const int col0 = colt + wc * 32 + 8 * fq;
#pragma unroll
        for (int ai = 0; ai < 2; ++ai)
#pragma unroll
            for (int m = 0; m < 4; ++m) { bf16_t* rowp = base + (size_t)(row0 + ai * HALF + m * 16) * ldc + col0;
#pragma unroll
                for (int bj = 0; bj < 2; ++bj) *(u32x4*)(rowp + bj * HALF) = pack8(acc[ai][bj][m][0], acc[ai][bj][m][1]); }
    }
};
struct EpiInProj {
    static constexpr bool PERM = true;
    bf16_t* QKV; bf16_t* QI; bf16_t* KI; float* WI; const float* cos128; const float* sin128; const float* cos64; const float* sin64;
    DI void operator()(const f32x4 (&acc)[2][2][4][2], const Unit& u, int wr, int wc, int fr, int fq) const {
        const int row0 = u.pm * BM + wr * 64 + fr;
        if (u.pn < 8) {
            bf16_t* base = QKV + (size_t)(u.pn >> 2) * NTOK * DM; const int col0 = (u.pn & 3) * BM + wc * 32 + 8 * fq, dp = 16 * wc + 4 * fq;
#pragma unroll
            for (int ai = 0; ai < 2; ++ai)
#pragma unroll
                for (int m = 0; m < 4; ++m) { const int row = row0 + ai * HALF + m * 16, t = row & (SEQ - 1);
                    const f32x4 c4 = *(const f32x4*)(cos128 + t * 64 + dp), s4 = *(const f32x4*)(sin128 + t * 64 + dp);
#pragma unroll
                    for (int bj = 0; bj < 2; ++bj) { const f32x4 x1 = acc[ai][bj][m][0], x2 = acc[ai][bj][m][1];
                        *(u32x4*)(base + (size_t)row * DM + col0 + bj * HALF) = pack8(x1 * c4 - x2 * s4, x1 * s4 + x2 * c4); } }
        } else if (u.pn < 12) {
            bf16_t* base = QKV + (size_t)2 * NTOK * DM; const int col0 = (u.pn - 8) * BM + wc * 32 + 8 * fq;
#pragma unroll
            for (int ai = 0; ai < 2; ++ai)
#pragma unroll
                for (int m = 0; m < 4; ++m) { const int row = row0 + ai * HALF + m * 16;
#pragma unroll
                    for (int bj = 0; bj < 2; ++bj) *(u32x4*)(base + (size_t)row * DM + col0 + bj * HALF) = pack8(acc[ai][bj][m][0], acc[ai][bj][m][1]); }
        } else if (u.pn < 14) {
            const int col0 = (u.pn - 12) * BM + wc * 32 + 8 * fq, dp = 16 * (wc & 1) + 4 * fq;
#pragma unroll
            for (int ai = 0; ai < 2; ++ai)
#pragma unroll
                for (int m = 0; m < 4; ++m) { const int row = row0 + ai * HALF + m * 16, t = row & (SEQ - 1);
                    const f32x4 c4 = *(const f32x4*)(cos64 + t * 32 + dp), s4 = *(const f32x4*)(sin64 + t * 32 + dp);
#pragma unroll
                    for (int bj = 0; bj < 2; ++bj) { const f32x4 x1 = acc[ai][bj][m][0], x2 = acc[ai][bj][m][1];
                        *(u32x4*)(QI + (size_t)row * 512 + col0 + bj * HALF) = pack8(x1 * c4 - x2 * s4, x1 * s4 + x2 * c4); } }
        } else {
            if (wc < 2) { const int col0 = wc * 32 + 8 * fq, dp = 16 * wc + 4 * fq;
#pragma unroll
                for (int ai = 0; ai < 2; ++ai)
#pragma unroll
                    for (int m = 0; m < 4; ++m) { const int row = row0 + ai * HALF + m * 16, t = row & (SEQ - 1);
                        const f32x4 c4 = *(const f32x4*)(cos64 + t * 32 + dp), s4 = *(const f32x4*)(sin64 + t * 32 + dp);
                        const f32x4 x1 = acc[ai][0][m][0], x2 = acc[ai][0][m][1];
                        *(u32x4*)(KI + (size_t)row * 64 + col0) = pack8(x1 * c4 - x2 * s4, x1 * s4 + x2 * c4); }
            } else if (wc == 2 && fq == 0) {
                const float sc = 0.35355339059327373f;
#pragma unroll
                for (int ai = 0; ai < 2; ++ai)
#pragma unroll
                    for (int m = 0; m < 4; ++m) { const int row = row0 + ai * HALF + m * 16;
                        *(f32x4*)(WI + (size_t)row * 8) = acc[ai][0][m][0] * sc; *(f32x4*)(WI + (size_t)row * 8 + 4) = acc[ai][0][m][1] * sc; }
            }
        }
    }
};
struct EpiMoe1 {
    static constexpr bool PERM = true;
    bf16_t* HE;
    DI void operator()(const f32x4 (&acc)[2][2][4][2], const Unit& u, int wr, int wc, int fr, int fq) const {
        const int row0 = u.pm * BM + wr * 64 + fr, hc0 = 128 * u.pn + 16 * wc + 4 * fq;
#pragma unroll
        for (int ai = 0; ai < 2; ++ai)
#pragma unroll
            for (int m = 0; m < 4; ++m) { const int row = row0 + ai * HALF + m * 16;
#pragma unroll
                for (int bj = 0; bj < 2; ++bj) { const f32x4 g = acc[ai][bj][m][0], up = acc[ai][bj][m][1]; f32x4 h;
#pragma unroll
                    for (int j = 0; j < 4; ++j) h[j] = g[j] * __builtin_amdgcn_rcpf(1.0f + __builtin_amdgcn_exp2f(-1.4426950408889634f * g[j])) * up[j];
                    u32x2 w; w.x = cvt_pk_bf16(h[0], h[1]); w.y = cvt_pk_bf16(h[2], h[3]);
                    *(u32x2*)(HE + (size_t)row * FFE + hc0 + 64 * bj) = w; } }
    }
};
struct EpiMoe2 {
    static constexpr bool PERM = true;
    bf16_t* Y; const int* list; const float* gatew; const LAS int* tab;
    DI void operator()(const f32x4 (&acc)[2][2][4][2], const Unit& u, int wr, int wc, int fr, int fq) const {
        const int cnt = tab[17 + u.e], col0 = u.pn * BM + wc * 32 + 8 * fq;
        int ent[8]; float gw[8];
#pragma unroll
        for (int i = 0; i < 8; ++i) { int r = u.rb + (i >> 2) * HALF + wr * 64 + (i & 3) * 16 + fr; r = r < cnt ? r : cnt - 1; ent[i] = list[(size_t)u.e * LISTCAP + r]; }
#pragma unroll
        for (int i = 0; i < 8; ++i) { int r = u.rb + (i >> 2) * HALF + wr * 64 + (i & 3) * 16 + fr; r = r < cnt ? r : cnt - 1; gw[i] = gatew[(size_t)u.e * LISTCAP + r]; }
#pragma unroll
        for (int i = 0; i < 8; ++i) { const int ai = i >> 2, m = i & 3, r = u.rb + ai * HALF + wr * 64 + m * 16 + fr;
            if (r < cnt) { bf16_t* dst = Y + ((size_t)(ent[i] & 1) * NTOK + (size_t)(ent[i] >> 1)) * DM + col0;
#pragma unroll
                for (int bj = 0; bj < 2; ++bj) *(u32x4*)(dst + bj * HALF) = pack8(acc[ai][bj][m][0] * gw[i], acc[ai][bj][m][1] * gw[i]); } }
    }
};
}

struct Args { const float* in[13]; float* out; unsigned char* ws; int ph_lo, ph_hi; };
struct Frame {
    LAS unsigned char* lds; int tid, lane, wave, G, bid;
    unsigned char* ws; unsigned* ctl;
};

DI int src_col(int mode, int p) {
    if (mode == 0) return p;
    if (mode == 1) {
        if (p < 2048) { const int hd = p >> 7, pp = p & 127; return (hd << 7) + ((pp >> 3) << 2) + (pp & 3) + 64 * ((pp >> 2) & 1); }
        if (p < 3072) return p;
        if (p < 3648) { const int q = p - 3072, hd = q >> 6, pp = q & 63; return 3072 + (hd << 6) + ((pp >> 3) << 2) + (pp & 3) + 32 * ((pp >> 2) & 1); }
        if (p < AIN) return p;
        return -1; }
    return ((p >> 3) << 2) + (p & 3);
}
DI void tconv_tile(const Frame& F, const float* W, const float* W2, int ldw, int K, bf16_t* Bt, int mode, int k0, int n0) {
    LAS float* T = (LAS float*)F.lds;
    { const int n4 = (F.tid & 15) * 4, p = n0 + n4, src = src_col(mode, p); const float* Ws = (mode == 2 && ((p >> 2) & 1)) ? W2 : W;
#pragma unroll
      for (int i = 0; i < 2; ++i) { const int kl = (F.tid >> 4) + 32 * i;
          const f32x4 v = src >= 0 ? *(const f32x4*)(Ws + (size_t)(k0 + kl) * ldw + src) : (f32x4){0.f, 0.f, 0.f, 0.f};
          T[kl * 65 + n4] = v[0]; T[kl * 65 + n4 + 1] = v[1]; T[kl * 65 + n4 + 2] = v[2]; T[kl * 65 + n4 + 3] = v[3]; } }
    __syncthreads();
    { const int nl = F.tid >> 3, kl = (F.tid & 7) * 8; float v[8];
#pragma unroll
      for (int j = 0; j < 8; ++j) v[j] = T[(kl + j) * 65 + nl];
      u32x4 w; w.x = cvt_pk_bf16(v[0], v[1]); w.y = cvt_pk_bf16(v[2], v[3]); w.z = cvt_pk_bf16(v[4], v[5]); w.w = cvt_pk_bf16(v[6], v[7]);
      *(u32x4*)(Bt + (size_t)(n0 + nl) * K + k0 + kl) = w; }
    __syncthreads();
}
DI void dsincos(double x, double& s, double& c) {
    const double k = rint(x * 0.63661977236758134308);
    const double r = (x - k * 1.57079632679489655800) - k * 6.12323399573676603587e-17;
    const double r2 = r * r;
    double sp = 1.0 / 1307674368000.0; sp = sp * r2 - 1.0 / 6227020800.0; sp = sp * r2 + 1.0 / 39916800.0; sp = sp * r2 - 1.0 / 5040.0; sp = sp * r2 + 1.0 / 120.0; sp = sp * r2 - 1.0 / 6.0; sp = sp * r2 + 1.0;
    double cp = -1.0 / 87178291200.0; cp = cp * r2 + 1.0 / 479001600.0; cp = cp * r2 - 1.0 / 3628800.0; cp = cp * r2 + 1.0 / 40320.0; cp = cp * r2 - 1.0 / 720.0; cp = cp * r2 + 1.0 / 24.0; cp = cp * r2 - 0.5; cp = cp * r2 + 1.0;
    const double sr = sp * r, cr = cp;
    const int q = ((int)k) & 3;
    s = (q == 0) ? sr : (q == 1) ? cr : (q == 2) ? -sr : -cr;
    c = (q == 0) ? cr : (q == 1) ? -sr : (q == 2) ? -cr : sr;
}
DI float dpp_wave_max_f(float v);
DI void quant_row(const f32x4 (&v)[4], int lane, signed char* dst, float* sdst) {
    float mx = 0.f;
#pragma unroll
    for (int i = 0; i < 4; ++i) mx = fmaxf(mx, fmaxf(fmaxf(fabsf(v[i][0]), fabsf(v[i][1])), fmaxf(fabsf(v[i][2]), fabsf(v[i][3]))));
    mx = dpp_wave_max_f(mx);
    const float inv = mx > 0.f ? 127.0f / mx : 0.f;
#pragma unroll
    for (int i = 0; i < 4; ++i) { const int q0 = (int)__builtin_rintf(v[i][0] * inv), q1 = (int)__builtin_rintf(v[i][1] * inv), q2 = (int)__builtin_rintf(v[i][2] * inv), q3 = (int)__builtin_rintf(v[i][3] * inv);
        *(int*)(dst + 4 * lane + 256 * i) = (q0 & 0xFF) | ((q1 & 0xFF) << 8) | ((q2 & 0xFF) << 16) | (q3 << 24); }
    if (lane == 0) *sdst = mx * (1.0f / 127.0f);
}
DI void wq8_unit(const Frame& F, const float* W0, const float* W2, int ldw, int mode, signed char* Bt8, float* sB, int n0) {
    LAS float* T = (LAS float*)F.lds;
    LAS unsigned* cmax = (LAS unsigned*)(F.lds + 1024 * 33 * 4);
    const int n4 = (F.tid & 7) * 4, src = src_col(mode, n0 + n4); const float* W = (mode == 2 && (((n0 + n4) >> 2) & 1)) ? W2 : W0;
    if (F.tid < 32) cmax[F.tid] = 0u;
    __syncthreads();
    f32x4 m4 = {0.f, 0.f, 0.f, 0.f}, vv[16];
#pragma unroll
    for (int i = 0; i < 16; ++i) vv[i] = src >= 0 ? *(const f32x4*)(W + (size_t)((F.tid >> 3) + 64 * i) * ldw + src) : (f32x4){0.f, 0.f, 0.f, 0.f};
#pragma unroll
    for (int i = 0; i < 16; ++i) { const int kk = (F.tid >> 3) + 64 * i; const f32x4 v = vv[i];
        m4[0] = fmaxf(m4[0], fabsf(v[0])); m4[1] = fmaxf(m4[1], fabsf(v[1])); m4[2] = fmaxf(m4[2], fabsf(v[2])); m4[3] = fmaxf(m4[3], fabsf(v[3]));
        T[kk * 33 + n4] = v[0]; T[kk * 33 + n4 + 1] = v[1]; T[kk * 33 + n4 + 2] = v[2]; T[kk * 33 + n4 + 3] = v[3]; }
#pragma unroll
    for (int j = 0; j < 4; ++j) __hip_atomic_fetch_max(cmax + n4 + j, __float_as_uint(m4[j]), __ATOMIC_RELAXED, __HIP_MEMORY_SCOPE_WORKGROUP);
    __syncthreads();
    if (F.tid < 32) sB[n0 + F.tid] = __uint_as_float(cmax[F.tid]) * (1.0f / 127.0f);
    { const int nl = F.tid & 31, kb = (F.tid >> 5) * 64; const float mx = __uint_as_float(cmax[nl]), inv = mx > 0.f ? 127.0f / mx : 0.f;
#pragma unroll 2
      for (int k8 = 0; k8 < 64; k8 += 8) { int q[8];
#pragma unroll
          for (int j = 0; j < 8; ++j) q[j] = (int)__builtin_rintf(T[(kb + k8 + j) * 33 + nl] * inv);
          u32x2 w; w.x = (unsigned)((q[0] & 0xFF) | ((q[1] & 0xFF) << 8) | ((q[2] & 0xFF) << 16) | (q[3] << 24)); w.y = (unsigned)((q[4] & 0xFF) | ((q[5] & 0xFF) << 8) | ((q[6] & 0xFF) << 16) | (q[7] << 24));
          *(u32x2*)(Bt8 + (size_t)(n0 + nl) * DM + kb + k8) = w; } }
    __syncthreads();
}
DI void p0_prologue(const Frame& F, const Args& a) {
    const size_t gtid = (size_t)F.bid * 512 + F.tid, gthreads = (size_t)F.G * 512;
    { signed char* xq = (signed char*)(F.ws + WS_XB8); float* SA = (float*)(F.ws + WS_SCL + SCL_SA);
      const int gw = F.bid * 8 + F.wave, nw = F.G * 8, lane = F.lane;
      f32x4 rr[4][4];
#define XQ_LOAD(slot, r_) do { const int r2_ = (r_) < NTOK ? (r_) : gw; _Pragma("unroll") for (int i = 0; i < 4; ++i) rr[slot][i] = *(const f32x4*)(a.in[0] + (size_t)r2_ * DM + 4 * lane + 256 * i); } while (0)
      XQ_LOAD(0, gw); XQ_LOAD(1, gw + nw); XQ_LOAD(2, gw + 2 * nw);
      for (int row = gw; row < NTOK; row += 4 * nw) {
          XQ_LOAD(3, row + 3 * nw);
          quant_row(rr[0], lane, xq + (size_t)row * DM, SA + row);
          XQ_LOAD(0, row + 4 * nw);
          if (row + nw < NTOK) quant_row(rr[1], lane, xq + (size_t)(row + nw) * DM, SA + row + nw);
          XQ_LOAD(1, row + 5 * nw);
          if (row + 2 * nw < NTOK) quant_row(rr[2], lane, xq + (size_t)(row + 2 * nw) * DM, SA + row + 2 * nw);
          XQ_LOAD(2, row + 6 * nw);
          if (row + 3 * nw < NTOK) quant_row(rr[3], lane, xq + (size_t)(row + 3 * nw) * DM, SA + row + 3 * nw);
      }
#undef XQ_LOAD
    }
    { float* c128 = (float*)(F.ws + WS_ROPE), * s128 = c128 + SEQ * 64, * c64 = s128 + SEQ * 64, * s64 = c64 + SEQ * 32;
      for (size_t i = gtid; i < (size_t)SEQ * 96; i += gthreads) {
          const bool big = i < (size_t)SEQ * 64; const int j = big ? (int)i : (int)(i - (size_t)SEQ * 64);
          const int t = big ? j >> 6 : j >> 5, d = big ? j & 63 : j & 31;
          const float ex = big ? (float)(2 * d) / 128.0f : (float)(2 * d) / 64.0f;
          const float pw = (float)exp((double)ex * 9.21034037197618273607);
          const float inv = 1.0f / pw;
          const float ang = (float)t * inv;
          double s, c; dsincos((double)ang, s, c);
          if (big) { c128[j] = (float)c; s128[j] = (float)s; } else { c64[j] = (float)c; s64[j] = (float)s; } } }
    { constexpr int T_SQ = 256, T_GU = 512 / 32, T_DN = 64, U_IN = NIN / 32, U_Q = DM / 32, U_KV = 2 * DM / 32;
      constexpr int O1 = U_IN, O2 = O1 + U_Q, O3 = O2 + U_KV, O4 = O3 + T_SQ, O5 = O4 + T_SQ, O6 = O5 + 32 * T_GU, O7 = O6 + 32 * T_DN;
      float* SBIN = (float*)(F.ws + WS_SCL + SCL_SBIN); float* SBQKV = (float*)(F.ws + WS_SCL + SCL_SBQKV);
      for (int tile = F.bid; tile < O7; tile += F.G) {
          if (tile < O1) wq8_unit(F, a.in[1], nullptr, AIN, 1, (signed char*)(F.ws + WS_WAIN), SBIN, tile * 32);
          else if (tile < O2) wq8_unit(F, a.in[3], nullptr, DM, 0, (signed char*)(F.ws + WS_WBQKV), SBQKV, (tile - O1) * 32);
          else if (tile < O3) wq8_unit(F, a.in[4], nullptr, 2 * DM, 0, (signed char*)(F.ws + WS_WBQKV) + (size_t)DM * DM, SBQKV + DM, (tile - O2) * 32);
          else if (tile < O4) { const int t = tile - O3; tconv_tile(F, a.in[2], nullptr, DM, DM, (bf16_t*)(F.ws + WS_WAOUT), 0, (t & 15) * 64, (t >> 4) * 64); }
          else if (tile < O5) { const int t = tile - O4; tconv_tile(F, a.in[5], nullptr, DM, DM, (bf16_t*)(F.ws + WS_WBOUT), 0, (t & 15) * 64, (t >> 4) * 64); }
          else if (tile < O6) { const int t = tile - O5, le = t >> 4, tt = t & 15;
              wq8_unit(F, a.in[8] + (size_t)le * DM * FFE, a.in[9] + (size_t)le * DM * FFE, FFE, 2, (signed char*)(F.ws + WS_WGU) + (size_t)le * 512 * DM, (float*)(F.ws + WS_SCL + SCL_SBGU) + le * 512, tt * 32); }
          else { const int t = tile - O6, le = t >> 6, tt = t & 63;
              tconv_tile(F, a.in[10] + (size_t)le * FFE * DM, nullptr, DM, FFE, (bf16_t*)(F.ws + WS_WD) + (size_t)le * DM * FFE, 0, (tt & 3) * 64, (tt >> 2) * 64); }
      } }
}

constexpr int SCP = 2064;
DI unsigned ord_key(float v) { const unsigned b = __float_as_uint(v); return b ^ (((int)b >> 31) | 0x80000000u); }
DI unsigned popc64(u64 m) { return (unsigned)__builtin_popcountll(m); }

#define DPPF(x, ctrl) __uint_as_float(__builtin_amdgcn_update_dpp(0u, __float_as_uint(x), ctrl, 0xf, 0xf, true))
DI float dpp_wave_max(float v) {
    v = fmaxf(v, DPPF(v, 0xB1)); v = fmaxf(v, DPPF(v, 0x4E)); v = fmaxf(v, DPPF(v, 0x141)); v = fmaxf(v, DPPF(v, 0x140));
    const float r0 = __uint_as_float(__builtin_amdgcn_readlane(__float_as_uint(v), 0)), r1 = __uint_as_float(__builtin_amdgcn_readlane(__float_as_uint(v), 16));
    const float r2 = __uint_as_float(__builtin_amdgcn_readlane(__float_as_uint(v), 32)), r3 = __uint_as_float(__builtin_amdgcn_readlane(__float_as_uint(v), 48));
    return fmaxf(fmaxf(r0, r1), fmaxf(r2, r3));
}
DI float dpp_wave_max_f(float v) { return dpp_wave_max(v); }
DI float dpp_wave_min(float v) {
    v = fminf(v, DPPF(v, 0xB1)); v = fminf(v, DPPF(v, 0x4E)); v = fminf(v, DPPF(v, 0x141)); v = fminf(v, DPPF(v, 0x140));
    const float r0 = __uint_as_float(__builtin_amdgcn_readlane(__float_as_uint(v), 0)), r1 = __uint_as_float(__builtin_amdgcn_readlane(__float_as_uint(v), 16));
    const float r2 = __uint_as_float(__builtin_amdgcn_readlane(__float_as_uint(v), 32)), r3 = __uint_as_float(__builtin_amdgcn_readlane(__float_as_uint(v), 48));
    return fminf(fminf(r0, r1), fminf(r2, r3));
}
DI unsigned dpp_scan_add(unsigned v) {
    v += (unsigned)__builtin_amdgcn_update_dpp(0, (int)v, 0x111, 0xf, 0xf, false);
    v += (unsigned)__builtin_amdgcn_update_dpp(0, (int)v, 0x112, 0xf, 0xf, false);
    v += (unsigned)__builtin_amdgcn_update_dpp(0, (int)v, 0x114, 0xf, 0xf, false);
    v += (unsigned)__builtin_amdgcn_update_dpp(0, (int)v, 0x118, 0xf, 0xf, false);
    v += (unsigned)__builtin_amdgcn_update_dpp(0, (int)v, 0x142, 0xa, 0xf, false);
    v += (unsigned)__builtin_amdgcn_update_dpp(0, (int)v, 0x143, 0xc, 0xf, false);
    return v;
}
DI void select_topk(const LAS float* srow, int nj, LAS unsigned* hist, LAS unsigned* cand, LAS unsigned* ccnt, int lane, u64* mrow) {
    const LAS float* sp = srow + lane;
    float v[32];
#pragma unroll
    for (int g = 0; g < 4; ++g) { if (8 * g < nj) {
#pragma unroll
        for (int j = 8 * g; j < 8 * g + 8; ++j) v[j] = sp[j * 64]; } else {
#pragma unroll
        for (int j = 8 * g; j < 8 * g + 8; ++j) v[j] = -__builtin_inff(); } }
    int njv = nj; asm volatile("" : "+v"(njv));
#pragma unroll
    for (int j = 0; j < 32; ++j) v[j] = (j < njv) ? v[j] : -__builtin_inff();
    float vmx = v[0], vmn = v[0];
#pragma unroll
    for (int j = 1; j < 32; ++j) { vmx = fmaxf(vmx, v[j]); vmn = fminf(vmn, v[j] > -3.0e38f ? v[j] : vmn); }
    vmx = dpp_wave_max(vmx); vmn = dpp_wave_min(vmn);
    unsigned T = 0u, n_gt = 0u, n_ge = 0u;
    bool fast = false;
    if (vmx > vmn) {
        const float scale = 256.0f / (vmx - vmn);
        *(LAS u32x4*)(hist + 4 * lane) = (u32x4){0u, 0u, 0u, 0u};
        if (lane == 0) *ccnt = 0u;
        LDS_WAIT();
#pragma unroll
        for (int j = 0; j < 32; ++j) if (j < njv) { int b = (int)((v[j] - vmn) * scale); b = b > 255 ? 255 : b; __hip_atomic_fetch_add(hist + b, 1u, __ATOMIC_RELAXED, __HIP_MEMORY_SCOPE_WORKGROUP); }
        LDS_WAIT();
        const u32x4 h4 = *(const LAS u32x4*)(hist + 4 * (63 - lane));
        const unsigned c4 = h4.x + h4.y + h4.z + h4.w;
        const unsigned P = dpp_scan_add(c4);
        const u64 bal = __ballot(P >= (unsigned)TOPK);
        const int Ls = __builtin_ctzll(bal);
        const unsigned P_L = __builtin_amdgcn_readlane(P, Ls), c_L = __builtin_amdgcn_readlane(c4, Ls);
        const unsigned hb0 = __builtin_amdgcn_readlane(h4.x, Ls), hb1 = __builtin_amdgcn_readlane(h4.y, Ls), hb2 = __builtin_amdgcn_readlane(h4.z, Ls), hb3 = __builtin_amdgcn_readlane(h4.w, Ls);
        const int bin0 = 4 * (63 - Ls);
        unsigned cum = P_L - c_L; int bstar; unsigned mc;
        if (cum + hb3 >= (unsigned)TOPK) { bstar = bin0 + 3; mc = hb3; }
        else { cum += hb3; if (cum + hb2 >= (unsigned)TOPK) { bstar = bin0 + 2; mc = hb2; }
        else { cum += hb2; if (cum + hb1 >= (unsigned)TOPK) { bstar = bin0 + 1; mc = hb1; }
        else { cum += hb1; bstar = bin0; mc = hb0; } } }
        if (mc <= 256u) {
            fast = true;
            unsigned cbase = 0;
#pragma unroll
            for (int j = 0; j < 32; ++j) { int b = (int)((v[j] - vmn) * scale); b = b > 255 ? 255 : b;
                const u64 m = __ballot(b == bstar);
                if (m) { if (b == bstar) cand[(cbase + __builtin_amdgcn_mbcnt_hi((unsigned)(m >> 32), __builtin_amdgcn_mbcnt_lo((unsigned)m, 0u))) & 255u] = ord_key(v[j]); cbase += popc64(m); } }
            LDS_WAIT();
            const unsigned r = (unsigned)TOPK - cum;
            if (mc <= 64u) {
                const unsigned cu = ((unsigned)lane < mc) ? cand[lane] : 0u;
#pragma unroll 1
                for (int bit = 31; bit >= 0; --bit) { const unsigned ct = T | (1u << bit); if (popc64(__ballot(cu >= ct)) >= r) T = ct; }
                n_gt = cum + popc64(__ballot(cu > T)); n_ge = cum + popc64(__ballot(cu >= T));
            } else {
                unsigned cu[4];
#pragma unroll
                for (int ch = 0; ch < 4; ++ch) cu[ch] = ((unsigned)(lane + 64 * ch) < mc) ? cand[lane + 64 * ch] : 0u;
#pragma unroll 1
                for (int bit = 31; bit >= 0; --bit) { const unsigned ct = T | (1u << bit); unsigned cnt = 0;
#pragma unroll
                    for (int ch = 0; ch < 4; ++ch) cnt += popc64(__ballot(cu[ch] >= ct));
                    if (cnt >= r) T = ct; }
                unsigned cge = 0, cgt = 0;
#pragma unroll
                for (int ch = 0; ch < 4; ++ch) { cge += popc64(__ballot(cu[ch] >= T)); cgt += popc64(__ballot(cu[ch] > T)); }
                n_gt = cum + cgt; n_ge = cum + cge;
            }
        }
    }
    if (!fast) {
#pragma unroll 1
        for (int bit = 31; bit >= 0; --bit) { const unsigned ct = T | (1u << bit); unsigned cnt = 0;
#pragma unroll
            for (int j = 0; j < 32; ++j) cnt += popc64(__ballot(j < njv && ord_key(v[j]) >= ct));
            if (cnt >= (unsigned)TOPK) T = ct; }
        n_gt = 0; n_ge = 0;
#pragma unroll
        for (int j = 0; j < 32; ++j) { const unsigned u = ord_key(v[j]); n_ge += popc64(__ballot(j < njv && u >= T)); n_gt += popc64(__ballot(j < njv && u > T)); }
    }
    const unsigned mneed = (unsigned)TOPK - n_gt, n_eq = n_ge - n_gt;
    u64 myword = 0ull;
    if (n_eq == mneed) {
#pragma unroll
        for (int j = 0; j < 32; ++j) { const u64 w = __ballot(ord_key(v[j]) >= T); myword = (lane == j) ? w : myword; }
    } else {
        unsigned running = 0; const u64 ltmask = (1ull << lane) - 1ull;
#pragma unroll
        for (int j = 0; j < 32; ++j) { const unsigned u = ord_key(v[j]); const u64 eqm = __ballot(u == T); const unsigned pre = running + popc64(eqm & ltmask);
            const u64 w = __ballot(u > T || (u == T && pre < mneed)); running += popc64(eqm); myword = (lane == j) ? w : myword; }
    }
    if (lane < 32) mrow[lane] = myword;
}

DI void indexer_phase(const Frame& F) {
    const bf16_t* QI = (const bf16_t*)(F.ws + WS_HF + HF_QI); const bf16_t* KI = (const bf16_t*)(F.ws + WS_HF + HF_KI);
    const float* WI = (const float*)(F.ws + WS_HF + HF_WI); u64* MASK = (u64*)(F.ws + WS_HF + HF_MASK);
    LAS float* sc = (LAS float*)F.lds;
    LAS unsigned* hist = (LAS unsigned*)(F.lds + 16 * SCP * 4) + F.wave * 256;
    LAS unsigned* cand = (LAS unsigned*)(F.lds + 16 * SCP * 4 + 8192) + F.wave * 256;
    LAS unsigned* ccnt = (LAS unsigned*)(F.lds + 16 * SCP * 4 + 16384) + F.wave * 16;
    const int lane = F.lane, fr = lane & 15, fq = lane >> 4;
    constexpr int NITEM = NB * 32 * 4;
    bf16x8 qa[8][2]; f32x4 wq[4][2];
#define IDX_ITEM(i_, c_, b_, tok0_) const int L_##i_ = (i_) * F.G + (((i_) & 1) ? (F.G - 1 - F.bid) : F.bid); const int c_ = 31 - L_##i_ / 64, b_ = (L_##i_ % 64) >> 2, tok0_ = b_ * SEQ + c_ * 64 + ((L_##i_ % 64) & 3) * 16
#define IDX_LOADQ(tok0_) do { _Pragma("unroll") for (int h = 0; h < 8; ++h) _Pragma("unroll") for (int ks = 0; ks < 2; ++ks) qa[h][ks] = *(const bf16x8*)(QI + (size_t)((tok0_) + fr) * 512 + h * 64 + ks * 32 + fq * 8); \
        _Pragma("unroll") for (int j = 0; j < 4; ++j) { wq[j][0] = *(const f32x4*)(WI + (size_t)((tok0_) + 4 * fq + j) * 8); wq[j][1] = *(const f32x4*)(WI + (size_t)((tok0_) + 4 * fq + j) * 8 + 4); } } while (0)
    { IDX_ITEM(0, c0, b0, t0); (void)b0; if (F.bid < NITEM && c0 >= 4) IDX_LOADQ(t0); }
    for (int i = 0;; ++i) {
        const int L = i * F.G + ((i & 1) ? (F.G - 1 - F.bid) : F.bid); if (L >= NITEM) break;
        const int c = 31 - L / 64, rr = L % 64, b = rr >> 2, g4 = rr & 3;
        const int tok0 = b * SEQ + c * 64 + g4 * 16, nk = 64 * (c + 1);
        const int Ln = (i + 1) * F.G + (((i + 1) & 1) ? (F.G - 1 - F.bid) : F.bid);
        const int cn = 31 - Ln / 64, tokn = ((Ln % 64) >> 2) * SEQ + cn * 64 + ((Ln % 64) & 3) * 16; const bool pre = Ln < NITEM && cn >= 4;
        if (c >= 4) {
            const int ntile = nk / 16, ntw = (ntile - F.wave + 7) >> 3;
            const bf16_t* kbase = KI + (size_t)(b * SEQ + fr) * 64 + fq * 8;
            bf16x8 kA[4][2], kB[4][2];
#define IDX_LOAD(dst, i0) do { _Pragma("unroll") for (int u = 0; u < 4; ++u) { int i_ = (i0) + u; i_ = i_ < ntw ? i_ : ntw - 1; const bf16_t* kp = kbase + (size_t)(F.wave + 8 * i_) * 16 * 64; \
                dst[u][0] = *(const bf16x8*)kp; dst[u][1] = *(const bf16x8*)(kp + 32); } } while (0)
#define IDX_COMP(srcb, i0) do { _Pragma("unroll") for (int u = 0; u < 4; ++u) { const int i_ = (i0) + u; if (i_ < ntw) { const int kt = F.wave + 8 * i_; f32x4 s = {0.f, 0.f, 0.f, 0.f}; \
                _Pragma("unroll") for (int h = 0; h < 8; ++h) { f32x4 acc = {0.f, 0.f, 0.f, 0.f}; \
                    acc = __builtin_amdgcn_mfma_f32_16x16x32_bf16(qa[h][0], srcb[u][0], acc, 0, 0, 0); \
                    acc = __builtin_amdgcn_mfma_f32_16x16x32_bf16(qa[h][1], srcb[u][1], acc, 0, 0, 0); \
                    _Pragma("unroll") for (int j = 0; j < 4; ++j) s[j] += wq[j][h >> 2][h & 3] * fmaxf(acc[j], 0.f); } \
                _Pragma("unroll") for (int j = 0; j < 4; ++j) sc[(4 * fq + j) * SCP + kt * 16 + fr] = s[j]; } } } while (0)
            IDX_LOAD(kA, 0);
            for (int i0 = 0; i0 < ntw; i0 += 8) {
                IDX_LOAD(kB, i0 + 4);
                IDX_COMP(kA, i0);
                IDX_LOAD(kA, i0 + 8);
                IDX_COMP(kB, i0 + 4);
            }
#undef IDX_LOAD
#undef IDX_COMP
            __syncthreads();
            if (pre) IDX_LOADQ(tokn);
#pragma unroll 1
            for (int qq = 0; qq < 2; ++qq) { const int ql = 2 * F.wave + qq;
                select_topk(sc + ql * SCP, c + 1, hist, cand, ccnt, lane, MASK + (size_t)(tok0 + ql) * 32); }
            __syncthreads();
        } else {
            const int q = F.tid >> 5, w = F.tid & 31;
            MASK[(size_t)(tok0 + q) * 32 + w] = (w <= c) ? ~0ull : 0ull;
            if (pre) IDX_LOADQ(tokn);
        }
    }
#undef IDX_ITEM
#undef IDX_LOADQ
}

namespace att {
constexpr float SCALE = 0.08838834764831845f;
constexpr float THR = 8.f;
constexpr int NW = 8, QBLK = 32, KVBLK = 64, QB = NW * QBLK;
constexpr int SHM_V = KVBLK * HD * 2, SHM_K = KVBLK * HD * 2;
#define KSWZ(row, colB) ((row) * 256 + ((colB) ^ (((row) & 7) << 4)))
#define SBAR() __builtin_amdgcn_sched_barrier(0)
DI int v_st(int k, int c) { const int kk = (k & ~0xC) | ((k & 4) << 1) | ((k & 8) >> 1); return ((kk >> 3) * 4 + (c >> 5)) * 512 + ((kk & 7) * 32 + (c & 31)) * 2; }
DI int v_rd_base(int lane) { return ((lane & 3) << 3) | (((lane >> 2) & 3) << 6) | (((lane >> 4) & 1) << 5) | (((lane >> 5) & 1) << 8); }
constexpr int v_rd_off(int d0, int ks, int half) { return d0 * 512 + ks * 4096 + half * 2048; }
DI int crow(int r, int hi) { return (r & 3) + 8 * (r >> 2) + 4 * hi; }

DI void partialSM(f32x16& p0, f32x16& p1, float& m_reg, float& mn, float& alpha) {
    float pmax = p0[0];
#pragma unroll
    for (int r = 1; r < 16; ++r) pmax = fmaxf(pmax, p0[r]);
#pragma unroll
    for (int r = 0; r < 16; ++r) pmax = fmaxf(pmax, p1[r]);
    { auto rr = __builtin_amdgcn_permlane32_swap(__float_as_uint(pmax), __float_as_uint(pmax), false, false);
      pmax = fmaxf(__uint_as_float(rr[0]), __uint_as_float(rr[1])); }
    constexpr float C2 = 1.4426950408889634f * SCALE;
    if (__builtin_expect(__all((pmax - m_reg) * SCALE <= THR), 1)) { mn = m_reg; alpha = 1.f; }
    else { mn = fmaxf(m_reg, pmax); alpha = __builtin_amdgcn_exp2f((m_reg - mn) * C2); m_reg = mn; }
    const float mnL = -mn * C2;
#pragma unroll
    for (int r = 0; r < 16; ++r) p0[r] = fmaf(p0[r], C2, mnL);
#pragma unroll
    for (int r = 0; r < 16; ++r) p1[r] = fmaf(p1[r], C2, mnL);
#pragma unroll
    for (int r = 0; r < 16; ++r) p0[r] = __builtin_amdgcn_exp2f(p0[r]);
}
#define PK4(P, B_, OUT) do { unsigned a0 = cvt_pk_bf16(P[B_+0], P[B_+1]), a1 = cvt_pk_bf16(P[B_+2], P[B_+3]);                          \
        unsigned b0 = cvt_pk_bf16(P[B_+4], P[B_+5]), b1 = cvt_pk_bf16(P[B_+6], P[B_+7]);                                             \
        auto r0 = __builtin_amdgcn_permlane32_swap(a0, b0, false, false); auto r1 = __builtin_amdgcn_permlane32_swap(a1, b1, false, false); \
        u32x4 w = {r0[0], r1[0], r0[1], r1[1]}; OUT = *reinterpret_cast<bf16x8*>(&w); } while (0)
DI void finishSM(f32x16& p0, f32x16& p1, float alpha, float& l_reg, bf16x8& pa0, bf16x8& pa1, bf16x8& pa2, bf16x8& pa3) {
#pragma unroll
    for (int r = 0; r < 16; ++r) p1[r] = __builtin_amdgcn_exp2f(p1[r]);
    float ps = 0;
#pragma unroll
    for (int r = 0; r < 16; ++r) ps += p0[r];
#pragma unroll
    for (int r = 0; r < 16; ++r) ps += p1[r];
    { auto rr = __builtin_amdgcn_permlane32_swap(__float_as_uint(ps), __float_as_uint(ps), false, false);
      ps = __uint_as_float(rr[0]) + __uint_as_float(rr[1]); }
    l_reg = l_reg * alpha + ps;
    PK4(p0, 0, pa0); PK4(p0, 8, pa1); PK4(p1, 0, pa2); PK4(p1, 8, pa3);
}
DI void packP(const f32x16& p0, const f32x16& p1, bf16x8& pa0, bf16x8& pa1, bf16x8& pa2, bf16x8& pa3) {
    PK4(p0, 0, pa0); PK4(p0, 8, pa1); PK4(p1, 0, pa2); PK4(p1, 8, pa3);
}
template <int KB>
DI void qkt(f32x16& p0, f32x16& p1, const LAS char* K_lds, int r32, int hi, const bf16x8* qr) {
    p0 = f32x16{}; p1 = f32x16{};
    const LAS char* kb[4];
#pragma unroll
    for (int dd = 0; dd < 4; ++dd) kb[dd] = K_lds + KB * SHM_K + KSWZ(r32, (dd * 16 + hi * 8) * 2);
#pragma unroll
    for (int d0 = 0; d0 < 8; ++d0) { const LAS char* a = kb[d0 & 3] + (d0 >> 2) * 128;
        bf16x8 b0 = *reinterpret_cast<const LAS bf16x8*>(a);
        bf16x8 b1 = *reinterpret_cast<const LAS bf16x8*>(a + 32 * 256);
        p0 = __builtin_amdgcn_mfma_f32_32x32x16_bf16(b0, qr[d0], p0, 0, 0, 0);
        p1 = __builtin_amdgcn_mfma_f32_32x32x16_bf16(b1, qr[d0], p1, 0, 0, 0); }
}
template <int VB>
DI void pv_tile(f32x16* o, int vb0, bf16x8 pa0, bf16x8 pa1, bf16x8 pa2, bf16x8 pa3) {
#define TRRD(dst, off) asm volatile("ds_read_b64_tr_b16 %0, %1 offset:%2" : "=&v"(dst) : "v"(vb0), "i"(off) : "memory")
#define PV_D0(d0) do { s16x4 l0, l1, l2, l3, h0, h1, h2, h3; constexpr int b_ = VB * SHM_V + v_rd_off(d0, 0, 0);   \
        TRRD(l0, b_); TRRD(h0, b_ + 2048); TRRD(l1, b_ + 4096); TRRD(h1, b_ + 6144); TRRD(l2, b_ + 8192); TRRD(h2, b_ + 10240); TRRD(l3, b_ + 12288); TRRD(h3, b_ + 14336); \
        asm volatile("s_waitcnt lgkmcnt(0)" ::: "memory"); SBAR();   \
        o[d0] = __builtin_amdgcn_mfma_f32_32x32x16_bf16(pa0, (bf16x8){l0[0], l0[1], l0[2], l0[3], h0[0], h0[1], h0[2], h0[3]}, o[d0], 0, 0, 0);   \
        o[d0] = __builtin_amdgcn_mfma_f32_32x32x16_bf16(pa1, (bf16x8){l1[0], l1[1], l1[2], l1[3], h1[0], h1[1], h1[2], h1[3]}, o[d0], 0, 0, 0);   \
        o[d0] = __builtin_amdgcn_mfma_f32_32x32x16_bf16(pa2, (bf16x8){l2[0], l2[1], l2[2], l2[3], h2[0], h2[1], h2[2], h2[3]}, o[d0], 0, 0, 0);   \
        o[d0] = __builtin_amdgcn_mfma_f32_32x32x16_bf16(pa3, (bf16x8){l3[0], l3[1], l3[2], l3[3], h3[0], h3[1], h3[2], h3[3]}, o[d0], 0, 0, 0); } while (0)
    PV_D0(0); PV_D0(1); PV_D0(2); PV_D0(3);
#undef PV_D0
#undef TRRD
}
struct Stage { bf16x8 k0, k1, v0, v1; };
DI void sload(Stage& s, const bf16_t* Kp, const bf16_t* Vp, size_t tokbase, int k0, int sr, int hcol) {
    const size_t o0 = (tokbase + k0 + sr) * DM + hcol, o1 = o0 + (size_t)32 * DM;
    s.v0 = *(const bf16x8*)(Vp + o0); s.v1 = *(const bf16x8*)(Vp + o1); s.k0 = *(const bf16x8*)(Kp + o0); s.k1 = *(const bf16x8*)(Kp + o1);
}
DI void swrite(const Stage& s, LAS char* V_lds, LAS char* K_lds, int bf, int kws, int vst0, int vst1) {
    *(LAS bf16x8*)(V_lds + bf * SHM_V + vst0) = s.v0; *(LAS bf16x8*)(V_lds + bf * SHM_V + vst1) = s.v1;
    *(LAS bf16x8*)(K_lds + bf * SHM_K + kws) = s.k0; *(LAS bf16x8*)(K_lds + bf * SHM_K + kws + 32 * 256) = s.k1;
}
DI void store_o(const f32x16* o, const float* rli, bf16_t* Ow, int r32, int hi) {
#pragma unroll
    for (int r = 0; r < 16; ++r) { const int orow = crow(r, hi);
#pragma unroll
        for (int d0 = 0; d0 < 4; ++d0) { const float v = o[d0][r] * rli[r]; const float vn = __shfl_xor(v, 1);
            if ((r32 & 1) == 0) *(unsigned*)(Ow + (size_t)orow * DM + d0 * 32 + r32) = cvt_pk_bf16(v, vn); } }
}

DI void attnA_phase(const Frame& F) {
    const bf16_t* Q = (const bf16_t*)(F.ws + WS_R1); const bf16_t* Kt = Q + (size_t)NTOK * DM; const bf16_t* Vt = Kt + (size_t)NTOK * DM;
    bf16_t* O = (bf16_t*)(F.ws + WS_HF + 64 * MiB); const u64* MASK = (const u64*)(F.ws + WS_HF + HF_MASK);
    LAS char* V_lds = (LAS char*)F.lds; LAS char* K_lds = V_lds + 2 * SHM_V;
    const int tid = F.tid, wid = F.wave, lane = F.lane, r32 = lane & 31, hi = lane >> 5;
    LAS float* wsl = (LAS float*)(F.lds + 2 * SHM_V + 2 * SHM_K) + wid * 64; LAS float* li_l = wsl; LAS float* al_l = wsl + 32;
    const int sr = tid >> 4, sc = (tid & 15) * 8, vst0 = v_st(sr, sc), vst1 = v_st(32 + sr, sc), kws = KSWZ(sr, sc * 2);
    const int vb0 = (int)(uintptr_t)V_lds + v_rd_base(lane);
    constexpr int NITEM = NB * NH * 8;
    for (int it = F.bid; it < NITEM; it += F.G) {
        int bh, qb;
        if (F.G == 256) { const int pass = it >> 8, xcd = F.bid & 7, slot = F.bid >> 3, grp = slot >> 3, mem = slot & 7; bh = (pass * 4 + grp) * 8 + xcd; qb = (pass & 1) ? 7 - mem : mem; }
        else { bh = it >> 3; qb = it & 7; }
        const int b = bh >> 3, h = bh & 7, q0 = qb * QB, NT = 4 * (qb + 1);
        const size_t tokbase = (size_t)b * SEQ; const int hcol = h * HD + sc;
        const int qrow = q0 + wid * QBLK + r32, myc = (q0 + wid * QBLK) >> 6;
        bf16x8 qr[8];
#pragma unroll
        for (int d0 = 0; d0 < 8; ++d0) qr[d0] = *(const bf16x8*)(Q + (tokbase + qrow) * DM + h * HD + d0 * 16 + hi * 8);
        const u64* mrow = MASK + (tokbase + qrow) * 32;
        float m_reg = -1e30f, l_reg = 0.f; f32x16 o[4] = {};
        Stage st; sload(st, Kt, Vt, tokbase, 0, sr, hcol);
        u64 mw = mrow[0], mwn = mrow[1];
        asm volatile("s_waitcnt vmcnt(0)" ::: "memory");
        swrite(st, V_lds, K_lds, 0, kws, vst0, vst1);
        __syncthreads();
        f32x16 pA0, pA1, pB0, pB1; float mnA, mnB, alA = 1.f, alB = 1.f; bf16x8 pa0, pa1, pa2, pa3;
#define A_MASK(P0, P1) do { const unsigned mlo = (unsigned)mw >> (4 * hi), mhi = (unsigned)(mw >> 32) >> (4 * hi);      \
            _Pragma("unroll") for (int r = 0; r < 16; ++r) { const int cr = (r & 3) + 8 * (r >> 2);                 \
                const unsigned s0 = (unsigned)(-(int)((mlo >> cr) & 1u)), s1 = (unsigned)(-(int)((mhi >> cr) & 1u)); \
                P0[r] = __uint_as_float((__float_as_uint(P0[r]) & s0) | (0xFF800000u & ~s0));                        \
                P1[r] = __uint_as_float((__float_as_uint(P1[r]) & s1) | (0xFF800000u & ~s1)); } } while (0)
#define A_RESC(a) do { if (__any((a) < 1.f)) { if (hi == 0) al_l[r32] = (a); LDS_WAIT();                              \
                _Pragma("unroll") for (int d_ = 0; d_ < 4; ++d_) _Pragma("unroll") for (int r = 0; r < 16; ++r) o[d_][r] *= al_l[crow(r, hi)]; } } while (0)
        sload(st, Kt, Vt, tokbase, KVBLK, sr, hcol);
        qkt<0>(pA0, pA1, K_lds, r32, hi, qr);
        A_MASK(pA0, pA1); partialSM(pA0, pA1, m_reg, mnA, alA);
        asm volatile("s_waitcnt vmcnt(0)" ::: "memory"); swrite(st, V_lds, K_lds, 1, kws, vst0, vst1); mw = mwn;
        __syncthreads();
#define A_HALF(PX0, PX1, mnX, alX, PY0, PY1, alY, t, KB, VB, SB) do { const bool actT = (t) <= myc, actP = (t) - 1 <= myc, more = (t) + 1 < NT; \
        if (more) mwn = mrow[(t) + 1];                                                                              \
        SBAR(); if (actT) qkt<KB>(PX0, PX1, K_lds, r32, hi, qr);                                                    \
        if (actP) { finishSM(PY0, PY1, alY, l_reg, pa0, pa1, pa2, pa3); } SBAR();                                   \
        if (more) sload(st, Kt, Vt, tokbase, ((t) + 1) * KVBLK, sr, hcol);                                          \
        SBAR(); if (actP) pv_tile<VB>(o, vb0, pa0, pa1, pa2, pa3);                                                  \
        if (actT) { A_MASK(PX0, PX1); partialSM(PX0, PX1, m_reg, mnX, alX); }                                       \
        __syncthreads();                                                                                            \
        if (more) { asm volatile("s_waitcnt vmcnt(0)" ::: "memory"); swrite(st, V_lds, K_lds, SB, kws, vst0, vst1); } \
        mw = mwn;                                                                                                   \
        if (actT) A_RESC(alX);                                                                                      \
        __syncthreads(); } while (0)
        for (int t = 1; t + 1 < NT; t += 2) {
            A_HALF(pB0, pB1, mnB, alB, pA0, pA1, alA, t, 1, 0, 0);
            A_HALF(pA0, pA1, mnA, alA, pB0, pB1, alB, t + 1, 0, 1, 1);
        }
        { const bool actT = NT - 1 <= myc, actP = NT - 2 <= myc;
          SBAR(); if (actT) qkt<1>(pB0, pB1, K_lds, r32, hi, qr);
          if (actP) { finishSM(pA0, pA1, alA, l_reg, pa0, pa1, pa2, pa3); SBAR(); pv_tile<0>(o, vb0, pa0, pa1, pa2, pa3); }
          if (actT) { A_MASK(pB0, pB1); partialSM(pB0, pB1, m_reg, mnB, alB); A_RESC(alB);
                      finishSM(pB0, pB1, alB, l_reg, pa0, pa1, pa2, pa3); SBAR(); pv_tile<1>(o, vb0, pa0, pa1, pa2, pa3); } }
#undef A_HALF
#undef A_MASK
#undef A_RESC
        if (hi == 0) li_l[r32] = l_reg; LDS_WAIT();
        float rli[16];
#pragma unroll
        for (int r = 0; r < 16; ++r) rli[r] = __builtin_amdgcn_rcpf(li_l[crow(r, hi)]);
        store_o(o, rli, O + (tokbase + q0 + wid * QBLK) * DM + h * HD, r32, hi);
        __syncthreads();
    }
}

DI void attnB_phase(const Frame& F) {
    const bf16_t* Q = (const bf16_t*)(F.ws + WS_R1); const bf16_t* Kt = Q + (size_t)NTOK * DM; const bf16_t* Vt = Kt + (size_t)NTOK * DM;
    bf16_t* O = (bf16_t*)(F.ws + WS_HF + 64 * MiB);
    LAS char* V_lds = (LAS char*)F.lds; LAS char* K_lds = V_lds + 3 * SHM_V;
    const int tid = F.tid, wid = F.wave, lane = F.lane, r32 = lane & 31, hi = lane >> 5;
    LAS int* flags = (LAS int*)(F.lds + 3 * SHM_V + 3 * SHM_K);
    const int vb0 = (int)(uintptr_t)V_lds + v_rd_base(lane);
    unsigned offK[2], offV[2];
#pragma unroll
    for (int i = 0; i < 2; ++i) { const int p = i * 512 + wid * 64 + lane;
        { const int row = p >> 4, ch = (p & 15) ^ (row & 7); offK[i] = (unsigned)(row * DM + ch * 8) * 2u; }
        { const int sub = p >> 5, kk = (sub >> 2) * 8 + ((p & 31) >> 2), col = (sub & 3) * 32 + (p & 3) * 8, k = (kk & ~0xC) | ((kk & 4) << 1) | ((kk & 8) >> 1); offV[i] = (unsigned)(k * DM + col) * 2u; } }
    const unsigned ldsw = (unsigned)wid * 1024u;
    constexpr float C2 = 1.4426950408889634f * SCALE;
    constexpr int NITEM = NB * NH * 8;
    for (int it = F.bid; it < NITEM; it += F.G) {
        int bh, qb;
        if (F.G == 256) { const int pass = it >> 8, xcd = F.bid & 7, slot = F.bid >> 3, grp = slot >> 3, mem = slot & 7; bh = (pass * 4 + grp) * 8 + xcd; qb = (pass & 1) ? 7 - mem : mem; }
        else { bh = it >> 3; qb = it & 7; }
        const int b = bh >> 3, h = bh & 7, q0 = qb * QB;
        const size_t tokbase = (size_t)b * SEQ;
        const int qw0 = q0 + wid * QBLK, qrow = qw0 + r32, t_hi = 4 * (qb + 1) - 1, t_w = (qw0 + QBLK - 1) >> 6;
        const char* Kb = (const char*)(Kt + tokbase * DM + h * HD); const char* Vb = (const char*)(Vt + tokbase * DM + h * HD);
        bf16x8 qr[8];
#pragma unroll
        for (int d0 = 0; d0 < 8; ++d0) qr[d0] = *(const bf16x8*)(Q + (tokbase + qrow) * DM + h * HD + d0 * 16 + hi * 8);
        float carry = 1.f; int done_w = 0; f32x16 o[4] = {};
#define B_DMA(t_, SLOT) do { const size_t tb_ = (size_t)(t_) * KVBLK * DM * 2; _Pragma("unroll") for (int i = 0; i < 2; ++i) { \
            __builtin_amdgcn_global_load_lds((const unsigned*)(Kb + tb_ + offK[i]), (LAS unsigned*)(K_lds + (SLOT) * SHM_K + ldsw + i * 8192), 16, 0, 0); \
            __builtin_amdgcn_global_load_lds((const unsigned*)(Vb + tb_ + offV[i]), (LAS unsigned*)(V_lds + (SLOT) * SHM_V + ldsw + i * 8192), 16, 0, 0); } } while (0)
        asm volatile("s_waitcnt vmcnt(0)" ::: "memory");
        B_DMA(t_hi, 0); B_DMA(t_hi - 1, 1);
        asm volatile("s_waitcnt vmcnt(4)" ::: "memory");
        __builtin_amdgcn_s_barrier(); asm volatile("" ::: "memory");
        bool stop = false;
#define B_STEP(itn, SLOT, SLOTW) do { const int t = t_hi - (itn); const bool more = t > 0, more2 = t > 1;              \
        if (more2) B_DMA(t - 2, SLOTW);                                                                             \
        if (t <= t_w && !done_w) { f32x16 p0, p1, l0v, l1v; bf16x8 pa0, pa1, pa2, pa3;                               \
            qkt<SLOT>(p0, p1, K_lds, r32, hi, qr);                                                                  \
            const int dq = qrow - t * KVBLK - 4 * hi;                                                               \
              \
            _Pragma("unroll") for (int r = 0; r < 16; ++r) { const int cr = (r & 3) + 8 * (r >> 2);                 \
                const float e0 = __builtin_amdgcn_exp2f(-fmaxf(p0[r] * C2, -100.f)), e1 = __builtin_amdgcn_exp2f(-fmaxf(p1[r] * C2, -100.f)); \
                const float g0 = __builtin_amdgcn_rcpf(1.0f + e0), g1 = __builtin_amdgcn_rcpf(1.0f + e1);         \
                const bool v0 = cr < dq, v1 = cr + 32 < dq;                                                         \
                p0[r] = v0 ? g0 : 0.f; p1[r] = v1 ? g1 : 0.f;                                                       \
                l0v[r] = v0 ? e0 * g0 : 1.f; l1v[r] = v1 ? e1 * g1 : 1.f; }                                         \
            float gs[8];                                                                                            \
            _Pragma("unroll") for (int g = 0; g < 4; ++g) { gs[g] = (l0v[4 * g] * l0v[4 * g + 1]) * (l0v[4 * g + 2] * l0v[4 * g + 3]); \
                                                            gs[4 + g] = (l1v[4 * g] * l1v[4 * g + 1]) * (l1v[4 * g + 2] * l1v[4 * g + 3]); } \
            float acc = carry;                                                                                      \
            _Pragma("unroll") for (int g = 7; g >= 0; --g) {                                                        \
                auto rr = __builtin_amdgcn_permlane32_swap(__float_as_uint(gs[g]), __float_as_uint(gs[g]), false, false); \
                const float slo = __uint_as_float(rr[0]), shi = __uint_as_float(rr[1]);                             \
                float run = acc * (hi ? 1.f : shi);                                                                 \
                _Pragma("unroll") for (int j = 3; j >= 0; --j) { const int r = 4 * (g & 3) + j;                     \
                    if (g >= 4) { const float a_ = p1[r] * run; run *= l1v[r]; p1[r] = a_; }                        \
                    else        { const float a_ = p0[r] * run; run *= l0v[r]; p0[r] = a_; } }                      \
                acc *= slo * shi; }                                                                                 \
            carry = acc;                                                                                            \
            packP(p0, p1, pa0, pa1, pa2, pa3); SBAR();                                                              \
            pv_tile<SLOT>(o, vb0, pa0, pa1, pa2, pa3);                                                              \
            done_w = __all(carry < 1.0e-37f) ? 1 : 0; }                                                                     \
        if (lane == 0) flags[((itn) & 1) * 8 + wid] = done_w;                                                       \
        if (more2) asm volatile("s_waitcnt vmcnt(4)" ::: "memory"); else asm volatile("s_waitcnt vmcnt(0)" ::: "memory");     \
        LDS_WAIT(); __builtin_amdgcn_s_barrier(); asm volatile("" ::: "memory");                                    \
        { int alld = 1; _Pragma("unroll") for (int w = 0; w < 8; ++w) alld &= flags[((itn) & 1) * 8 + w]; stop = (alld != 0) || !more; } } while (0)
        for (int itn = 0;; itn += 3) { B_STEP(itn, 0, 2); if (stop) break; B_STEP(itn + 1, 1, 0); if (stop) break; B_STEP(itn + 2, 2, 1); if (stop) break; }
#undef B_STEP
#undef B_DMA
        asm volatile("s_waitcnt vmcnt(0)" ::: "memory");
        float rli[16];
#pragma unroll
        for (int r = 0; r < 16; ++r) rli[r] = 1.0f;
        store_o(o, rli, O + (tokbase + qw0) * DM + h * HD, r32, hi);
        __syncthreads();
    }
}
#undef PK4
}

DI void route16(const float (&lg)[16], const float (&bias)[16], int& e0, int& e1, float& w0, float& w1) {
    float mx = lg[0];
#pragma unroll
    for (int i = 1; i < 16; ++i) mx = fmaxf(mx, lg[i]);
    float pr[16], sum = 0.f;
#pragma unroll
    for (int i = 0; i < 16; ++i) { pr[i] = __builtin_amdgcn_exp2f((lg[i] - mx) * 1.4426950408889634f); sum += pr[i]; }
    float sel[16];
#pragma unroll
    for (int i = 0; i < 16; ++i) { pr[i] = pr[i] / sum; sel[i] = pr[i] + bias[i]; }
    float gsc[4];
#pragma unroll
    for (int g = 0; g < 4; ++g) { const float a = sel[4 * g], b = sel[4 * g + 1], c = sel[4 * g + 2], d = sel[4 * g + 3];
        gsc[g] = fmaxf(fmaxf(fmaxf(a + b, a + c), fmaxf(a + d, b + c)), fmaxf(b + d, c + d)); }
    int g = 0; float best = gsc[0];
#pragma unroll
    for (int i = 1; i < 4; ++i) if (gsc[i] > best) { best = gsc[i]; g = i; }
    float xs[4], ps[4];
#pragma unroll
    for (int j = 0; j < 4; ++j) { xs[j] = (g == 0) ? sel[j] : (g == 1) ? sel[4 + j] : (g == 2) ? sel[8 + j] : sel[12 + j];
                                  ps[j] = (g == 0) ? pr[j] : (g == 1) ? pr[4 + j] : (g == 2) ? pr[8 + j] : pr[12 + j]; }
    int i1 = 0; float b1 = xs[0];
#pragma unroll
    for (int j = 1; j < 4; ++j) if (xs[j] > b1) { b1 = xs[j]; i1 = j; }
    int i2 = -1; float b2 = -__builtin_inff();
#pragma unroll
    for (int j = 0; j < 4; ++j) if (j != i1 && (i2 < 0 || xs[j] > b2)) { b2 = xs[j]; i2 = j; }
    const float p1 = (i1 == 0) ? ps[0] : (i1 == 1) ? ps[1] : (i1 == 2) ? ps[2] : ps[3];
    const float p2 = (i2 == 0) ? ps[0] : (i2 == 1) ? ps[1] : (i2 == 2) ? ps[2] : ps[3];
    const float s = p1 + p2;
    e0 = 4 * g + i1; e1 = 4 * g + i2; w0 = p1 / s; w1 = p2 / s;
}

DI f32x4 bf4(u32x2 a) { f32x4 r; r[0] = __uint_as_float(a.x << 16); r[1] = __uint_as_float(a.x & 0xFFFF0000u); r[2] = __uint_as_float(a.y << 16); r[3] = __uint_as_float(a.y & 0xFFFF0000u); return r; }
struct LnRow { f32x4 hp[4]; u32x2 hb[4], ya[4], yb[4]; };
template <bool HPF, int NADD>
DI void ln_load(LnRow& R, size_t row, int lane, const void* hprev, const bf16_t* y0, const bf16_t* y1) {
#pragma unroll
    for (int i = 0; i < 4; ++i) { const size_t off = row * DM + 4 * lane + 256 * i;
        if (HPF) R.hp[i] = *(const f32x4*)((const float*)hprev + off); else R.hb[i] = *(const u32x2*)((const bf16_t*)hprev + off);
        R.ya[i] = *(const u32x2*)(y0 + off);
        if (NADD == 2) R.yb[i] = *(const u32x2*)(y1 + off); }
}
template <bool HPF, int NADD, bool OUTF>
DI void ln_row(LnRow& R, f32x4 (&v)[4], size_t row, int lane, const f32x4 (&g4)[4], const f32x4 (&b4)[4], void* out, signed char* out8, float* sc8) {
#pragma unroll
    for (int i = 0; i < 4; ++i) { f32x4 ad = bf4(R.ya[i]); if (NADD == 2) ad = ad + bf4(R.yb[i]);
        const f32x4 hp = HPF ? R.hp[i] : bf4(R.hb[i]);
        v[i] = hp * DN_ALPHA + ad; }
    float s = 0.f;
#pragma unroll
    for (int i = 0; i < 4; ++i) s += (v[i][0] + v[i][1]) + (v[i][2] + v[i][3]);
    const float mean = wave_sum(s) * (1.0f / DM);
    float q = 0.f;
#pragma unroll
    for (int i = 0; i < 4; ++i) { v[i] = v[i] - mean; q += (v[i][0] * v[i][0] + v[i][1] * v[i][1]) + (v[i][2] * v[i][2] + v[i][3] * v[i][3]); }
    const float rstd = __builtin_amdgcn_rsqf(wave_sum(q) * (1.0f / DM) + LN_EPS);
#pragma unroll
    for (int i = 0; i < 4; ++i) { v[i] = v[i] * rstd * g4[i] + b4[i]; const size_t off = row * DM + 4 * lane + 256 * i;
        if (OUTF) *(f32x4*)((float*)out + off) = v[i];
        else { u32x2 w; w.x = cvt_pk_bf16(v[i][0], v[i][1]); w.y = cvt_pk_bf16(v[i][2], v[i][3]); *(u32x2*)((bf16_t*)out + off) = w; } }
    if (out8) quant_row(v, lane, out8 + row * DM, sc8 + row);
}
DI float tr_reduce16(float (&pe)[16], int lane) {
    float r8[8], r4[4], r2[2], r1;
#pragma unroll
    for (int k = 0; k < 8; ++k) { const bool od = lane & 1; const float keep = od ? pe[2 * k + 1] : pe[2 * k], send = od ? pe[2 * k] : pe[2 * k + 1]; r8[k] = keep + __shfl_xor(send, 1); }
#pragma unroll
    for (int k = 0; k < 4; ++k) { const bool od = lane & 2; const float keep = od ? r8[2 * k + 1] : r8[2 * k], send = od ? r8[2 * k] : r8[2 * k + 1]; r4[k] = keep + __shfl_xor(send, 2); }
#pragma unroll
    for (int k = 0; k < 2; ++k) { const bool od = lane & 4; const float keep = od ? r4[2 * k + 1] : r4[2 * k], send = od ? r4[2 * k] : r4[2 * k + 1]; r2[k] = keep + __shfl_xor(send, 4); }
    { const bool od = lane & 8; const float keep = od ? r2[1] : r2[0], send = od ? r2[0] : r2[1]; r1 = keep + __shfl_xor(send, 8); }
    r1 += __shfl_xor(r1, 16); r1 += __shfl_xor(r1, 32);
    return r1;
}
DI void router_rows2(const f32x4 (&va)[4], const f32x4 (&vb)[4], const LAS float* wrT, int lane, float& la, float& lb) {
    float pa[16], pb[16];
#pragma unroll
    for (int e = 0; e < 16; ++e) { float a = 0.f, b = 0.f;
#pragma unroll
        for (int i = 0; i < 4; ++i) { const f32x4 w = *(const LAS f32x4*)(wrT + e * DM + 4 * lane + 256 * i);
            a += (va[i][0] * w[0] + va[i][1] * w[1]) + (va[i][2] * w[2] + va[i][3] * w[3]);
            b += (vb[i][0] * w[0] + vb[i][1] * w[1]) + (vb[i][2] * w[2] + vb[i][3] * w[3]); }
        pa[e] = a; pb[e] = b; }
    la = tr_reduce16(pa, lane); lb = tr_reduce16(pb, lane);
}
template <bool HPF, int NADD, bool OUTF, bool ROUTER>
DI void ln_phase(const Frame& F, const void* hprev, const bf16_t* y0, const bf16_t* y1, const float* gam, const float* bet, void* out,
                 const float* router_w, const float* router_b, unsigned* cnt, int* list, float* gatew, signed char* out8 = nullptr, float* sc8 = nullptr) {
    LAS float* wrT = (LAS float*)F.lds;
    LAS float* lsc = (LAS float*)(F.lds + 16 * DM * 4) + F.wave * 272;
    float rb[16];
    if (ROUTER) {
        for (int idx = F.tid; idx < 16 * DM; idx += 512) { const int e = idx >> 10, c = idx & 1023; wrT[idx] = router_w[c * 16 + e]; }
#pragma unroll
        for (int e = 0; e < 16; ++e) rb[e] = router_b[e];
        __syncthreads();
    }
    const int lane = F.lane;
    f32x4 g4[4], b4[4];
#pragma unroll
    for (int i = 0; i < 4; ++i) { g4[i] = *(const f32x4*)(gam + 4 * lane + 256 * i); b4[i] = *(const f32x4*)(bet + 4 * lane + 256 * i); }
    for (int c0 = F.bid * 8; c0 < NTOK / 16; c0 += F.G * 8) {
        const int chunk = c0 + F.wave; const bool cvalid = chunk < NTOK / 16;
        const size_t row0 = (size_t)(cvalid ? chunk : 0) * 16;
        if (cvalid) {
            LnRow RA, RB; f32x4 va[4], vb[4];
            ln_load<HPF, NADD>(RA, row0, lane, hprev, y0, y1);
#pragma unroll 1
            for (int ri = 0; ri < 16; ri += 2) {
                ln_load<HPF, NADD>(RB, row0 + ri + 1, lane, hprev, y0, y1);
                ln_row<HPF, NADD, OUTF>(RA, va, row0 + ri, lane, g4, b4, out, out8, sc8);
                if (ri + 2 < 16) ln_load<HPF, NADD>(RA, row0 + ri + 2, lane, hprev, y0, y1);
                ln_row<HPF, NADD, OUTF>(RB, vb, row0 + ri + 1, lane, g4, b4, out, out8, sc8);
                if (ROUTER) { float la, lb; router_rows2(va, vb, wrT, lane, la, lb); if (lane < 16) { lsc[ri * 17 + lane] = la; lsc[(ri + 1) * 17 + lane] = lb; } }
            }
        }
        if (ROUTER) {
            LDS_WAIT();
            float lg[16];
#pragma unroll
            for (int e = 0; e < 16; ++e) lg[e] = lsc[(lane & 15) * 17 + e];
            LDS_WAIT();
            int my_e0, my_e1; float my_w0, my_w1; route16(lg, rb, my_e0, my_e1, my_w0, my_w1);
            const size_t row = row0 + lane; const bool act = lane < 16 && cvalid;
            const u64 ltmask = (1ull << lane) - 1ull;
            LAS unsigned* wcnt = (LAS unsigned*)(F.lds + 16 * DM * 4 + 8 * 272 * 4);
            LAS unsigned* wbase = wcnt + 128;
            unsigned mycnt = 0;
#pragma unroll
            for (int e = 0; e < NEXP; ++e) { const unsigned n = popc64(__ballot(act && my_e0 == e)) + popc64(__ballot(act && my_e1 == e)); mycnt = (lane == e) ? n : mycnt; }
            if (lane < 16) wcnt[F.wave * 16 + lane] = mycnt;
            __syncthreads();
            if (F.wave == 0 && lane < 16) { unsigned tot = 0, pre[8];
#pragma unroll
                for (int w = 0; w < 8; ++w) { pre[w] = tot; tot += wcnt[w * 16 + lane]; }
                const unsigned base = tot ? atomicAdd(cnt + 64 * lane, tot) : 0u;
#pragma unroll
                for (int w = 0; w < 8; ++w) wbase[w * 16 + lane] = base + pre[w]; }
            __syncthreads();
#pragma unroll 1
            for (int e = 0; e < NEXP; ++e) {
                const u64 m0 = __ballot(act && my_e0 == e), m1 = __ballot(act && my_e1 == e);
                const unsigned n0 = popc64(m0);
                if (m0 | m1) { const unsigned base = wbase[F.wave * 16 + e];
                    if (act && my_e0 == e) { const size_t p = (size_t)e * LISTCAP + base + popc64(m0 & ltmask); list[p] = (int)(row * 2); gatew[p] = my_w0; }
                    if (act && my_e1 == e) { const size_t p = (size_t)e * LISTCAP + base + n0 + popc64(m1 & ltmask); list[p] = (int)(row * 2 + 1); gatew[p] = my_w1; } }
            }
            __syncthreads();
        }
    }
    if (ROUTER) __syncthreads();
}

DI void moe_table(const Frame& F, const unsigned* cnt) {
    LAS int* tab = (LAS int*)(F.lds + MISC_OFF + 64);
    if (F.tid == 0) { int acc = 0;
        for (int e = 0; e < NEXP; ++e) { const int c = (int)__hip_atomic_load(cnt + 64 * e, __ATOMIC_RELAXED, __HIP_MEMORY_SCOPE_AGENT); tab[e] = acc; tab[17 + e] = c; acc += (c + 255) >> 8; }
        tab[16] = acc; }
    __syncthreads();
}


__global__ void __launch_bounds__(512, 2) yoco_fwd(Args args) {
    extern __shared__ __attribute__((aligned(16))) unsigned char lds_raw[];
    Frame F;
    F.lds = (LAS unsigned char*)lds_raw; F.tid = threadIdx.x; F.lane = F.tid & 63; F.wave = __builtin_amdgcn_readfirstlane(F.tid >> 6);
    F.G = gridDim.x; F.bid = blockIdx.x; F.ws = args.ws; F.ctl = (unsigned*)(args.ws + WS_CTL);
    volatile LAS unsigned* misc = (volatile LAS unsigned*)(F.lds + MISC_OFF);
    if (F.tid < 4) misc[F.tid] = 0u;
    __syncthreads();
    XcdBarrier bar; bar.bar = F.ctl + CW_BAR; bar.x = 0; bar.st = misc;
    const int lo = args.ph_lo, hi = args.ph_hi;
    if (hi - lo > 1) bar = xcd_barrier_post(F.ctl + CW_BAR, misc);
#define IN(k) (lo <= (k) && (k) < hi)
#define SEAM(k) do { if (IN(k) && IN((k) + 1)) xcd_barrier(bar); } while (0)
    unsigned char* ws = args.ws;
    bf16_t* XB = (bf16_t*)(ws + WS_XB);
    bf16_t* QKV = (bf16_t*)(ws + WS_R1); bf16_t* MIX = (bf16_t*)(ws + WS_R1); bf16_t* OB = (bf16_t*)(ws + WS_HF + 64 * MiB);
    bf16_t* Y = (bf16_t*)(ws + WS_R1); bf16_t* HE = (bf16_t*)(ws + WS_R1 + R1_HE);
    int* LIST = (int*)(ws + WS_MOE); float* GATEW = (float*)(ws + WS_MOE + 2 * MiB);
    const float* ln_g = args.in[11]; const float* ln_b = args.in[12];
    LAS int* tab = (LAS int*)(F.lds + MISC_OFF + 64);

    if (IN(0)) { p0_prologue(F, args); } SEAM(0);
    if (IN(1)) {
        pg8::SchedDense S; S.init((const bf16_t*)(ws + WS_XB8), (const bf16_t*)(ws + WS_WAIN), NTOK, NIN, DM / 2, F.G, F.bid);
        S.sA = (const float*)(ws + WS_SCL + SCL_SA); S.sB = (const float*)(ws + WS_SCL + SCL_SBIN);
        const float* c128 = (const float*)(ws + WS_ROPE);
        pg8::EpiInProj E{QKV, (bf16_t*)(ws + WS_HF + HF_QI), (bf16_t*)(ws + WS_HF + HF_KI), (float*)(ws + WS_HF + HF_WI), c128, c128 + SEQ * 64, c128 + 2 * SEQ * 64, c128 + 2 * SEQ * 64 + SEQ * 32};
        pg8::gemm_phase<pg8::EpiInProj, pg8::SchedDense, true>(F.lds, S, E);
    } SEAM(1);
    if (IN(2)) { indexer_phase(F); } SEAM(2);
    if (IN(3)) { att::attnA_phase(F); } SEAM(3);
    if (IN(4)) {
        pg8::SchedDense S; S.init(OB, (const bf16_t*)(ws + WS_WAOUT), NTOK, DM, DM, F.G, F.bid);
        pg8::EpiBf16Split E{MIX, DM, DM, 0}; pg8::gemm_phase(F.lds, S, E);
    } SEAM(4);
    if (IN(5)) { ln_phase<true, 1, false, true>(F, args.in[0], MIX, nullptr, ln_g, ln_b, XB, args.in[6], args.in[7], F.ctl + CW_CNT, LIST, GATEW, (signed char*)(ws + WS_XB8), (float*)(ws + WS_SCL + SCL_SA)); } SEAM(5);
    if (IN(6)) {
        moe_table(F, F.ctl + CW_CNT);
        pg8::SchedMoe S{(const bf16_t*)(ws + WS_XB8), (const bf16_t*)(ws + WS_WGU), DM / 2, 2, (size_t)512 * DM, tab, LIST, 1, F.G, F.bid, (const float*)(ws + WS_SCL + SCL_SA), (const float*)(ws + WS_SCL + SCL_SBGU)};
        pg8::EpiMoe1 E{HE}; pg8::gemm_phase<pg8::EpiMoe1, pg8::SchedMoe, true>(F.lds, S, E);
    } SEAM(6);
    if (IN(7)) {
        moe_table(F, F.ctl + CW_CNT);
        pg8::SchedMoe S{HE, (const bf16_t*)(ws + WS_WD), FFE, 4, (size_t)DM * FFE * 2, tab, LIST, 0, F.G, F.bid};
        pg8::EpiMoe2 E{Y, LIST, GATEW, tab}; pg8::gemm_phase(F.lds, S, E);
    } SEAM(7);
    if (IN(8)) { ln_phase<false, 2, false, false>(F, XB, Y, Y + (size_t)NTOK * DM, ln_g + DM, ln_b + DM, XB, nullptr, nullptr, nullptr, nullptr, nullptr, (signed char*)(ws + WS_XB8), (float*)(ws + WS_SCL + SCL_SA)); } SEAM(8);
    if (IN(9)) {
        pg8::SchedDense S; S.init((const bf16_t*)(ws + WS_XB8), (const bf16_t*)(ws + WS_WBQKV), NTOK, 3 * DM, DM / 2, F.G, F.bid);
        S.sA = (const float*)(ws + WS_SCL + SCL_SA); S.sB = (const float*)(ws + WS_SCL + SCL_SBQKV);
        pg8::EpiBf16Split E{QKV, DM, DM, (size_t)NTOK * DM}; pg8::gemm_phase<pg8::EpiBf16Split, pg8::SchedDense, true>(F.lds, S, E);
    } SEAM(9);
    if (IN(10)) { att::attnB_phase(F); } SEAM(10);
    if (IN(11)) {
        pg8::SchedDense S; S.init(OB, (const bf16_t*)(ws + WS_WBOUT), NTOK, DM, DM, F.G, F.bid);
        pg8::EpiBf16Split E{MIX, DM, DM, 0}; pg8::gemm_phase(F.lds, S, E);
    } SEAM(11);
    if (IN(12)) { ln_phase<false, 1, false, true>(F, XB, MIX, nullptr, ln_g + 2 * DM, ln_b + 2 * DM, XB, args.in[6], args.in[7], F.ctl + CW_CNT + 2048, LIST, GATEW, (signed char*)(ws + WS_XB8), (float*)(ws + WS_SCL + SCL_SA)); } SEAM(12);
    if (IN(13)) {
        moe_table(F, F.ctl + CW_CNT + 2048);
        pg8::SchedMoe S{(const bf16_t*)(ws + WS_XB8), (const bf16_t*)((const signed char*)(ws + WS_WGU) + (size_t)NEXP * 512 * DM), DM / 2, 2, (size_t)512 * DM, tab, LIST, 1, F.G, F.bid, (const float*)(ws + WS_SCL + SCL_SA), (const float*)(ws + WS_SCL + SCL_SBGU) + NEXP * 512};
        pg8::EpiMoe1 E{HE}; pg8::gemm_phase<pg8::EpiMoe1, pg8::SchedMoe, true>(F.lds, S, E);
    } SEAM(13);
    if (IN(14)) {
        moe_table(F, F.ctl + CW_CNT + 2048);
        pg8::SchedMoe S{HE, (const bf16_t*)(ws + WS_WD) + (size_t)NEXP * DM * FFE, FFE, 4, (size_t)DM * FFE * 2, tab, LIST, 0, F.G, F.bid};
        pg8::EpiMoe2 E{Y, LIST, GATEW, tab}; pg8::gemm_phase(F.lds, S, E);
    } SEAM(14);
    if (IN(15)) { ln_phase<false, 2, true, false>(F, XB, Y, Y + (size_t)NTOK * DM, ln_g + 3 * DM, ln_b + 3 * DM, args.out, nullptr, nullptr, nullptr, nullptr, nullptr); }
#undef IN
#undef SEAM
}


extern "C" void kernel_launch(void* const* d_in, const int* in_sizes, int n_in, void* d_out, int out_size, void* d_ws, size_t ws_size, hipStream_t stream) {
    static int grid = 0;
    if (grid == 0) {
        if (n_in != 13 || in_sizes[0] != NTOK * DM || out_size != NTOK * DM || ws_size < WS_END) {
            fprintf(stderr, "kernel_launch: unexpected shapes (n_in %d, in0 %d, out %d, ws %zu < %zu)\n", n_in, n_in > 0 ? in_sizes[0] : -1, out_size, ws_size, (size_t)WS_END); grid = -1; return; }
        int dev = 0, cus = 0, per_cu = 0;
        if (hipGetDevice(&dev) != hipSuccess || hipDeviceGetAttribute(&cus, hipDeviceAttributeMultiprocessorCount, dev) != hipSuccess) { grid = -1; return; }
        if (hipFuncSetAttribute((const void*)yoco_fwd, hipFuncAttributeMaxDynamicSharedMemorySize, LDS_BYTES) != hipSuccess) { fprintf(stderr, "kernel_launch: hipFuncSetAttribute failed\n"); grid = -1; return; }
        if (hipOccupancyMaxActiveBlocksPerMultiprocessor(&per_cu, (const void*)yoco_fwd, 512, LDS_BYTES) != hipSuccess || per_cu < 1)
            fprintf(stderr, "kernel_launch: occupancy query reports %d\n", per_cu);
        (void)hipGetLastError();
        grid = cus;
    }
    if (grid < 0) return;
    (void)hipMemsetAsync((char*)d_ws + WS_CTL, 0, CTL_BYTES, stream);
    Args a; memset(&a, 0, sizeof(a));
    for (int i = 0; i < 13; ++i) a.in[i] = (const float*)d_in[i];
    a.out = (float*)d_out; a.ws = (unsigned char*)d_ws;
#if MK_N_LAUNCHES == 1
    a.ph_lo = 0; a.ph_hi = NPH;
    hipLaunchKernelGGL(yoco_fwd, dim3(grid), dim3(512), LDS_BYTES, stream, a);
#else
    for (int p = 0; p < NPH; ++p) { a.ph_lo = p; a.ph_hi = p + 1; hipLaunchKernelGGL(yoco_fwd, dim3(grid), dim3(512), LDS_BYTES, stream, a);
#ifdef REPMASK
        if ((REPMASK >> p) & 1) hipLaunchKernelGGL(yoco_fwd, dim3(grid), dim3(512), LDS_BYTES, stream, a);
#endif
    }
#endif
}
```

```cpp
#include <hip/hip_runtime.h>
#include <cstdio>
#include <cstdint>
#include <cstring>

#ifndef MK_N_LAUNCHES
#define MK_N_LAUNCHES 1
#endif

#define LAS __attribute__((address_space(3)))
#define DI __device__ __forceinline__
typedef unsigned short bf16_t;
typedef short bf16x8 __attribute__((ext_vector_type(8)));
typedef short s16x4 __attribute__((ext_vector_type(4)));
typedef float f32x2 __attribute__((ext_vector_type(2)));
typedef float f32x4 __attribute__((ext_vector_type(4)));
typedef float f32x16 __attribute__((ext_vector_type(16)));
typedef unsigned u32x2 __attribute__((ext_vector_type(2)));
typedef unsigned u32x4 __attribute__((ext_vector_type(4)));
typedef unsigned long long u64;

constexpr int NB = 16, SEQ = 2048, DM = 1024, NTOK = NB * SEQ, NH = 8, HD = 128;
constexpr int AIN = 3656, NIN = 3840;
constexpr int NEXP = 16, FFE = 256, LISTCAP = NTOK;
constexpr int TOPK = 256;
constexpr float LN_EPS = 1e-5f;
constexpr float DN_ALPHA = 1.41421356237309515f;
constexpr int NPH = 16;
constexpr int LDS_BYTES = 160 * 1024;
constexpr int MISC_OFF = LDS_BYTES - 1024;

constexpr size_t MiB = 1u << 20;
constexpr size_t WS_CTL = 0, CTL_BYTES = 64 * 1024;
constexpr size_t WS_WAIN = 1 * MiB;
constexpr size_t WS_WAOUT = WS_WAIN + (size_t)NIN * DM * 2;
constexpr size_t WS_WBQKV = WS_WAOUT + 2 * MiB;
constexpr size_t WS_WBOUT = WS_WBQKV + 6 * MiB;
constexpr size_t WS_WGU = WS_WBOUT + 2 * MiB;
constexpr size_t WS_WD = WS_WGU + 32 * MiB;
constexpr size_t WS_ROPE = WS_WD + 16 * MiB;
constexpr size_t WS_MOE = WS_ROPE + 2 * MiB;
constexpr size_t WS_XB = WS_MOE + 4 * MiB;
constexpr size_t WS_R1 = WS_XB + 64 * MiB;
constexpr size_t WS_HF = WS_R1 + 192 * MiB;
constexpr size_t WS_XB8 = WS_HF + 128 * MiB;
constexpr size_t WS_END = WS_XB8 + 32 * MiB;
constexpr size_t WS_SCL = WS_ROPE + 1536 * 1024;
constexpr size_t SCL_SA = 0, SCL_SBIN = 128 * 1024, SCL_SBQKV = 144 * 1024, SCL_SBGU = 160 * 1024;
constexpr size_t R1_HE = 128 * MiB;
constexpr size_t HF_QI = 0, HF_KI = 32 * MiB, HF_WI = 36 * MiB, HF_MASK = 40 * MiB;
constexpr int CW_BAR = 0;
constexpr int CW_CNT = 4096;

DI unsigned cvt_pk_bf16(float lo, float hi) { unsigned r; asm volatile("v_cvt_pk_bf16_f32 %0, %1, %2" : "=v"(r) : "v"(lo), "v"(hi)); return r; }
DI float bf2f(bf16_t b) { return __uint_as_float(((unsigned)b) << 16); }
#define DPPF0(x, ctrl) __uint_as_float(__builtin_amdgcn_update_dpp(0u, __float_as_uint(x), ctrl, 0xf, 0xf, true))
DI float wave_sum(float v) {
    v += DPPF0(v, 0xB1); v += DPPF0(v, 0x4E); v += DPPF0(v, 0x141); v += DPPF0(v, 0x140);
    const float r0 = __uint_as_float(__builtin_amdgcn_readlane(__float_as_uint(v), 0)), r1 = __uint_as_float(__builtin_amdgcn_readlane(__float_as_uint(v), 16));
    const float r2 = __uint_as_float(__builtin_amdgcn_readlane(__float_as_uint(v), 32)), r3 = __uint_as_float(__builtin_amdgcn_readlane(__float_as_uint(v), 48));
    return (r0 + r1) + (r2 + r3);
}
DI float wave_max(float v) {
#pragma unroll
    for (int d = 32; d >= 1; d >>= 1) v = fmaxf(v, __shfl_xor(v, d));
    return v;
}
DI float wave_min(float v) {
#pragma unroll
    for (int d = 32; d >= 1; d >>= 1) v = fminf(v, __shfl_xor(v, d));
    return v;
}
#define LDS_WAIT() asm volatile("s_waitcnt lgkmcnt(0)" ::: "memory")

#define XB_TMO      128
#define XB_XCNT(j)  (256  + 64 * (j))
#define XB_XSUB(j)  (1280 + 64 * (j))
#define XB_XGEN(j)  (2304 + 64 * (j))
#define XB_TOP      3328
#define XB_TOPGEN   3392
#define XCD_BAR_WORDS 3456
#define XB_SPIN_CAP (1u << 22)

DI unsigned xb_ld(unsigned* p)              { return __hip_atomic_load(p, __ATOMIC_RELAXED, __HIP_MEMORY_SCOPE_AGENT); }
DI unsigned xb_add(unsigned* p, unsigned v) { return __hip_atomic_fetch_add(p, v, __ATOMIC_RELAXED, __HIP_MEMORY_SCOPE_AGENT); }
DI unsigned xb_xcc_id() { return (unsigned)__builtin_amdgcn_s_getreg((3 << 11) | 20) & 0xFu; }
#define XB_SPIN(cond, bar) do { unsigned _sp = 0; while (cond) { __builtin_amdgcn_s_sleep(1); \
    if ((++_sp & 255u) == 0u) { if (xb_ld(&(bar)[XB_TMO])) break; if (_sp > XB_SPIN_CAP) { atomicAdd(&(bar)[XB_TMO], 1u); break; } } } } while (0)

struct XcdBarrier { unsigned* bar; unsigned x; volatile LAS unsigned* st; };

DI XcdBarrier xcd_barrier_post(unsigned* bar, volatile LAS unsigned* st) {
    XcdBarrier b; b.bar = bar; b.x = xb_xcc_id(); b.st = st;
    if (threadIdx.x == 0) (void)xb_add(&bar[XB_XCNT(b.x)], 1u);
    return b;
}
DI void xcd_barrier_complete(unsigned* bar, unsigned x, unsigned& nloc, unsigned& nx) {
    const unsigned G = gridDim.x * gridDim.y * gridDim.z;
    unsigned sum, cnt, mine, sp = 0u;
    for (;;) {
        sum = 0u; cnt = 0u; mine = 0u;
#pragma unroll
        for (unsigned j = 0; j < 16; ++j) { const unsigned c = xb_ld(&bar[XB_XCNT(j)]); sum += c; cnt += (c > 0u) ? 1u : 0u; mine = (j == x) ? c : mine; }
        if (sum == G) break;
        __builtin_amdgcn_s_sleep(1);
        if ((++sp & 255u) == 0u) { if (xb_ld(&bar[XB_TMO])) break; if (sp > XB_SPIN_CAP) { atomicAdd(&bar[XB_TMO], 1u); break; } }
    }
    nloc = mine > 0u ? mine : 1u; nx = cnt > 0u ? cnt : 1u;
}
DI void xcd_barrier(const XcdBarrier& b) {
    asm volatile("s_waitcnt vmcnt(0)" ::: "memory");
    __syncthreads();
    if (threadIdx.x == 0) {
        unsigned* bar = b.bar;
        __builtin_amdgcn_s_waitcnt(0);
        unsigned nloc = b.st[0], nx = b.st[1];
        if (nloc == 0u) { xcd_barrier_complete(bar, b.x, nloc, nx); b.st[0] = nloc; b.st[1] = nx; }
        const unsigned old = xb_add(&bar[XB_XSUB(b.x)], 1u);
        const unsigned gen = old / nloc;
        if (old + 1u == (gen + 1u) * nloc) {
            __builtin_amdgcn_fence(__ATOMIC_RELEASE, "agent");
            asm volatile("s_waitcnt vmcnt(0)" ::: "memory");
            const unsigned og = xb_add(&bar[XB_TOP], 1u);
            const unsigned tg = og / nx;
            if (og + 1u == (tg + 1u) * nx) xb_add(&bar[XB_TOPGEN], 1u);
            else XB_SPIN(xb_ld(&bar[XB_TOPGEN]) == tg, bar);
            __builtin_amdgcn_fence(__ATOMIC_ACQUIRE, "agent");
            xb_add(&bar[XB_XGEN(b.x)], 1u);
            asm volatile("s_waitcnt vmcnt(0)" ::: "memory");
        } else {
            XB_SPIN(xb_ld(&bar[XB_XGEN(b.x)]) == gen, bar);
            __builtin_amdgcn_fence(__ATOMIC_ACQUIRE, "agent");
            asm volatile("s_waitcnt vmcnt(0)" ::: "memory");
        }
    }
    __syncthreads();
}

namespace pg8 {
constexpr int BM = 256, BK = 64, HALF = 128, HTB = HALF * BK * 2, STAGE_BYTES = 8 * HTB, NXCD = 8, WGM = 8;
DI int lds_byte(int r, int c) { const int st = (r >> 4) * 2 + (c >> 5), rr = r & 15, cc = c & 31, ob = rr * 64 + cc * 2; return st * 1024 + (ob ^ (((ob >> 9) & 1) << 5)); }
DI void stage_rc(int b, int& R, int& C) { const int st = b / 1024, sb = b % 1024, swz = sb ^ (((sb >> 9) & 1) << 5); R = (st >> 1) * 16 + swz / 64; C = (st & 1) * 32 + (swz % 64) / 2; }
DI int perm32(int rho) { const int n = rho >> 4, i = rho & 15; return 8 * (i >> 2) + 4 * n + (i & 3); }

struct Unit { int pm, pn, e, rb; };

DI int xcd_remap(int wgid, int nwg) { const int q = nwg / NXCD, r = nwg % NXCD, xcd = wgid % NXCD, off = wgid / NXCD; return (xcd < r ? xcd * (q + 1) : r * (q + 1) + (xcd - r) * q) + off; }

struct SchedDense {
    static constexpr bool GATHER = false;
    const bf16_t* A; const bf16_t* Bt; int K; int nM, nN, nwg, G, c; const float* sA = nullptr; const float* sB = nullptr;
    DI void init(const bf16_t* A_, const bf16_t* Bt_, int M, int N, int K_, int G_, int c_) { A = A_; Bt = Bt_; K = K_; nM = M / BM; nN = N / BM; nwg = nM * nN; G = G_; c = c_; }
    DI bool next(int i, Unit& u) const {
        const long L = (long)i * G + c; if (L >= nwg) return false;
        const int wgid = xcd_remap((int)L, nwg);
        const int nig = WGM * nN, gid = wgid / nig, fm = gid * WGM, gsz = (nM - fm) < WGM ? (nM - fm) : WGM;
        u.pm = fm + ((wgid % nig) % gsz); u.pn = (wgid % nig) / gsz; u.e = 0; u.rb = 0; return true;
    }
    DI const char* abase(const Unit& u) const { return (const char*)A + (size_t)u.pm * BM * K * 2; }
    DI const char* bbase(const Unit& u) const { return (const char*)Bt + (size_t)u.pn * BM * K * 2; }
    DI float scale_a(const Unit& u, int r) const { return sA[u.pm * BM + r]; }
    DI const float* scale_b(const Unit& u) const { return sB + u.pn * BM; }
    DI void aoffs(const Unit&, int tid, unsigned (&v)[2][2]) const {
#pragma unroll
        for (int i = 0; i < 2; ++i) { int R, C; stage_rc(tid * 16 + i * 8192, R, C); v[0][i] = (unsigned)(R * K + C) * 2u; v[1][i] = v[0][i] + (unsigned)(HALF * K) * 2u; }
    }
};
struct SchedMoe {
    static constexpr bool GATHER = true;
    const bf16_t* A; const bf16_t* Bt; int K, nN; size_t bstride; const LAS int* tab; const int* list; int gather; int G, c; const float* sA = nullptr; const float* sB = nullptr;
    DI bool next(int i, Unit& u) const {
        const int total = tab[16] * nN; const long L = (long)i * G + c; if (L >= total) return false;
        const int wgid = xcd_remap((int)L, total);
        const int rt = wgid / nN; u.pn = wgid % nN; u.pm = rt;
        int e = 0;
#pragma unroll 1
        for (; e < 15; ++e) if (rt < tab[e + 1]) break;
        u.e = e; u.rb = (rt - tab[e]) * BM; return true;
    }
    DI const char* abase(const Unit& u) const { return gather ? (const char*)A : (const char*)A + (size_t)u.pm * BM * K * 2; }
    DI const char* bbase(const Unit& u) const { return (const char*)Bt + (size_t)u.e * bstride + (size_t)u.pn * BM * K * 2; }
    DI float scale_a(const Unit& u, int r) const { const int cnt = tab[17 + u.e]; int rr = u.rb + r; rr = rr < cnt ? rr : cnt - 1; return sA[list[(size_t)u.e * LISTCAP + rr] >> 1]; }
    DI const float* scale_b(const Unit& u) const { return sB + u.e * 512 + u.pn * BM; }
    DI void aoffs(const Unit& u, int tid, unsigned (&v)[2][2]) const {
        const int cnt = tab[17 + u.e];
#pragma unroll
        for (int i = 0; i < 2; ++i) { int R, C; stage_rc(tid * 16 + i * 8192, R, C);
#pragma unroll
            for (int h = 0; h < 2; ++h) {
                int row = R + h * HALF;
                if (gather) { int r = u.rb + row; r = r < cnt ? r : cnt - 1; row = list[(size_t)u.e * LISTCAP + r] >> 1; }
                v[h][i] = (unsigned)(row * K + C) * 2u; } }
    }
};

typedef int i32x4 __attribute__((ext_vector_type(4)));
template <class Epi, class Sched, bool INT8 = false>
DI void gemm_phase(LAS unsigned char* lds, const Sched& S, const Epi& E) {
    const int tid = threadIdx.x, wid = __builtin_amdgcn_readfirstlane(tid >> 6), lane = tid & 63, wr = wid >> 2, wc = wid & 3, fr = lane & 15, fq = lane >> 4;
    const int K = S.K, nt = K / BK;
    unsigned voffB[2], vA[2][2], vN[2][2];
#pragma unroll
    for (int i = 0; i < 2; ++i) { int R, C; stage_rc(tid * 16 + i * 8192, R, C); const int Rb = Epi::PERM ? ((R & ~31) + perm32(R & 31)) : R; voffB[i] = (unsigned)(Rb * K + C) * 2u; }
    const size_t kstep = (size_t)(BK * 2);
    const size_t hstep = (size_t)HALF * K * 2;
    const unsigned ldsw = (unsigned)wid * 1024u;
    const int aoff = lds_byte(wr * 64 + fr, fq * 8), boff = lds_byte(wc * 32 + fr, fq * 8);
#define PG8_SA(b, h) (((b) * 2 + (h)) * HTB)
#define PG8_SB(b, h) ((4 + (b) * 2 + (h)) * HTB)
#define PG8_STAGE(bufoff, gbase, voff) do { _Pragma("unroll") for (int _i = 0; _i < 2; ++_i) \
        __builtin_amdgcn_global_load_lds((const unsigned*)((const char*)(gbase) + (voff)[_i]), (LAS unsigned*)(lds + (bufoff) + ldsw + _i * 8192), 16, 0, 0); } while (0)
#define PG8_LDA(dst, b, h) do { _Pragma("unroll") for (int m = 0; m < 4; ++m) _Pragma("unroll") for (int k = 0; k < 2; ++k) dst[m][k] = *(const LAS bf16x8*)(lds + PG8_SA(b, h) + aoff + m * 2048 + k * 1024); } while (0)
#define PG8_LDB(dst, b, h) do { _Pragma("unroll") for (int n = 0; n < 2; ++n) _Pragma("unroll") for (int k = 0; k < 2; ++k) dst[n][k] = *(const LAS bf16x8*)(lds + PG8_SB(b, h) + boff + n * 2048 + k * 1024); } while (0)
#define PG8_MMA(ai, bj, At, Bt) do { __builtin_amdgcn_s_setprio(1); _Pragma("unroll") for (int m = 0; m < 4; ++m) _Pragma("unroll") for (int n = 0; n < 2; ++n) _Pragma("unroll") for (int k = 0; k < 2; ++k) { \
        if constexpr (INT8) acc[ai][bj][m][n] = __builtin_bit_cast(f32x4, __builtin_amdgcn_mfma_i32_16x16x64_i8(__builtin_bit_cast(i32x4, Bt[n][k]), __builtin_bit_cast(i32x4, At[m][k]), __builtin_bit_cast(i32x4, acc[ai][bj][m][n]), 0, 0, 0)); \
        else acc[ai][bj][m][n] = __builtin_amdgcn_mfma_f32_16x16x32_bf16(Bt[n][k], At[m][k], acc[ai][bj][m][n], 0, 0, 0); } __builtin_amdgcn_s_setprio(0); } while (0)
#define PG8_WAIT_V(n) asm volatile("s_waitcnt vmcnt(" #n ")" ::: "memory")
#define PG8_WAIT_L(n) asm volatile("s_waitcnt lgkmcnt(" #n ")" ::: "memory")
#define PG8_BAR __builtin_amdgcn_s_barrier()
#define PG8_SCHED __builtin_amdgcn_sched_barrier(0)
    Unit cur, nxt; int ui = 0;
    if (!S.next(0, cur)) return;
    f32x4 acc[2][2][4][2];
#pragma unroll
    for (int a = 0; a < 2; ++a)
#pragma unroll
        for (int b = 0; b < 2; ++b)
#pragma unroll
            for (int m = 0; m < 4; ++m)
#pragma unroll
                for (int n = 0; n < 2; ++n) acc[a][b][m][n] = (f32x4){0.f, 0.f, 0.f, 0.f};
    bf16x8 At[4][2], B0[2][2], B1[2][2];
    const char* cA = S.abase(cur); const char* cB = S.bbase(cur);
    S.aoffs(cur, tid, vA);
    PG8_STAGE(PG8_SB(0, 0), cB, voffB); PG8_STAGE(PG8_SA(0, 0), cA, vA[0]); PG8_STAGE(PG8_SB(0, 1), cB + hstep, voffB); PG8_STAGE(PG8_SA(0, 1), cA, vA[1]);
    if (wr == 1) PG8_BAR;
    PG8_WAIT_V(4); PG8_BAR;
    PG8_STAGE(PG8_SB(1, 0), cB + kstep, voffB); PG8_STAGE(PG8_SA(1, 0), cA + kstep, vA[0]); PG8_STAGE(PG8_SB(1, 1), cB + hstep + kstep, voffB);
    PG8_WAIT_V(6); PG8_BAR;
    for (;;) {
        const bool has_next = S.next(ui + 1, nxt);
        const char* nA = has_next ? S.abase(nxt) : cA; const char* nB = has_next ? S.bbase(nxt) : cB;
        if (Sched::GATHER) { if (has_next) S.aoffs(nxt, tid, vN); else { vN[0][0] = vA[0][0]; vN[0][1] = vA[0][1]; vN[1][0] = vA[1][0]; vN[1][1] = vA[1][1]; } }
        for (int t = 0; t < nt; t += 2) {
            const bool last = (t == nt - 2);
            const char* a1 = cA + (size_t)(t + 1) * kstep;
            const char* a2 = last ? nA : cA + (size_t)(t + 2) * kstep; const char* b2 = last ? nB : cB + (size_t)(t + 2) * kstep;
            const char* a3 = a2 + kstep; const char* b3 = b2 + kstep;
            unsigned o2[2][2];
#pragma unroll
            for (int h = 0; h < 2; ++h)
#pragma unroll
                for (int i = 0; i < 2; ++i) o2[h][i] = (Sched::GATHER && last) ? vN[h][i] : vA[h][i];
            PG8_LDB(B0, 0, 0); PG8_SCHED; PG8_LDA(At, 0, 0); PG8_STAGE(PG8_SA(1, 1), a1, vA[1]);
            PG8_WAIT_L(8); PG8_BAR; PG8_WAIT_L(0); PG8_MMA(0, 0, At, B0); PG8_BAR; PG8_SCHED;
            PG8_LDB(B1, 0, 1); PG8_STAGE(PG8_SB(0, 0), b2, voffB);
            PG8_BAR; PG8_WAIT_L(0); PG8_MMA(0, 1, At, B1); PG8_BAR;
            PG8_LDA(At, 0, 1); PG8_STAGE(PG8_SA(0, 0), a2, o2[0]);
            PG8_BAR; PG8_WAIT_L(0); PG8_MMA(1, 0, At, B0); PG8_BAR; PG8_SCHED;
            PG8_STAGE(PG8_SB(0, 1), b2 + hstep, voffB);
            PG8_WAIT_V(6); PG8_BAR; PG8_MMA(1, 1, At, B1); PG8_BAR;
            PG8_LDB(B0, 1, 0); PG8_SCHED; PG8_LDA(At, 1, 0); PG8_STAGE(PG8_SA(0, 1), a2, o2[1]);
            PG8_WAIT_L(8); PG8_BAR; PG8_WAIT_L(0); PG8_MMA(0, 0, At, B0); PG8_BAR; PG8_SCHED;
            PG8_LDB(B1, 1, 1); PG8_STAGE(PG8_SB(1, 0), b3, voffB);
            PG8_BAR; PG8_WAIT_L(0); PG8_MMA(0, 1, At, B1); PG8_BAR;
            PG8_LDA(At, 1, 1); PG8_STAGE(PG8_SA(1, 0), a3, o2[0]);
            PG8_BAR; PG8_WAIT_L(0); PG8_MMA(1, 0, At, B0); PG8_BAR; PG8_SCHED;
            PG8_STAGE(PG8_SB(1, 1), b3 + hstep, voffB);
            PG8_WAIT_V(6); PG8_BAR; PG8_MMA(1, 1, At, B1); PG8_BAR;
        }
        if constexpr (INT8) {
            const int rb_ = wr * 64 + fr, cb_ = wc * 32 + (Epi::PERM ? 8 * fq : 4 * fq); const float* sbp = S.scale_b(cur);
            float ra[2][4]; f32x4 cs[2][2];
#pragma unroll
            for (int a = 0; a < 2; ++a)
#pragma unroll
                for (int m = 0; m < 4; ++m) ra[a][m] = S.scale_a(cur, rb_ + a * HALF + m * 16);
#pragma unroll
            for (int b = 0; b < 2; ++b)
#pragma unroll
                for (int n = 0; n < 2; ++n) cs[b][n] = *(const f32x4*)(sbp + cb_ + b * HALF + (Epi::PERM ? 4 * n : 16 * n));
#pragma unroll
            for (int a = 0; a < 2; ++a)
#pragma unroll
                for (int b = 0; b < 2; ++b)
#pragma unroll
                    for (int m = 0; m < 4; ++m)
#pragma unroll
                        for (int n = 0; n < 2; ++n) { const i32x4 v_ = __builtin_bit_cast(i32x4, acc[a][b][m][n]);
                            acc[a][b][m][n] = (f32x4){(float)v_[0], (float)v_[1], (float)v_[2], (float)v_[3]} * ra[a][m] * cs[b][n]; }
        }
        E(acc, cur, wr, wc, fr, fq);
        if (!has_next) break;
#pragma unroll
        for (int a = 0; a < 2; ++a)
#pragma unroll
            for (int b = 0; b < 2; ++b)
#pragma unroll
                for (int m = 0; m < 4; ++m)
#pragma unroll
                    for (int n = 0; n < 2; ++n) acc[a][b][m][n] = (f32x4){0.f, 0.f, 0.f, 0.f};
        cur = nxt; cA = nA; cB = nB; ++ui;
        if (Sched::GATHER) { vA[0][0] = vN[0][0]; vA[0][1] = vN[0][1]; vA[1][0] = vN[1][0]; vA[1][1] = vN[1][1]; }
    }
    PG8_WAIT_V(0);
    if (wr == 0) PG8_BAR;
    PG8_BAR;
#undef PG8_SA
#undef PG8_SB
#undef PG8_STAGE
#undef PG8_LDA
#undef PG8_LDB
#undef PG8_MMA
#undef PG8_WAIT_V
#undef PG8_WAIT_L
#undef PG8_BAR
#undef PG8_SCHED
}

DI u32x4 pack8(f32x4 a, f32x4 b) { u32x4 w; w.x = cvt_pk_bf16(a[0], a[1]); w.y = cvt_pk_bf16(a[2], a[3]); w.z = cvt_pk_bf16(b[0], b[1]); w.w = cvt_pk_bf16(b[2], b[3]); return w; }

struct EpiF32 {
    static constexpr bool PERM = false;
    float* C; int ldc;
    DI void operator()(const f32x4 (&acc)[2][2][4][2], const Unit& u, int wr, int wc, int fr, int fq) const {
        const int row0 = u.pm * BM + wr * 64 + fr, col0 = u.pn * BM + wc * 32 + 4 * fq;
#pragma unroll
        for (int ai = 0; ai < 2; ++ai)
#pragma unroll
            for (int m = 0; m < 4; ++m) { float* rowp = C + (size_t)(row0 + ai * HALF + m * 16) * ldc + col0;
#pragma unroll
                for (int bj = 0; bj < 2; ++bj)
#pragma unroll
                    for (int n = 0; n < 2; ++n) *(f32x4*)(rowp + bj * HALF + n * 16) = acc[ai][bj][m][n]; }
    }
};
struct EpiBf16Split {
    static constexpr bool PERM = true;
    bf16_t* O; int ldc; int split_cols; size_t split_stride;
    DI void operator()(const f32x4 (&acc)[2][2][4][2], const Unit& u, int wr, int wc, int fr, int fq) const {
        const int row0 = u.pm * BM + wr * 64 + fr; int colt = u.pn * BM; bf16_t* base = O;
        { const int t = colt / split_cols; base += (size_t)t * split_stride; colt -= t * split_cols; }
        const int col0 = colt + wc * 32 + 8 * fq;
#pragma unroll
        for (int ai = 0; ai < 2; ++ai)
#pragma unroll
            for (int m = 0; m < 4; ++m) { bf16_t* rowp = base + (size_t)(row0 + ai * HALF + m * 16) * ldc + col0;
#pragma unroll
                for (int bj = 0; bj < 2; ++bj) *(u32x4*)(rowp + bj * HALF) = pack8(acc[ai][bj][m][0], acc[ai][bj][m][1]); }
    }
};
struct EpiInProj {
    static constexpr bool PERM = true;
    bf16_t* QKV; bf16_t* QI; bf16_t* KI; float* WI; const float* cos128; const float* sin128; const float* cos64; const float* sin64;
    DI void operator()(const f32x4 (&acc)[2][2][4][2], const Unit& u, int wr, int wc, int fr, int fq) const {
        const int row0 = u.pm * BM + wr * 64 + fr;
        if (u.pn < 8) {
            bf16_t* base = QKV + (size_t)(u.pn >> 2) * NTOK * DM; const int col0 = (u.pn & 3) * BM + wc * 32 + 8 * fq, dp = 16 * wc + 4 * fq;
#pragma unroll
            for (int ai = 0; ai < 2; ++ai)
#pragma unroll
                for (int m = 0; m < 4; ++m) { const int row = row0 + ai * HALF + m * 16, t = row & (SEQ - 1);
                    const f32x4 c4 = *(const f32x4*)(cos128 + t * 64 + dp), s4 = *(const f32x4*)(sin128 + t * 64 + dp);
#pragma unroll
                    for (int bj = 0; bj < 2; ++bj) { const f32x4 x1 = acc[ai][bj][m][0], x2 = acc[ai][bj][m][1];
                        *(u32x4*)(base + (size_t)row * DM + col0 + bj * HALF) = pack8(x1 * c4 - x2 * s4, x1 * s4 + x2 * c4); } }
        } else if (u.pn < 12) {
            bf16_t* base = QKV + (size_t)2 * NTOK * DM; const int col0 = (u.pn - 8) * BM + wc * 32 + 8 * fq;
#pragma unroll
            for (int ai = 0; ai < 2; ++ai)
#pragma unroll
                for (int m = 0; m < 4; ++m) { const int row = row0 + ai * HALF + m * 16;
#pragma unroll
                    for (int bj = 0; bj < 2; ++bj) *(u32x4*)(base + (size_t)row * DM + col0 + bj * HALF) = pack8(acc[ai][bj][m][0], acc[ai][bj][m][1]); }
        } else if (u.pn < 14) {
            const int col0 = (u.pn - 12) * BM + wc * 32 + 8 * fq, dp = 16 * (wc & 1) + 4 * fq;
#pragma unroll
            for (int ai = 0; ai < 2; ++ai)
#pragma unroll
                for (int m = 0; m < 4; ++m) { const int row = row0 + ai * HALF + m * 16, t = row & (SEQ - 1);
                    const f32x4 c4 = *(const f32x4*)(cos64 + t * 32 + dp), s4 = *(const f32x4*)(sin64 + t * 32 + dp);
#pragma unroll
                    for (int bj = 0; bj < 2; ++bj) { const f32x4 x1 = acc[ai][bj][m][0], x2 = acc[ai][bj][m][1];
                        *(u32x4*)(QI + (size_t)row * 512 + col0 + bj * HALF) = pack8(x1 * c4 - x2 * s4, x1 * s4 + x2 * c4); } }
        } else {
            if (wc < 2) { const int col0 = wc * 32 + 8 * fq, dp = 16 * wc + 4 * fq;
#pragma unroll
                for (int ai = 0; ai < 2; ++ai)
#pragma unroll
                    for (int m = 0; m < 4; ++m) { const int row = row0 + ai * HALF + m * 16, t = row & (SEQ - 1);
                        const f32x4 c4 = *(const f32x4*)(cos64 + t * 32 + dp), s4 = *(const f32x4*)(sin64 + t * 32 + dp);
                        const f32x4 x1 = acc[ai][0][m][0], x2 = acc[ai][0][m][1];
                        *(u32x4*)(KI + (size_t)row * 64 + col0) = pack8(x1 * c4 - x2 * s4, x1 * s4 + x2 * c4); }
            } else if (wc == 2 && fq == 0) {
                const float sc = 0.35355339059327373f;
#pragma unroll
                for (int ai = 0; ai < 2; ++ai)
#pragma unroll
                    for (int m = 0; m < 4; ++m) { const int row = row0 + ai * HALF + m * 16;
                        *(f32x4*)(WI + (size_t)row * 8) = acc[ai][0][m][0] * sc; *(f32x4*)(WI + (size_t)row * 8 + 4) = acc[ai][0][m][1] * sc; }
            }
        }
    }
};
struct EpiMoe1 {
    static constexpr bool PERM = true;
    bf16_t* HE;
    DI void operator()(const f32x4 (&acc)[2][2][4][2], const Unit& u, int wr, int wc, int fr, int fq) const {
        const int row0 = u.pm * BM + wr * 64 + fr, hc0 = 128 * u.pn + 16 * wc + 4 * fq;
#pragma unroll
        for (int ai = 0; ai < 2; ++ai)
#pragma unroll
            for (int m = 0; m < 4; ++m) { const int row = row0 + ai * HALF + m * 16;
#pragma unroll
                for (int bj = 0; bj < 2; ++bj) { const f32x4 g = acc[ai][bj][m][0], up = acc[ai][bj][m][1]; f32x4 h;
#pragma unroll
                    for (int j = 0; j < 4; ++j) h[j] = g[j] * __builtin_amdgcn_rcpf(1.0f + __builtin_amdgcn_exp2f(-1.4426950408889634f * g[j])) * up[j];
                    u32x2 w; w.x = cvt_pk_bf16(h[0], h[1]); w.y = cvt_pk_bf16(h[2], h[3]);
                    *(u32x2*)(HE + (size_t)row * FFE + hc0 + 64 * bj) = w; } }
    }
};
struct EpiMoe2 {
    static constexpr bool PERM = true;
    bf16_t* Y; const int* list; const float* gatew; const LAS int* tab;
    DI void operator()(const f32x4 (&acc)[2][2][4][2], const Unit& u, int wr, int wc, int fr, int fq) const {
        const int cnt = tab[17 + u.e], col0 = u.pn * BM + wc * 32 + 8 * fq;
        int ent[8]; float gw[8];
#pragma unroll
        for (int i = 0; i < 8; ++i) { int r = u.rb + (i >> 2) * HALF + wr * 64 + (i & 3) * 16 + fr; r = r < cnt ? r : cnt - 1; ent[i] = list[(size_t)u.e * LISTCAP + r]; }
#pragma unroll
        for (int i = 0; i < 8; ++i) { int r = u.rb + (i >> 2) * HALF + wr * 64 + (i & 3) * 16 + fr; r = r < cnt ? r : cnt - 1; gw[i] = gatew[(size_t)u.e * LISTCAP + r]; }
#pragma unroll
        for (int i = 0; i < 8; ++i) { const int ai = i >> 2, m = i & 3, r = u.rb + ai * HALF + wr * 64 + m * 16 + fr;
            if (r < cnt) { bf16_t* dst = Y + ((size_t)(ent[i] & 1) * NTOK + (size_t)(ent[i] >> 1)) * DM + col0;
#pragma unroll
                for (int bj = 0; bj < 2; ++bj) *(u32x4*)(dst + bj * HALF) = pack8(acc[ai][bj][m][0] * gw[i], acc[ai][bj][m][1] * gw[i]); } }
    }
};
}

struct Args { const float* in[13]; float* out; unsigned char* ws; int ph_lo, ph_hi; };
struct Frame {
    LAS unsigned char* lds; int tid, lane, wave, G, bid;
    unsigned char* ws; unsigned* ctl;
};

DI int src_col(int mode, int p) {
    if (mode == 0) return p;
    if (mode == 1) {
        if (p < 2048) { const int hd = p >> 7, pp = p & 127; return (hd << 7) + ((pp >> 3) << 2) + (pp & 3) + 64 * ((pp >> 2) & 1); }
        if (p < 3072) return p;
        if (p < 3648) { const int q = p - 3072, hd = q >> 6, pp = q & 63; return 3072 + (hd << 6) + ((pp >> 3) << 2) + (pp & 3) + 32 * ((pp >> 2) & 1); }
        if (p < AIN) return p;
        return -1; }
    return ((p >> 3) << 2) + (p & 3);
}
DI void tconv_tile(const Frame& F, const float* W, const float* W2, int ldw, int K, bf16_t* Bt, int mode, int k0, int n0) {
    LAS float* T = (LAS float*)F.lds;
    { const int n4 = (F.tid & 15) * 4, p = n0 + n4, src = src_col(mode, p); const float* Ws = (mode == 2 && ((p >> 2) & 1)) ? W2 : W;
#pragma unroll
      for (int i = 0; i < 2; ++i) { const int kl = (F.tid >> 4) + 32 * i;
          const f32x4 v = src >= 0 ? *(const f32x4*)(Ws + (size_t)(k0 + kl) * ldw + src) : (f32x4){0.f, 0.f, 0.f, 0.f};
          T[kl * 65 + n4] = v[0]; T[kl * 65 + n4 + 1] = v[1]; T[kl * 65 + n4 + 2] = v[2]; T[kl * 65 + n4 + 3] = v[3]; } }
    __syncthreads();
    { const int nl = F.tid >> 3, kl = (F.tid & 7) * 8; float v[8];
#pragma unroll
      for (int j = 0; j < 8; ++j) v[j] = T[(kl + j) * 65 + nl];
      u32x4 w; w.x = cvt_pk_bf16(v[0], v[1]); w.y = cvt_pk_bf16(v[2], v[3]); w.z = cvt_pk_bf16(v[4], v[5]); w.w = cvt_pk_bf16(v[6], v[7]);
      *(u32x4*)(Bt + (size_t)(n0 + nl) * K + k0 + kl) = w; }
    __syncthreads();
}
DI void dsincos(double x, double& s, double& c) {
    const double k = rint(x * 0.63661977236758134308);
    const double r = (x - k * 1.57079632679489655800) - k * 6.12323399573676603587e-17;
    const double r2 = r * r;
    double sp = 1.0 / 1307674368000.0; sp = sp * r2 - 1.0 / 6227020800.0; sp = sp * r2 + 1.0 / 39916800.0; sp = sp * r2 - 1.0 / 5040.0; sp = sp * r2 + 1.0 / 120.0; sp = sp * r2 - 1.0 / 6.0; sp = sp * r2 + 1.0;
    double cp = -1.0 / 87178291200.0; cp = cp * r2 + 1.0 / 479001600.0; cp = cp * r2 - 1.0 / 3628800.0; cp = cp * r2 + 1.0 / 40320.0; cp = cp * r2 - 1.0 / 720.0; cp = cp * r2 + 1.0 / 24.0; cp = cp * r2 - 0.5; cp = cp * r2 + 1.0;
    const double sr = sp * r, cr = cp;
    const int q = ((int)k) & 3;
    s = (q == 0) ? sr : (q == 1) ? cr : (q == 2) ? -sr : -cr;
    c = (q == 0) ? cr : (q == 1) ? -sr : (q == 2) ? -cr : sr;
}
DI float dpp_wave_max_f(float v);
DI void quant_row(const f32x4 (&v)[4], int lane, signed char* dst, float* sdst) {
    float mx = 0.f;
#pragma unroll
    for (int i = 0; i < 4; ++i) mx = fmaxf(mx, fmaxf(fmaxf(fabsf(v[i][0]), fabsf(v[i][1])), fmaxf(fabsf(v[i][2]), fabsf(v[i][3]))));
    mx = dpp_wave_max_f(mx);
    const float inv = mx > 0.f ? 127.0f / mx : 0.f;
#pragma unroll
    for (int i = 0; i < 4; ++i) { const int q0 = (int)__builtin_rintf(v[i][0] * inv), q1 = (int)__builtin_rintf(v[i][1] * inv), q2 = (int)__builtin_rintf(v[i][2] * inv), q3 = (int)__builtin_rintf(v[i][3] * inv);
        *(int*)(dst + 4 * lane + 256 * i) = (q0 & 0xFF) | ((q1 & 0xFF) << 8) | ((q2 & 0xFF) << 16) | (q3 << 24); }
    if (lane == 0) *sdst = mx * (1.0f / 127.0f);
}
DI void wq8_unit(const Frame& F, const float* W0, const float* W2, int ldw, int mode, signed char* Bt8, float* sB, int n0) {
    LAS float* T = (LAS float*)F.lds;
    LAS unsigned* cmax = (LAS unsigned*)(F.lds + 1024 * 33 * 4);
    const int n4 = (F.tid & 7) * 4, src = src_col(mode, n0 + n4); const float* W = (mode == 2 && (((n0 + n4) >> 2) & 1)) ? W2 : W0;
    if (F.tid < 32) cmax[F.tid] = 0u;
    __syncthreads();
    f32x4 m4 = {0.f, 0.f, 0.f, 0.f}, vv[16];
#pragma unroll
    for (int i = 0; i < 16; ++i) vv[i] = src >= 0 ? *(const f32x4*)(W + (size_t)((F.tid >> 3) + 64 * i) * ldw + src) : (f32x4){0.f, 0.f, 0.f, 0.f};
#pragma unroll
    for (int i = 0; i < 16; ++i) { const int kk = (F.tid >> 3) + 64 * i; const f32x4 v = vv[i];
        m4[0] = fmaxf(m4[0], fabsf(v[0])); m4[1] = fmaxf(m4[1], fabsf(v[1])); m4[2] = fmaxf(m4[2], fabsf(v[2])); m4[3] = fmaxf(m4[3], fabsf(v[3]));
        T[kk * 33 + n4] = v[0]; T[kk * 33 + n4 + 1] = v[1]; T[kk * 33 + n4 + 2] = v[2]; T[kk * 33 + n4 + 3] = v[3]; }
#pragma unroll
    for (int j = 0; j < 4; ++j) __hip_atomic_fetch_max(cmax + n4 + j, __float_as_uint(m4[j]), __ATOMIC_RELAXED, __HIP_MEMORY_SCOPE_WORKGROUP);
    __syncthreads();
    if (F.tid < 32) sB[n0 + F.tid] = __uint_as_float(cmax[F.tid]) * (1.0f / 127.0f);
    { const int nl = F.tid & 31, kb = (F.tid >> 5) * 64; const float mx = __uint_as_float(cmax[nl]), inv = mx > 0.f ? 127.0f / mx : 0.f;
#pragma unroll 2
      for (int k8 = 0; k8 < 64; k8 += 8) { int q[8];
#pragma unroll
          for (int j = 0; j < 8; ++j) q[j] = (int)__builtin_rintf(T[(kb + k8 + j) * 33 + nl] * inv);
          u32x2 w; w.x = (unsigned)((q[0] & 0xFF) | ((q[1] & 0xFF) << 8) | ((q[2] & 0xFF) << 16) | (q[3] << 24)); w.y = (unsigned)((q[4] & 0xFF) | ((q[5] & 0xFF) << 8) | ((q[6] & 0xFF) << 16) | (q[7] << 24));
          *(u32x2*)(Bt8 + (size_t)(n0 + nl) * DM + kb + k8) = w; } }
    __syncthreads();
}
DI void p0_prologue(const Frame& F, const Args& a) {
    const size_t gtid = (size_t)F.bid * 512 + F.tid, gthreads = (size_t)F.G * 512;
    { signed char* xq = (signed char*)(F.ws + WS_XB8); float* SA = (float*)(F.ws + WS_SCL + SCL_SA);
      const int gw = F.bid * 8 + F.wave, nw = F.G * 8, lane = F.lane;
      f32x4 rr[4][4];
#define XQ_LOAD(slot, r_) do { const int r2_ = (r_) < NTOK ? (r_) : gw; _Pragma("unroll") for (int i = 0; i < 4; ++i) rr[slot][i] = *(const f32x4*)(a.in[0] + (size_t)r2_ * DM + 4 * lane + 256 * i); } while (0)
      XQ_LOAD(0, gw); XQ_LOAD(1, gw + nw); XQ_LOAD(2, gw + 2 * nw);
      for (int row = gw; row < NTOK; row += 4 * nw) {
          XQ_LOAD(3, row + 3 * nw);
          quant_row(rr[0], lane, xq + (size_t)row * DM, SA + row);
          XQ_LOAD(0, row + 4 * nw);
          if (row + nw < NTOK) quant_row(rr[1], lane, xq + (size_t)(row + nw) * DM, SA + row + nw);
          XQ_LOAD(1, row + 5 * nw);
          if (row + 2 * nw < NTOK) quant_row(rr[2], lane, xq + (size_t)(row + 2 * nw) * DM, SA + row + 2 * nw);
          XQ_LOAD(2, row + 6 * nw);
          if (row + 3 * nw < NTOK) quant_row(rr[3], lane, xq + (size_t)(row + 3 * nw) * DM, SA + row + 3 * nw);
      }
#undef XQ_LOAD
    }
    { float* c128 = (float*)(F.ws + WS_ROPE), * s128 = c128 + SEQ * 64, * c64 = s128 + SEQ * 64, * s64 = c64 + SEQ * 32;
      for (size_t i = gtid; i < (size_t)SEQ * 96; i += gthreads) {
          const bool big = i < (size_t)SEQ * 64; const int j = big ? (int)i : (int)(i - (size_t)SEQ * 64);
          const int t = big ? j >> 6 : j >> 5, d = big ? j & 63 : j & 31;
          const float ex = big ? (float)(2 * d) / 128.0f : (float)(2 * d) / 64.0f;
          const float pw = (float)exp((double)ex * 9.21034037197618273607);
          const float inv = 1.0f / pw;
          const float ang = (float)t * inv;
          double s, c; dsincos((double)ang, s, c);
          if (big) { c128[j] = (float)c; s128[j] = (float)s; } else { c64[j] = (float)c; s64[j] = (float)s; } } }
    { constexpr int T_SQ = 256, T_GU = 512 / 32, T_DN = 64, U_IN = NIN / 32, U_Q = DM / 32, U_KV = 2 * DM / 32;
      constexpr int O1 = U_IN, O2 = O1 + U_Q, O3 = O2 + U_KV, O4 = O3 + T_SQ, O5 = O4 + T_SQ, O6 = O5 + 32 * T_GU, O7 = O6 + 32 * T_DN;
      float* SBIN = (float*)(F.ws + WS_SCL + SCL_SBIN); float* SBQKV = (float*)(F.ws + WS_SCL + SCL_SBQKV);
      for (int tile = F.bid; tile < O7; tile += F.G) {
          if (tile < O1) wq8_unit(F, a.in[1], nullptr, AIN, 1, (signed char*)(F.ws + WS_WAIN), SBIN, tile * 32);
          else if (tile < O2) wq8_unit(F, a.in[3], nullptr, DM, 0, (signed char*)(F.ws + WS_WBQKV), SBQKV, (tile - O1) * 32);
          else if (tile < O3) wq8_unit(F, a.in[4], nullptr, 2 * DM, 0, (signed char*)(F.ws + WS_WBQKV) + (size_t)DM * DM, SBQKV + DM, (tile - O2) * 32);
          else if (tile < O4) { const int t = tile - O3; tconv_tile(F, a.in[2], nullptr, DM, DM, (bf16_t*)(F.ws + WS_WAOUT), 0, (t & 15) * 64, (t >> 4) * 64); }
          else if (tile < O5) { const int t = tile - O4; tconv_tile(F, a.in[5], nullptr, DM, DM, (bf16_t*)(F.ws + WS_WBOUT), 0, (t & 15) * 64, (t >> 4) * 64); }
          else if (tile < O6) { const int t = tile - O5, le = t >> 4, tt = t & 15;
              wq8_unit(F, a.in[8] + (size_t)le * DM * FFE, a.in[9] + (size_t)le * DM * FFE, FFE, 2, (signed char*)(F.ws + WS_WGU) + (size_t)le * 512 * DM, (float*)(F.ws + WS_SCL + SCL_SBGU) + le * 512, tt * 32); }
          else { const int t = tile - O6, le = t >> 6, tt = t & 63;
              tconv_tile(F, a.in[10] + (size_t)le * FFE * DM, nullptr, DM, FFE, (bf16_t*)(F.ws + WS_WD) + (size_t)le * DM * FFE, 0, (tt & 3) * 64, (tt >> 2) * 64); }
      } }
}

constexpr int SCP = 2064;
DI unsigned ord_key(float v) { const unsigned b = __float_as_uint(v); return b ^ (((int)b >> 31) | 0x80000000u); }
DI unsigned popc64(u64 m) { return (unsigned)__builtin_popcountll(m); }

#define DPPF(x, ctrl) __uint_as_float(__builtin_amdgcn_update_dpp(0u, __float_as_uint(x), ctrl, 0xf, 0xf, true))
DI float dpp_wave_max(float v) {
    v = fmaxf(v, DPPF(v, 0xB1)); v = fmaxf(v, DPPF(v, 0x4E)); v = fmaxf(v, DPPF(v, 0x141)); v = fmaxf(v, DPPF(v, 0x140));
    const float r0 = __uint_as_float(__builtin_amdgcn_readlane(__float_as_uint(v), 0)), r1 = __uint_as_float(__builtin_amdgcn_readlane(__float_as_uint(v), 16));
    const float r2 = __uint_as_float(__builtin_amdgcn_readlane(__float_as_uint(v), 32)), r3 = __uint_as_float(__builtin_amdgcn_readlane(__float_as_uint(v), 48));
    return fmaxf(fmaxf(r0, r1), fmaxf(r2, r3));
}
DI float dpp_wave_max_f(float v) { return dpp_wave_max(v); }
DI float dpp_wave_min(float v) {
    v = fminf(v, DPPF(v, 0xB1)); v = fminf(v, DPPF(v, 0x4E)); v = fminf(v, DPPF(v, 0x141)); v = fminf(v, DPPF(v, 0x140));
    const float r0 = __uint_as_float(__builtin_amdgcn_readlane(__float_as_uint(v), 0)), r1 = __uint_as_float(__builtin_amdgcn_readlane(__float_as_uint(v), 16));
    const float r2 = __uint_as_float(__builtin_amdgcn_readlane(__float_as_uint(v), 32)), r3 = __uint_as_float(__builtin_amdgcn_readlane(__float_as_uint(v), 48));
    return fminf(fminf(r0, r1), fminf(r2, r3));
}
DI unsigned dpp_scan_add(unsigned v) {
    v += (unsigned)__builtin_amdgcn_update_dpp(0, (int)v, 0x111, 0xf, 0xf, false);
    v += (unsigned)__builtin_amdgcn_update_dpp(0, (int)v, 0x112, 0xf, 0xf, false);
    v += (unsigned)__builtin_amdgcn_update_dpp(0, (int)v, 0x114, 0xf, 0xf, false);
    v += (unsigned)__builtin_amdgcn_update_dpp(0, (int)v, 0x118, 0xf, 0xf, false);
    v += (unsigned)__builtin_amdgcn_update_dpp(0, (int)v, 0x142, 0xa, 0xf, false);
    v += (unsigned)__builtin_amdgcn_update_dpp(0, (int)v, 0x143, 0xc, 0xf, false);
    return v;
}
DI void select_topk(const LAS float* srow, int nj, LAS unsigned* hist, LAS unsigned* cand, LAS unsigned* ccnt, int lane, u64* mrow) {
    const LAS float* sp = srow + lane;
    float v[32];
#pragma unroll
    for (int g = 0; g < 4; ++g) { if (8 * g < nj) {
#pragma unroll
        for (int j = 8 * g; j < 8 * g + 8; ++j) v[j] = sp[j * 64]; } else {
#pragma unroll
        for (int j = 8 * g; j < 8 * g + 8; ++j) v[j] = -__builtin_inff(); } }
    int njv = nj; asm volatile("" : "+v"(njv));
#pragma unroll
    for (int j = 0; j < 32; ++j) v[j] = (j < njv) ? v[j] : -__builtin_inff();
    float vmx = v[0], vmn = v[0];
#pragma unroll
    for (int j = 1; j < 32; ++j) { vmx = fmaxf(vmx, v[j]); vmn = fminf(vmn, v[j] > -3.0e38f ? v[j] : vmn); }
    vmx = dpp_wave_max(vmx); vmn = dpp_wave_min(vmn);
    unsigned T = 0u, n_gt = 0u, n_ge = 0u;
    bool fast = false;
    if (vmx > vmn) {
        const float scale = 256.0f / (vmx - vmn);
        *(LAS u32x4*)(hist + 4 * lane) = (u32x4){0u, 0u, 0u, 0u};
        if (lane == 0) *ccnt = 0u;
        LDS_WAIT();
#pragma unroll
        for (int j = 0; j < 32; ++j) if (j < njv) { int b = (int)((v[j] - vmn) * scale); b = b > 255 ? 255 : b; __hip_atomic_fetch_add(hist + b, 1u, __ATOMIC_RELAXED, __HIP_MEMORY_SCOPE_WORKGROUP); }
        LDS_WAIT();
        const u32x4 h4 = *(const LAS u32x4*)(hist + 4 * (63 - lane));
        const unsigned c4 = h4.x + h4.y + h4.z + h4.w;
        const unsigned P = dpp_scan_add(c4);
        const u64 bal = __ballot(P >= (unsigned)TOPK);
        const int Ls = __builtin_ctzll(bal);
        const unsigned P_L = __builtin_amdgcn_readlane(P, Ls), c_L = __builtin_amdgcn_readlane(c4, Ls);
        const unsigned hb0 = __builtin_amdgcn_readlane(h4.x, Ls), hb1 = __builtin_amdgcn_readlane(h4.y, Ls), hb2 = __builtin_amdgcn_readlane(h4.z, Ls), hb3 = __builtin_amdgcn_readlane(h4.w, Ls);
        const int bin0 = 4 * (63 - Ls);
        unsigned cum = P_L - c_L; int bstar; unsigned mc;
        if (cum + hb3 >= (unsigned)TOPK) { bstar = bin0 + 3; mc = hb3; }
        else { cum += hb3; if (cum + hb2 >= (unsigned)TOPK) { bstar = bin0 + 2; mc = hb2; }
        else { cum += hb2; if (cum + hb1 >= (unsigned)TOPK) { bstar = bin0 + 1; mc = hb1; }
        else { cum += hb1; bstar = bin0; mc = hb0; } } }
        if (mc <= 256u) {
            fast = true;
            unsigned cbase = 0;
#pragma unroll
            for (int j = 0; j < 32; ++j) { int b = (int)((v[j] - vmn) * scale); b = b > 255 ? 255 : b;
                const u64 m = __ballot(b == bstar);
                if (m) { if (b == bstar) cand[(cbase + __builtin_amdgcn_mbcnt_hi((unsigned)(m >> 32), __builtin_amdgcn_mbcnt_lo((unsigned)m, 0u))) & 255u] = ord_key(v[j]); cbase += popc64(m); } }
            LDS_WAIT();
            const unsigned r = (unsigned)TOPK - cum;
            if (mc <= 64u) {
                const unsigned cu = ((unsigned)lane < mc) ? cand[lane] : 0u;
#pragma unroll 1
                for (int bit = 31; bit >= 0; --bit) { const unsigned ct = T | (1u << bit); if (popc64(__ballot(cu >= ct)) >= r) T = ct; }
                n_gt = cum + popc64(__ballot(cu > T)); n_ge = cum + popc64(__ballot(cu >= T));
            } else {
                unsigned cu[4];
#pragma unroll
                for (int ch = 0; ch < 4; ++ch) cu[ch] = ((unsigned)(lane + 64 * ch) < mc) ? cand[lane + 64 * ch] : 0u;
#pragma unroll 1
                for (int bit = 31; bit >= 0; --bit) { const unsigned ct = T | (1u << bit); unsigned cnt = 0;
#pragma unroll
                    for (int ch = 0; ch < 4; ++ch) cnt += popc64(__ballot(cu[ch] >= ct));
                    if (cnt >= r) T = ct; }
                unsigned cge = 0, cgt = 0;
#pragma unroll
                for (int ch = 0; ch < 4; ++ch) { cge += popc64(__ballot(cu[ch] >= T)); cgt += popc64(__ballot(cu[ch] > T)); }
                n_gt = cum + cgt; n_ge = cum + cge;
            }
        }
    }
    if (!fast) {
#pragma unroll 1
        for (int bit = 31; bit >= 0; --bit) { const unsigned ct = T | (1u << bit); unsigned cnt = 0;
#pragma unroll
            for (int j = 0; j < 32; ++j) cnt += popc64(__ballot(j < njv && ord_key(v[j]) >= ct));
            if (cnt >= (unsigned)TOPK) T = ct; }
        n_gt = 0; n_ge = 0;
#pragma unroll
        for (int j = 0; j < 32; ++j) { const unsigned u = ord_key(v[j]); n_ge += popc64(__ballot(j < njv && u >= T)); n_gt += popc64(__ballot(j < njv && u > T)); }
    }
    const unsigned mneed = (unsigned)TOPK - n_gt, n_eq = n_ge - n_gt;
    u64 myword = 0ull;
    if (n_eq == mneed) {
#pragma unroll
        for (int j = 0; j < 32; ++j) { const u64 w = __ballot(ord_key(v[j]) >= T); myword = (lane == j) ? w : myword; }
    } else {
        unsigned running = 0; const u64 ltmask = (1ull << lane) - 1ull;
#pragma unroll
        for (int j = 0; j < 32; ++j) { const unsigned u = ord_key(v[j]); const u64 eqm = __ballot(u == T); const unsigned pre = running + popc64(eqm & ltmask);
            const u64 w = __ballot(u > T || (u == T && pre < mneed)); running += popc64(eqm); myword = (lane == j) ? w : myword; }
    }
    if (lane < 32) mrow[lane] = myword;
}

DI void indexer_phase(const Frame& F) {
    const bf16_t* QI = (const bf16_t*)(F.ws + WS_HF + HF_QI); const bf16_t* KI = (const bf16_t*)(F.ws + WS_HF + HF_KI);
    const float* WI = (const float*)(F.ws + WS_HF + HF_WI); u64* MASK = (u64*)(F.ws + WS_HF + HF_MASK);
    LAS float* sc = (LAS float*)F.lds;
    LAS unsigned* hist = (LAS unsigned*)(F.lds + 16 * SCP * 4) + F.wave * 256;
    LAS unsigned* cand = (LAS unsigned*)(F.lds + 16 * SCP * 4 + 8192) + F.wave * 256;
    LAS unsigned* ccnt = (LAS unsigned*)(F.lds + 16 * SCP * 4 + 16384) + F.wave * 16;
    const int lane = F.lane, fr = lane & 15, fq = lane >> 4;
    constexpr int NITEM = NB * 32 * 4;
    bf16x8 qa[8][2]; f32x4 wq[4][2];
#define IDX_ITEM(i_, c_, b_, tok0_) const int L_##i_ = (i_) * F.G + (((i_) & 1) ? (F.G - 1 - F.bid) : F.bid); const int c_ = 31 - L_##i_ / 64, b_ = (L_##i_ % 64) >> 2, tok0_ = b_ * SEQ + c_ * 64 + ((L_##i_ % 64) & 3) * 16
#define IDX_LOADQ(tok0_) do { _Pragma("unroll") for (int h = 0; h < 8; ++h) _Pragma("unroll") for (int ks = 0; ks < 2; ++ks) qa[h][ks] = *(const bf16x8*)(QI + (size_t)((tok0_) + fr) * 512 + h * 64 + ks * 32 + fq * 8); \
        _Pragma("unroll") for (int j = 0; j < 4; ++j) { wq[j][0] = *(const f32x4*)(WI + (size_t)((tok0_) + 4 * fq + j) * 8); wq[j][1] = *(const f32x4*)(WI + (size_t)((tok0_) + 4 * fq + j) * 8 + 4); } } while (0)
    { IDX_ITEM(0, c0, b0, t0); (void)b0; if (F.bid < NITEM && c0 >= 4) IDX_LOADQ(t0); }
    for (int i = 0;; ++i) {
        const int L = i * F.G + ((i & 1) ? (F.G - 1 - F.bid) : F.bid); if (L >= NITEM) break;
        const int c = 31 - L / 64, rr = L % 64, b = rr >> 2, g4 = rr & 3;
        const int tok0 = b * SEQ + c * 64 + g4 * 16, nk = 64 * (c + 1);
        const int Ln = (i + 1) * F.G + (((i + 1) & 1) ? (F.G - 1 - F.bid) : F.bid);
        const int cn = 31 - Ln / 64, tokn = ((Ln % 64) >> 2) * SEQ + cn * 64 + ((Ln % 64) & 3) * 16; const bool pre = Ln < NITEM && cn >= 4;
        if (c >= 4) {
            const int ntile = nk / 16, ntw = (ntile - F.wave + 7) >> 3;
            const bf16_t* kbase = KI + (size_t)(b * SEQ + fr) * 64 + fq * 8;
            bf16x8 kA[4][2], kB[4][2];
#define IDX_LOAD(dst, i0) do { _Pragma("unroll") for (int u = 0; u < 4; ++u) { int i_ = (i0) + u; i_ = i_ < ntw ? i_ : ntw - 1; const bf16_t* kp = kbase + (size_t)(F.wave + 8 * i_) * 16 * 64; \
                dst[u][0] = *(const bf16x8*)kp; dst[u][1] = *(const bf16x8*)(kp + 32); } } while (0)
#define IDX_COMP(srcb, i0) do { _Pragma("unroll") for (int u = 0; u < 4; ++u) { const int i_ = (i0) + u; if (i_ < ntw) { const int kt = F.wave + 8 * i_; f32x4 s = {0.f, 0.f, 0.f, 0.f}; \
                _Pragma("unroll") for (int h = 0; h < 8; ++h) { f32x4 acc = {0.f, 0.f, 0.f, 0.f}; \
                    acc = __builtin_amdgcn_mfma_f32_16x16x32_bf16(qa[h][0], srcb[u][0], acc, 0, 0, 0); \
                    acc = __builtin_amdgcn_mfma_f32_16x16x32_bf16(qa[h][1], srcb[u][1], acc, 0, 0, 0); \
                    _Pragma("unroll") for (int j = 0; j < 4; ++j) s[j] += wq[j][h >> 2][h & 3] * fmaxf(acc[j], 0.f); } \
                _Pragma("unroll") for (int j = 0; j < 4; ++j) sc[(4 * fq + j) * SCP + kt * 16 + fr] = s[j]; } } } while (0)
            IDX_LOAD(kA, 0);
            for (int i0 = 0; i0 < ntw; i0 += 8) {
                IDX_LOAD(kB, i0 + 4);
                IDX_COMP(kA, i0);
                IDX_LOAD(kA, i0 + 8);
                IDX_COMP(kB, i0 + 4);
            }
#undef IDX_LOAD
#undef IDX_COMP
            __syncthreads();
            if (pre) IDX_LOADQ(tokn);
#pragma unroll 1
            for (int qq = 0; qq < 2; ++qq) { const int ql = 2 * F.wave + qq;
                select_topk(sc + ql * SCP, c + 1, hist, cand, ccnt, lane, MASK + (size_t)(tok0 + ql) * 32); }
            __syncthreads();
        } else {
            const int q = F.tid >> 5, w = F.tid & 31;
            MASK[(size_t)(tok0 + q) * 32 + w] = (w <= c) ? ~0ull : 0ull;
            if (pre) IDX_LOADQ(tokn);
        }
    }
#undef IDX_ITEM
#undef IDX_LOADQ
}

namespace att {
constexpr float SCALE = 0.08838834764831845f;
constexpr float THR = 8.f;
constexpr int NW = 8, QBLK = 32, KVBLK = 64, QB = NW * QBLK;
constexpr int SHM_V = KVBLK * HD * 2, SHM_K = KVBLK * HD * 2;
#define KSWZ(row, colB) ((row) * 256 + ((colB) ^ (((row) & 7) << 4)))
#define SBAR() __builtin_amdgcn_sched_barrier(0)
DI int v_st(int k, int c) { const int kk = (k & ~0xC) | ((k & 4) << 1) | ((k & 8) >> 1); return ((kk >> 3) * 4 + (c >> 5)) * 512 + ((kk & 7) * 32 + (c & 31)) * 2; }
DI int v_rd_base(int lane) { return ((lane & 3) << 3) | (((lane >> 2) & 3) << 6) | (((lane >> 4) & 1) << 5) | (((lane >> 5) & 1) << 8); }
constexpr int v_rd_off(int d0, int ks, int half) { return d0 * 512 + ks * 4096 + half * 2048; }
DI int crow(int r, int hi) { return (r & 3) + 8 * (r >> 2) + 4 * hi; }

DI void partialSM(f32x16& p0, f32x16& p1, float& m_reg, float& mn, float& alpha) {
    float pmax = p0[0];
#pragma unroll
    for (int r = 1; r < 16; ++r) pmax = fmaxf(pmax, p0[r]);
#pragma unroll
    for (int r = 0; r < 16; ++r) pmax = fmaxf(pmax, p1[r]);
    { auto rr = __builtin_amdgcn_permlane32_swap(__float_as_uint(pmax), __float_as_uint(pmax), false, false);
      pmax = fmaxf(__uint_as_float(rr[0]), __uint_as_float(rr[1])); }
    constexpr float C2 = 1.4426950408889634f * SCALE;
    if (__builtin_expect(__all((pmax - m_reg) * SCALE <= THR), 1)) { mn = m_reg; alpha = 1.f; }
    else { mn = fmaxf(m_reg, pmax); alpha = __builtin_amdgcn_exp2f((m_reg - mn) * C2); m_reg = mn; }
    const float mnL = -mn * C2;
#pragma unroll
    for (int r = 0; r < 16; ++r) p0[r] = fmaf(p0[r], C2, mnL);
#pragma unroll
    for (int r = 0; r < 16; ++r) p1[r] = fmaf(p1[r], C2, mnL);
#pragma unroll
    for (int r = 0; r < 16; ++r) p0[r] = __builtin_amdgcn_exp2f(p0[r]);
}
#define PK4(P, B_, OUT) do { unsigned a0 = cvt_pk_bf16(P[B_+0], P[B_+1]), a1 = cvt_pk_bf16(P[B_+2], P[B_+3]);                          \
        unsigned b0 = cvt_pk_bf16(P[B_+4], P[B_+5]), b1 = cvt_pk_bf16(P[B_+6], P[B_+7]);                                             \
        auto r0 = __builtin_amdgcn_permlane32_swap(a0, b0, false, false); auto r1 = __builtin_amdgcn_permlane32_swap(a1, b1, false, false); \
        u32x4 w = {r0[0], r1[0], r0[1], r1[1]}; OUT = *reinterpret_cast<bf16x8*>(&w); } while (0)
DI void finishSM(f32x16& p0, f32x16& p1, float alpha, float& l_reg, bf16x8& pa0, bf16x8& pa1, bf16x8& pa2, bf16x8& pa3) {
#pragma unroll
    for (int r = 0; r < 16; ++r) p1[r] = __builtin_amdgcn_exp2f(p1[r]);
    float ps = 0;
#pragma unroll
    for (int r = 0; r < 16; ++r) ps += p0[r];
#pragma unroll
    for (int r = 0; r < 16; ++r) ps += p1[r];
    { auto rr = __builtin_amdgcn_permlane32_swap(__float_as_uint(ps), __float_as_uint(ps), false, false);
      ps = __uint_as_float(rr[0]) + __uint_as_float(rr[1]); }
    l_reg = l_reg * alpha + ps;
    PK4(p0, 0, pa0); PK4(p0, 8, pa1); PK4(p1, 0, pa2); PK4(p1, 8, pa3);
}
DI void packP(const f32x16& p0, const f32x16& p1, bf16x8& pa0, bf16x8& pa1, bf16x8& pa2, bf16x8& pa3) {
    PK4(p0, 0, pa0); PK4(p0, 8, pa1); PK4(p1, 0, pa2); PK4(p1, 8, pa3);
}
template <int KB>
DI void qkt(f32x16& p0, f32x16& p1, const LAS char* K_lds, int r32, int hi, const bf16x8* qr) {
    p0 = f32x16{}; p1 = f32x16{};
    const LAS char* kb[4];
#pragma unroll
    for (int dd = 0; dd < 4; ++dd) kb[dd] = K_lds + KB * SHM_K + KSWZ(r32, (dd * 16 + hi * 8) * 2);
#pragma unroll
    for (int d0 = 0; d0 < 8; ++d0) { const LAS char* a = kb[d0 & 3] + (d0 >> 2) * 128;
        bf16x8 b0 = *reinterpret_cast<const LAS bf16x8*>(a);
        bf16x8 b1 = *reinterpret_cast<const LAS bf16x8*>(a + 32 * 256);
        p0 = __builtin_amdgcn_mfma_f32_32x32x16_bf16(b0, qr[d0], p0, 0, 0, 0);
        p1 = __builtin_amdgcn_mfma_f32_32x32x16_bf16(b1, qr[d0], p1, 0, 0, 0); }
}
template <int VB>
DI void pv_tile(f32x16* o, int vb0, bf16x8 pa0, bf16x8 pa1, bf16x8 pa2, bf16x8 pa3) {
#define TRRD(dst, off) asm volatile("ds_read_b64_tr_b16 %0, %1 offset:%2" : "=&v"(dst) : "v"(vb0), "i"(off) : "memory")
#define PV_D0(d0) do { s16x4 l0, l1, l2, l3, h0, h1, h2, h3; constexpr int b_ = VB * SHM_V + v_rd_off(d0, 0, 0);   \
        TRRD(l0, b_); TRRD(h0, b_ + 2048); TRRD(l1, b_ + 4096); TRRD(h1, b_ + 6144); TRRD(l2, b_ + 8192); TRRD(h2, b_ + 10240); TRRD(l3, b_ + 12288); TRRD(h3, b_ + 14336); \
        asm volatile("s_waitcnt lgkmcnt(0)" ::: "memory"); SBAR();   \
        o[d0] = __builtin_amdgcn_mfma_f32_32x32x16_bf16(pa0, (bf16x8){l0[0], l0[1], l0[2], l0[3], h0[0], h0[1], h0[2], h0[3]}, o[d0], 0, 0, 0);   \
        o[d0] = __builtin_amdgcn_mfma_f32_32x32x16_bf16(pa1, (bf16x8){l1[0], l1[1], l1[2], l1[3], h1[0], h1[1], h1[2], h1[3]}, o[d0], 0, 0, 0);   \
        o[d0] = __builtin_amdgcn_mfma_f32_32x32x16_bf16(pa2, (bf16x8){l2[0], l2[1], l2[2], l2[3], h2[0], h2[1], h2[2], h2[3]}, o[d0], 0, 0, 0);   \
        o[d0] = __builtin_amdgcn_mfma_f32_32x32x16_bf16(pa3, (bf16x8){l3[0], l3[1], l3[2], l3[3], h3[0], h3[1], h3[2], h3[3]}, o[d0], 0, 0, 0); } while (0)
    PV_D0(0); PV_D0(1); PV_D0(2); PV_D0(3);
#undef PV_D0
#undef TRRD
}
struct Stage { bf16x8 k0, k1, v0, v1; };
DI void sload(Stage& s, const bf16_t* Kp, const bf16_t* Vp, size_t tokbase, int k0, int sr, int hcol) {
    const size_t o0 = (tokbase + k0 + sr) * DM + hcol, o1 = o0 + (size_t)32 * DM;
    s.v0 = *(const bf16x8*)(Vp + o0); s.v1 = *(const bf16x8*)(Vp + o1); s.k0 = *(const bf16x8*)(Kp + o0); s.k1 = *(const bf16x8*)(Kp + o1);
}
DI void swrite(const Stage& s, LAS char* V_lds, LAS char* K_lds, int bf, int kws, int vst0, int vst1) {
    *(LAS bf16x8*)(V_lds + bf * SHM_V + vst0) = s.v0; *(LAS bf16x8*)(V_lds + bf * SHM_V + vst1) = s.v1;
    *(LAS bf16x8*)(K_lds + bf * SHM_K + kws) = s.k0; *(LAS bf16x8*)(K_lds + bf * SHM_K + kws + 32 * 256) = s.k1;
}
DI void store_o(const f32x16* o, const float* rli, bf16_t* Ow, int r32, int hi) {
#pragma unroll
    for (int r = 0; r < 16; ++r) { const int orow = crow(r, hi);
#pragma unroll
        for (int d0 = 0; d0 < 4; ++d0) { const float v = o[d0][r] * rli[r]; const float vn = __shfl_xor(v, 1);
            if ((r32 & 1) == 0) *(unsigned*)(Ow + (size_t)orow * DM + d0 * 32 + r32) = cvt_pk_bf16(v, vn); } }
}

DI void attnA_phase(const Frame& F) {
    const bf16_t* Q = (const bf16_t*)(F.ws + WS_R1); const bf16_t* Kt = Q + (size_t)NTOK * DM; const bf16_t* Vt = Kt + (size_t)NTOK * DM;
    bf16_t* O = (bf16_t*)(F.ws + WS_HF + 64 * MiB); const u64* MASK = (const u64*)(F.ws + WS_HF + HF_MASK);
    LAS char* V_lds = (LAS char*)F.lds; LAS char* K_lds = V_lds + 2 * SHM_V;
    const int tid = F.tid, wid = F.wave, lane = F.lane, r32 = lane & 31, hi = lane >> 5;
    LAS float* wsl = (LAS float*)(F.lds + 2 * SHM_V + 2 * SHM_K) + wid * 64; LAS float* li_l = wsl; LAS float* al_l = wsl + 32;
    const int sr = tid >> 4, sc = (tid & 15) * 8, vst0 = v_st(sr, sc), vst1 = v_st(32 + sr, sc), kws = KSWZ(sr, sc * 2);
    const int vb0 = (int)(uintptr_t)V_lds + v_rd_base(lane);
    constexpr int NITEM = NB * NH * 8;
    for (int it = F.bid; it < NITEM; it += F.G) {
        int bh, qb;
        if (F.G == 256) { const int pass = it >> 8, xcd = F.bid & 7, slot = F.bid >> 3, grp = slot >> 3, mem = slot & 7; bh = (pass * 4 + grp) * 8 + xcd; qb = (pass & 1) ? 7 - mem : mem; }
        else { bh = it >> 3; qb = it & 7; }
        const int b = bh >> 3, h = bh & 7, q0 = qb * QB, NT = 4 * (qb + 1);
        const size_t tokbase = (size_t)b * SEQ; const int hcol = h * HD + sc;
        const int qrow = q0 + wid * QBLK + r32, myc = (q0 + wid * QBLK) >> 6;
        bf16x8 qr[8];
#pragma unroll
        for (int d0 = 0; d0 < 8; ++d0) qr[d0] = *(const bf16x8*)(Q + (tokbase + qrow) * DM + h * HD + d0 * 16 + hi * 8);
        const u64* mrow = MASK + (tokbase + qrow) * 32;
        float m_reg = -1e30f, l_reg = 0.f; f32x16 o[4] = {};
        Stage st; sload(st, Kt, Vt, tokbase, 0, sr, hcol);
        u64 mw = mrow[0], mwn = mrow[1];
        asm volatile("s_waitcnt vmcnt(0)" ::: "memory");
        swrite(st, V_lds, K_lds, 0, kws, vst0, vst1);
        __syncthreads();
        f32x16 pA0, pA1, pB0, pB1; float mnA, mnB, alA = 1.f, alB = 1.f; bf16x8 pa0, pa1, pa2, pa3;
#define A_MSEL(P, M, BIT) do { const unsigned t_ = (unsigned)__builtin_amdgcn_sbfe((int)(M), (BIT), 1); P = __uint_as_float((__float_as_uint(P) & t_) | (__float_as_uint(ninf_) & ~t_)); } while (0)
#define A_MASK(P0, P1) do { const unsigned mlo = (unsigned)mw >> (4 * hi), mhi = (unsigned)(mw >> 32) >> (4 * hi); const float ninf_ = -__builtin_inff(); \
            _Pragma("unroll") for (int r = 0; r < 16; ++r) { A_MSEL(P0[r], mlo, (r & 3) + 8 * (r >> 2)); A_MSEL(P1[r], mhi, (r & 3) + 8 * (r >> 2)); } } while (0)
#define A_RESC(a) do { if (__any((a) < 1.f)) { if (hi == 0) al_l[r32] = (a); LDS_WAIT();                              \
                _Pragma("unroll") for (int d_ = 0; d_ < 4; ++d_) _Pragma("unroll") for (int r = 0; r < 16; ++r) o[d_][r] *= al_l[crow(r, hi)]; } } while (0)
        sload(st, Kt, Vt, tokbase, KVBLK, sr, hcol);
        qkt<0>(pA0, pA1, K_lds, r32, hi, qr);
        A_MASK(pA0, pA1); partialSM(pA0, pA1, m_reg, mnA, alA);
        asm volatile("s_waitcnt vmcnt(0)" ::: "memory"); swrite(st, V_lds, K_lds, 1, kws, vst0, vst1); mw = mwn;
        __syncthreads();
#define A_HALF(PX0, PX1, mnX, alX, PY0, PY1, alY, t, KB, VB, SB) do { const bool actT = (t) <= myc, actP = (t) - 1 <= myc, more = (t) + 1 < NT; \
        if (more) mwn = mrow[(t) + 1];                                                                              \
        SBAR(); if (actT) qkt<KB>(PX0, PX1, K_lds, r32, hi, qr);                                                    \
        if (actP) { finishSM(PY0, PY1, alY, l_reg, pa0, pa1, pa2, pa3); } SBAR();                                   \
        if (more) sload(st, Kt, Vt, tokbase, ((t) + 1) * KVBLK, sr, hcol);                                          \
        SBAR(); if (actP) pv_tile<VB>(o, vb0, pa0, pa1, pa2, pa3);                                                  \
        if (actT) { A_MASK(PX0, PX1); partialSM(PX0, PX1, m_reg, mnX, alX); }                                       \
        __syncthreads();                                                                                            \
        if (more) { asm volatile("s_waitcnt vmcnt(0)" ::: "memory"); swrite(st, V_lds, K_lds, SB, kws, vst0, vst1); } \
        mw = mwn;                                                                                                   \
        if (actT) A_RESC(alX);                                                                                      \
        __syncthreads(); } while (0)
        for (int t = 1; t + 1 < NT; t += 2) {
            A_HALF(pB0, pB1, mnB, alB, pA0, pA1, alA, t, 1, 0, 0);
            A_HALF(pA0, pA1, mnA, alA, pB0, pB1, alB, t + 1, 0, 1, 1);
        }
        { const bool actT = NT - 1 <= myc, actP = NT - 2 <= myc;
          SBAR(); if (actT) qkt<1>(pB0, pB1, K_lds, r32, hi, qr);
          if (actP) { finishSM(pA0, pA1, alA, l_reg, pa0, pa1, pa2, pa3); SBAR(); pv_tile<0>(o, vb0, pa0, pa1, pa2, pa3); }
          if (actT) { A_MASK(pB0, pB1); partialSM(pB0, pB1, m_reg, mnB, alB); A_RESC(alB);
                      finishSM(pB0, pB1, alB, l_reg, pa0, pa1, pa2, pa3); SBAR(); pv_tile<1>(o, vb0, pa0, pa1, pa2, pa3); } }
#undef A_HALF
#undef A_MASK
#undef A_MSEL
#undef A_RESC
        if (hi == 0) li_l[r32] = l_reg; LDS_WAIT();
        float rli[16];
#pragma unroll
        for (int r = 0; r < 16; ++r) rli[r] = __builtin_amdgcn_rcpf(li_l[crow(r, hi)]);
        store_o(o, rli, O + (tokbase + q0 + wid * QBLK) * DM + h * HD, r32, hi);
        __syncthreads();
    }
}

DI void attnB_phase(const Frame& F) {
    const bf16_t* Q = (const bf16_t*)(F.ws + WS_R1); const bf16_t* Kt = Q + (size_t)NTOK * DM; const bf16_t* Vt = Kt + (size_t)NTOK * DM;
    bf16_t* O = (bf16_t*)(F.ws + WS_HF + 64 * MiB);
    LAS char* V_lds = (LAS char*)F.lds; LAS char* K_lds = V_lds + 3 * SHM_V;
    const int tid = F.tid, wid = F.wave, lane = F.lane, r32 = lane & 31, hi = lane >> 5;
    LAS int* flags = (LAS int*)(F.lds + 3 * SHM_V + 3 * SHM_K);
    const int vb0 = (int)(uintptr_t)V_lds + v_rd_base(lane);
    unsigned offK[2], offV[2];
#pragma unroll
    for (int i = 0; i < 2; ++i) { const int p = i * 512 + wid * 64 + lane;
        { const int row = p >> 4, ch = (p & 15) ^ (row & 7); offK[i] = (unsigned)(row * DM + ch * 8) * 2u; }
        { const int sub = p >> 5, kk = (sub >> 2) * 8 + ((p & 31) >> 2), col = (sub & 3) * 32 + (p & 3) * 8, k = (kk & ~0xC) | ((kk & 4) << 1) | ((kk & 8) >> 1); offV[i] = (unsigned)(k * DM + col) * 2u; } }
    const unsigned ldsw = (unsigned)wid * 1024u;
    constexpr float C2 = 1.4426950408889634f * SCALE;
    constexpr int NITEM = NB * NH * 8;
    for (int it = F.bid; it < NITEM; it += F.G) {
        int bh, qb;
        if (F.G == 256) { const int pass = it >> 8, xcd = F.bid & 7, slot = F.bid >> 3, grp = slot >> 3, mem = slot & 7; bh = (pass * 4 + grp) * 8 + xcd; qb = (pass & 1) ? 7 - mem : mem; }
        else { bh = it >> 3; qb = it & 7; }
        const int b = bh >> 3, h = bh & 7, q0 = qb * QB;
        const size_t tokbase = (size_t)b * SEQ;
        const int qw0 = q0 + wid * QBLK, qrow = qw0 + r32, t_hi = 4 * (qb + 1) - 1, t_w = (qw0 + QBLK - 1) >> 6;
        const char* Kb = (const char*)(Kt + tokbase * DM + h * HD); const char* Vb = (const char*)(Vt + tokbase * DM + h * HD);
        bf16x8 qr[8];
#pragma unroll
        for (int d0 = 0; d0 < 8; ++d0) qr[d0] = *(const bf16x8*)(Q + (tokbase + qrow) * DM + h * HD + d0 * 16 + hi * 8);
        float carry = 1.f; int done_w = 0; f32x16 o[4] = {};
#define B_DMA(t_, SLOT) do { const size_t tb_ = (size_t)(t_) * KVBLK * DM * 2; _Pragma("unroll") for (int i = 0; i < 2; ++i) { \
            __builtin_amdgcn_global_load_lds((const unsigned*)(Kb + tb_ + offK[i]), (LAS unsigned*)(K_lds + (SLOT) * SHM_K + ldsw + i * 8192), 16, 0, 0); \
            __builtin_amdgcn_global_load_lds((const unsigned*)(Vb + tb_ + offV[i]), (LAS unsigned*)(V_lds + (SLOT) * SHM_V + ldsw + i * 8192), 16, 0, 0); } } while (0)
        asm volatile("s_waitcnt vmcnt(0)" ::: "memory");
        B_DMA(t_hi, 0); B_DMA(t_hi - 1, 1);
        asm volatile("s_waitcnt vmcnt(4)" ::: "memory");
        __builtin_amdgcn_s_barrier(); asm volatile("" ::: "memory");
        bool stop = false;
#define B_STEP(itn, SLOT, SLOTW) do { const int t = t_hi - (itn); const bool more = t > 0, more2 = t > 1;              \
        if (more2) B_DMA(t - 2, SLOTW);                                                                             \
        if (t <= t_w && !done_w) { f32x16 p0, p1, l0v, l1v; bf16x8 pa0, pa1, pa2, pa3;                               \
            qkt<SLOT>(p0, p1, K_lds, r32, hi, qr);                                                                  \
            const int dq = qrow - t * KVBLK - 4 * hi;                                                               \
              \
            _Pragma("unroll") for (int r = 0; r < 16; ++r) { const int cr = (r & 3) + 8 * (r >> 2);                 \
                const float e0 = __builtin_amdgcn_exp2f(-fmaxf(p0[r] * C2, -100.f)), e1 = __builtin_amdgcn_exp2f(-fmaxf(p1[r] * C2, -100.f)); \
                const float g0 = __builtin_amdgcn_rcpf(1.0f + e0), g1 = __builtin_amdgcn_rcpf(1.0f + e1);         \
                const bool v0 = cr < dq, v1 = cr + 32 < dq;                                                         \
                p0[r] = v0 ? g0 : 0.f; p1[r] = v1 ? g1 : 0.f;                                                       \
                l0v[r] = v0 ? e0 * g0 : 1.f; l1v[r] = v1 ? e1 * g1 : 1.f; }                                         \
            float gs[8];                                                                                            \
            _Pragma("unroll") for (int g = 0; g < 4; ++g) { gs[g] = (l0v[4 * g] * l0v[4 * g + 1]) * (l0v[4 * g + 2] * l0v[4 * g + 3]); \
                                                            gs[4 + g] = (l1v[4 * g] * l1v[4 * g + 1]) * (l1v[4 * g + 2] * l1v[4 * g + 3]); } \
            float acc = carry;                                                                                      \
            _Pragma("unroll") for (int g = 7; g >= 0; --g) {                                                        \
                auto rr = __builtin_amdgcn_permlane32_swap(__float_as_uint(gs[g]), __float_as_uint(gs[g]), false, false); \
                const float slo = __uint_as_float(rr[0]), shi = __uint_as_float(rr[1]);                             \
                float run = acc * (hi ? 1.f : shi);                                                                 \
                _Pragma("unroll") for (int j = 3; j >= 0; --j) { const int r = 4 * (g & 3) + j;                     \
                    if (g >= 4) { const float a_ = p1[r] * run; run *= l1v[r]; p1[r] = a_; }                        \
                    else        { const float a_ = p0[r] * run; run *= l0v[r]; p0[r] = a_; } }                      \
                acc *= slo * shi; }                                                                                 \
            carry = acc;                                                                                            \
            packP(p0, p1, pa0, pa1, pa2, pa3); SBAR();                                                              \
            pv_tile<SLOT>(o, vb0, pa0, pa1, pa2, pa3);                                                              \
            done_w = __all(carry < 1.0e-37f) ? 1 : 0; }                                                                     \
        if (lane == 0) flags[((itn) & 1) * 8 + wid] = done_w;                                                       \
        if (more2) asm volatile("s_waitcnt vmcnt(4)" ::: "memory"); else asm volatile("s_waitcnt vmcnt(0)" ::: "memory");     \
        LDS_WAIT(); __builtin_amdgcn_s_barrier(); asm volatile("" ::: "memory");                                    \
        { int alld = 1; _Pragma("unroll") for (int w = 0; w < 8; ++w) alld &= flags[((itn) & 1) * 8 + w]; stop = (alld != 0) || !more; } } while (0)
        for (int itn = 0;; itn += 3) { B_STEP(itn, 0, 2); if (stop) break; B_STEP(itn + 1, 1, 0); if (stop) break; B_STEP(itn + 2, 2, 1); if (stop) break; }
#undef B_STEP
#undef B_DMA
        asm volatile("s_waitcnt vmcnt(0)" ::: "memory");
        float rli[16];
#pragma unroll
        for (int r = 0; r < 16; ++r) rli[r] = 1.0f;
        store_o(o, rli, O + (tokbase + qw0) * DM + h * HD, r32, hi);
        __syncthreads();
    }
}
#undef PK4
}

DI void route16(const float (&lg)[16], const float (&bias)[16], int& e0, int& e1, float& w0, float& w1) {
    float mx = lg[0];
#pragma unroll
    for (int i = 1; i < 16; ++i) mx = fmaxf(mx, lg[i]);
    float pr[16], sum = 0.f;
#pragma unroll
    for (int i = 0; i < 16; ++i) { pr[i] = __builtin_amdgcn_exp2f((lg[i] - mx) * 1.4426950408889634f); sum += pr[i]; }
    float sel[16];
#pragma unroll
    for (int i = 0; i < 16; ++i) { pr[i] = pr[i] / sum; sel[i] = pr[i] + bias[i]; }
    float gsc[4];
#pragma unroll
    for (int g = 0; g < 4; ++g) { const float a = sel[4 * g], b = sel[4 * g + 1], c = sel[4 * g + 2], d = sel[4 * g + 3];
        gsc[g] = fmaxf(fmaxf(fmaxf(a + b, a + c), fmaxf(a + d, b + c)), fmaxf(b + d, c + d)); }
    int g = 0; float best = gsc[0];
#pragma unroll
    for (int i = 1; i < 4; ++i) if (gsc[i] > best) { best = gsc[i]; g = i; }
    float xs[4], ps[4];
#pragma unroll
    for (int j = 0; j < 4; ++j) { xs[j] = (g == 0) ? sel[j] : (g == 1) ? sel[4 + j] : (g == 2) ? sel[8 + j] : sel[12 + j];
                                  ps[j] = (g == 0) ? pr[j] : (g == 1) ? pr[4 + j] : (g == 2) ? pr[8 + j] : pr[12 + j]; }
    int i1 = 0; float b1 = xs[0];
#pragma unroll
    for (int j = 1; j < 4; ++j) if (xs[j] > b1) { b1 = xs[j]; i1 = j; }
    int i2 = -1; float b2 = -__builtin_inff();
#pragma unroll
    for (int j = 0; j < 4; ++j) if (j != i1 && (i2 < 0 || xs[j] > b2)) { b2 = xs[j]; i2 = j; }
    const float p1 = (i1 == 0) ? ps[0] : (i1 == 1) ? ps[1] : (i1 == 2) ? ps[2] : ps[3];
    const float p2 = (i2 == 0) ? ps[0] : (i2 == 1) ? ps[1] : (i2 == 2) ? ps[2] : ps[3];
    const float s = p1 + p2;
    e0 = 4 * g + i1; e1 = 4 * g + i2; w0 = p1 / s; w1 = p2 / s;
}

DI f32x4 bf4(u32x2 a) { f32x4 r; r[0] = __uint_as_float(a.x << 16); r[1] = __uint_as_float(a.x & 0xFFFF0000u); r[2] = __uint_as_float(a.y << 16); r[3] = __uint_as_float(a.y & 0xFFFF0000u); return r; }
struct LnRow { f32x4 hp[4]; u32x2 hb[4], ya[4], yb[4]; };
template <bool HPF, int NADD>
DI void ln_load(LnRow& R, size_t row, int lane, const void* hprev, const bf16_t* y0, const bf16_t* y1) {
#pragma unroll
    for (int i = 0; i < 4; ++i) { const size_t off = row * DM + 4 * lane + 256 * i;
        if (HPF) R.hp[i] = *(const f32x4*)((const float*)hprev + off); else R.hb[i] = *(const u32x2*)((const bf16_t*)hprev + off);
        R.ya[i] = *(const u32x2*)(y0 + off);
        if (NADD == 2) R.yb[i] = *(const u32x2*)(y1 + off); }
}
template <bool HPF, int NADD, bool OUTF>
DI void ln_row(LnRow& R, f32x4 (&v)[4], size_t row, int lane, const f32x4 (&g4)[4], const f32x4 (&b4)[4], void* out, signed char* out8, float* sc8) {
#pragma unroll
    for (int i = 0; i < 4; ++i) { f32x4 ad = bf4(R.ya[i]); if (NADD == 2) ad = ad + bf4(R.yb[i]);
        const f32x4 hp = HPF ? R.hp[i] : bf4(R.hb[i]);
        v[i] = hp * DN_ALPHA + ad; }
    float s = 0.f;
#pragma unroll
    for (int i = 0; i < 4; ++i) s += (v[i][0] + v[i][1]) + (v[i][2] + v[i][3]);
    const float mean = wave_sum(s) * (1.0f / DM);
    float q = 0.f;
#pragma unroll
    for (int i = 0; i < 4; ++i) { v[i] = v[i] - mean; q += (v[i][0] * v[i][0] + v[i][1] * v[i][1]) + (v[i][2] * v[i][2] + v[i][3] * v[i][3]); }
    const float rstd = __builtin_amdgcn_rsqf(wave_sum(q) * (1.0f / DM) + LN_EPS);
#pragma unroll
    for (int i = 0; i < 4; ++i) { v[i] = v[i] * rstd * g4[i] + b4[i]; const size_t off = row * DM + 4 * lane + 256 * i;
        if (OUTF) *(f32x4*)((float*)out + off) = v[i];
        else { u32x2 w; w.x = cvt_pk_bf16(v[i][0], v[i][1]); w.y = cvt_pk_bf16(v[i][2], v[i][3]); *(u32x2*)((bf16_t*)out + off) = w; } }
    if (out8) quant_row(v, lane, out8 + row * DM, sc8 + row);
}
DI float tr_reduce16(float (&pe)[16], int lane) {
    float r8[8], r4[4], r2[2], r1;
#pragma unroll
    for (int k = 0; k < 8; ++k) { const bool od = lane & 1; const float keep = od ? pe[2 * k + 1] : pe[2 * k], send = od ? pe[2 * k] : pe[2 * k + 1]; r8[k] = keep + __shfl_xor(send, 1); }
#pragma unroll
    for (int k = 0; k < 4; ++k) { const bool od = lane & 2; const float keep = od ? r8[2 * k + 1] : r8[2 * k], send = od ? r8[2 * k] : r8[2 * k + 1]; r4[k] = keep + __shfl_xor(send, 2); }
#pragma unroll
    for (int k = 0; k < 2; ++k) { const bool od = lane & 4; const float keep = od ? r4[2 * k + 1] : r4[2 * k], send = od ? r4[2 * k] : r4[2 * k + 1]; r2[k] = keep + __shfl_xor(send, 4); }
    { const bool od = lane & 8; const float keep = od ? r2[1] : r2[0], send = od ? r2[0] : r2[1]; r1 = keep + __shfl_xor(send, 8); }
    r1 += __shfl_xor(r1, 16); r1 += __shfl_xor(r1, 32);
    return r1;
}
DI void router_rows2(const f32x4 (&va)[4], const f32x4 (&vb)[4], const LAS float* wrT, int lane, float& la, float& lb) {
    float pa[16], pb[16];
#pragma unroll
    for (int e = 0; e < 16; ++e) { float a = 0.f, b = 0.f;
#pragma unroll
        for (int i = 0; i < 4; ++i) { const f32x4 w = *(const LAS f32x4*)(wrT + e * DM + 4 * lane + 256 * i);
            a += (va[i][0] * w[0] + va[i][1] * w[1]) + (va[i][2] * w[2] + va[i][3] * w[3]);
            b += (vb[i][0] * w[0] + vb[i][1] * w[1]) + (vb[i][2] * w[2] + vb[i][3] * w[3]); }
        pa[e] = a; pb[e] = b; }
    la = tr_reduce16(pa, lane); lb = tr_reduce16(pb, lane);
}
template <bool HPF, int NADD, bool OUTF, bool ROUTER>
DI void ln_phase(const Frame& F, const void* hprev, const bf16_t* y0, const bf16_t* y1, const float* gam, const float* bet, void* out,
                 const float* router_w, const float* router_b, unsigned* cnt, int* list, float* gatew, signed char* out8 = nullptr, float* sc8 = nullptr) {
    LAS float* wrT = (LAS float*)F.lds;
    LAS float* lsc = (LAS float*)(F.lds + 16 * DM * 4) + F.wave * 272;
    float rb[16];
    if (ROUTER) {
        for (int idx = F.tid; idx < 16 * DM; idx += 512) { const int e = idx >> 10, c = idx & 1023; wrT[idx] = router_w[c * 16 + e]; }
#pragma unroll
        for (int e = 0; e < 16; ++e) rb[e] = router_b[e];
        __syncthreads();
    }
    const int lane = F.lane;
    f32x4 g4[4], b4[4];
#pragma unroll
    for (int i = 0; i < 4; ++i) { g4[i] = *(const f32x4*)(gam + 4 * lane + 256 * i); b4[i] = *(const f32x4*)(bet + 4 * lane + 256 * i); }
    for (int c0 = F.bid * 8; c0 < NTOK / 16; c0 += F.G * 8) {
        const int chunk = c0 + F.wave; const bool cvalid = chunk < NTOK / 16;
        const size_t row0 = (size_t)(cvalid ? chunk : 0) * 16;
        if (cvalid) {
            LnRow RA, RB; f32x4 va[4], vb[4];
            ln_load<HPF, NADD>(RA, row0, lane, hprev, y0, y1);
#pragma unroll 1
            for (int ri = 0; ri < 16; ri += 2) {
                ln_load<HPF, NADD>(RB, row0 + ri + 1, lane, hprev, y0, y1);
                ln_row<HPF, NADD, OUTF>(RA, va, row0 + ri, lane, g4, b4, out, out8, sc8);
                if (ri + 2 < 16) ln_load<HPF, NADD>(RA, row0 + ri + 2, lane, hprev, y0, y1);
                ln_row<HPF, NADD, OUTF>(RB, vb, row0 + ri + 1, lane, g4, b4, out, out8, sc8);
                if (ROUTER) { float la, lb; router_rows2(va, vb, wrT, lane, la, lb); if (lane < 16) { lsc[ri * 17 + lane] = la; lsc[(ri + 1) * 17 + lane] = lb; } }
            }
        }
        if (ROUTER) {
            LDS_WAIT();
            float lg[16];
#pragma unroll
            for (int e = 0; e < 16; ++e) lg[e] = lsc[(lane & 15) * 17 + e];
            LDS_WAIT();
            int my_e0, my_e1; float my_w0, my_w1; route16(lg, rb, my_e0, my_e1, my_w0, my_w1);
            const size_t row = row0 + lane; const bool act = lane < 16 && cvalid;
            const u64 ltmask = (1ull << lane) - 1ull;
            LAS unsigned* wcnt = (LAS unsigned*)(F.lds + 16 * DM * 4 + 8 * 272 * 4);
            LAS unsigned* wbase = wcnt + 128;
            unsigned mycnt = 0;
#pragma unroll
            for (int e = 0; e < NEXP; ++e) { const unsigned n = popc64(__ballot(act && my_e0 == e)) + popc64(__ballot(act && my_e1 == e)); mycnt = (lane == e) ? n : mycnt; }
            if (lane < 16) wcnt[F.wave * 16 + lane] = mycnt;
            __syncthreads();
            if (F.wave == 0 && lane < 16) { unsigned tot = 0, pre[8];
#pragma unroll
                for (int w = 0; w < 8; ++w) { pre[w] = tot; tot += wcnt[w * 16 + lane]; }
                const unsigned base = tot ? atomicAdd(cnt + 64 * lane, tot) : 0u;
#pragma unroll
                for (int w = 0; w < 8; ++w) wbase[w * 16 + lane] = base + pre[w]; }
            __syncthreads();
#pragma unroll 1
            for (int e = 0; e < NEXP; ++e) {
                const u64 m0 = __ballot(act && my_e0 == e), m1 = __ballot(act && my_e1 == e);
                const unsigned n0 = popc64(m0);
                if (m0 | m1) { const unsigned base = wbase[F.wave * 16 + e];
                    if (act && my_e0 == e) { const size_t p = (size_t)e * LISTCAP + base + popc64(m0 & ltmask); list[p] = (int)(row * 2); gatew[p] = my_w0; }
                    if (act && my_e1 == e) { const size_t p = (size_t)e * LISTCAP + base + n0 + popc64(m1 & ltmask); list[p] = (int)(row * 2 + 1); gatew[p] = my_w1; } }
            }
            __syncthreads();
        }
    }
    if (ROUTER) __syncthreads();
}

DI void moe_table(const Frame& F, const unsigned* cnt) {
    LAS int* tab = (LAS int*)(F.lds + MISC_OFF + 64);
    if (F.tid == 0) { int acc = 0;
        for (int e = 0; e < NEXP; ++e) { const int c = (int)__hip_atomic_load(cnt + 64 * e, __ATOMIC_RELAXED, __HIP_MEMORY_SCOPE_AGENT); tab[e] = acc; tab[17 + e] = c; acc += (c + 255) >> 8; }
        tab[16] = acc; }
    __syncthreads();
}


__global__ void __launch_bounds__(512, 2) yoco_fwd(Args args) {
    extern __shared__ __attribute__((aligned(16))) unsigned char lds_raw[];
    Frame F;
    F.lds = (LAS unsigned char*)lds_raw; F.tid = threadIdx.x; F.lane = F.tid & 63; F.wave = __builtin_amdgcn_readfirstlane(F.tid >> 6);
    F.G = gridDim.x; F.bid = blockIdx.x; F.ws = args.ws; F.ctl = (unsigned*)(args.ws + WS_CTL);
    volatile LAS unsigned* misc = (volatile LAS unsigned*)(F.lds + MISC_OFF);
    if (F.tid < 4) misc[F.tid] = 0u;
    __syncthreads();
    XcdBarrier bar; bar.bar = F.ctl + CW_BAR; bar.x = 0; bar.st = misc;
    const int lo = args.ph_lo, hi = args.ph_hi;
    if (hi - lo > 1) bar = xcd_barrier_post(F.ctl + CW_BAR, misc);
#define IN(k) (lo <= (k) && (k) < hi)
#define SEAM(k) do { if (IN(k) && IN((k) + 1)) xcd_barrier(bar); } while (0)
    unsigned char* ws = args.ws;
    bf16_t* XB = (bf16_t*)(ws + WS_XB);
    bf16_t* QKV = (bf16_t*)(ws + WS_R1); bf16_t* MIX = (bf16_t*)(ws + WS_R1); bf16_t* OB = (bf16_t*)(ws + WS_HF + 64 * MiB);
    bf16_t* Y = (bf16_t*)(ws + WS_R1); bf16_t* HE = (bf16_t*)(ws + WS_R1 + R1_HE);
    int* LIST = (int*)(ws + WS_MOE); float* GATEW = (float*)(ws + WS_MOE + 2 * MiB);
    const float* ln_g = args.in[11]; const float* ln_b = args.in[12];
    LAS int* tab = (LAS int*)(F.lds + MISC_OFF + 64);

    if (IN(0)) { p0_prologue(F, args); } SEAM(0);
    if (IN(1)) {
        pg8::SchedDense S; S.init((const bf16_t*)(ws + WS_XB8), (const bf16_t*)(ws + WS_WAIN), NTOK, NIN, DM / 2, F.G, F.bid);
        S.sA = (const float*)(ws + WS_SCL + SCL_SA); S.sB = (const float*)(ws + WS_SCL + SCL_SBIN);
        const float* c128 = (const float*)(ws + WS_ROPE);
        pg8::EpiInProj E{QKV, (bf16_t*)(ws + WS_HF + HF_QI), (bf16_t*)(ws + WS_HF + HF_KI), (float*)(ws + WS_HF + HF_WI), c128, c128 + SEQ * 64, c128 + 2 * SEQ * 64, c128 + 2 * SEQ * 64 + SEQ * 32};
        pg8::gemm_phase<pg8::EpiInProj, pg8::SchedDense, true>(F.lds, S, E);
    } SEAM(1);
    if (IN(2)) { indexer_phase(F); } SEAM(2);
    if (IN(3)) { att::attnA_phase(F); } SEAM(3);
    if (IN(4)) {
        pg8::SchedDense S; S.init(OB, (const bf16_t*)(ws + WS_WAOUT), NTOK, DM, DM, F.G, F.bid);
        pg8::EpiBf16Split E{MIX, DM, DM, 0}; pg8::gemm_phase(F.lds, S, E);
    } SEAM(4);
    if (IN(5)) { ln_phase<true, 1, false, true>(F, args.in[0], MIX, nullptr, ln_g, ln_b, XB, args.in[6], args.in[7], F.ctl + CW_CNT, LIST, GATEW, (signed char*)(ws + WS_XB8), (float*)(ws + WS_SCL + SCL_SA)); } SEAM(5);
    if (IN(6)) {
        moe_table(F, F.ctl + CW_CNT);
        pg8::SchedMoe S{(const bf16_t*)(ws + WS_XB8), (const bf16_t*)(ws + WS_WGU), DM / 2, 2, (size_t)512 * DM, tab, LIST, 1, F.G, F.bid, (const float*)(ws + WS_SCL + SCL_SA), (const float*)(ws + WS_SCL + SCL_SBGU)};
        pg8::EpiMoe1 E{HE}; pg8::gemm_phase<pg8::EpiMoe1, pg8::SchedMoe, true>(F.lds, S, E);
    } SEAM(6);
    if (IN(7)) {
        moe_table(F, F.ctl + CW_CNT);
        pg8::SchedMoe S{HE, (const bf16_t*)(ws + WS_WD), FFE, 4, (size_t)DM * FFE * 2, tab, LIST, 0, F.G, F.bid};
        pg8::EpiMoe2 E{Y, LIST, GATEW, tab}; pg8::gemm_phase(F.lds, S, E);
    } SEAM(7);
    if (IN(8)) { ln_phase<false, 2, false, false>(F, XB, Y, Y + (size_t)NTOK * DM, ln_g + DM, ln_b + DM, XB, nullptr, nullptr, nullptr, nullptr, nullptr, (signed char*)(ws + WS_XB8), (float*)(ws + WS_SCL + SCL_SA)); } SEAM(8);
    if (IN(9)) {
        pg8::SchedDense S; S.init((const bf16_t*)(ws + WS_XB8), (const bf16_t*)(ws + WS_WBQKV), NTOK, 3 * DM, DM / 2, F.G, F.bid);
        S.sA = (const float*)(ws + WS_SCL + SCL_SA); S.sB = (const float*)(ws + WS_SCL + SCL_SBQKV);
        pg8::EpiBf16Split E{QKV, DM, DM, (size_t)NTOK * DM}; pg8::gemm_phase<pg8::EpiBf16Split, pg8::SchedDense, true>(F.lds, S, E);
    } SEAM(9);
    if (IN(10)) { att::attnB_phase(F); } SEAM(10);
    if (IN(11)) {
        pg8::SchedDense S; S.init(OB, (const bf16_t*)(ws + WS_WBOUT), NTOK, DM, DM, F.G, F.bid);
        pg8::EpiBf16Split E{MIX, DM, DM, 0}; pg8::gemm_phase(F.lds, S, E);
    } SEAM(11);
    if (IN(12)) { ln_phase<false, 1, false, true>(F, XB, MIX, nullptr, ln_g + 2 * DM, ln_b + 2 * DM, XB, args.in[6], args.in[7], F.ctl + CW_CNT + 2048, LIST, GATEW, (signed char*)(ws + WS_XB8), (float*)(ws + WS_SCL + SCL_SA)); } SEAM(12);
    if (IN(13)) {
        moe_table(F, F.ctl + CW_CNT + 2048);
        pg8::SchedMoe S{(const bf16_t*)(ws + WS_XB8), (const bf16_t*)((const signed char*)(ws + WS_WGU) + (size_t)NEXP * 512 * DM), DM / 2, 2, (size_t)512 * DM, tab, LIST, 1, F.G, F.bid, (const float*)(ws + WS_SCL + SCL_SA), (const float*)(ws + WS_SCL + SCL_SBGU) + NEXP * 512};
        pg8::EpiMoe1 E{HE}; pg8::gemm_phase<pg8::EpiMoe1, pg8::SchedMoe, true>(F.lds, S, E);
    } SEAM(13);
    if (IN(14)) {
        moe_table(F, F.ctl + CW_CNT + 2048);
        pg8::SchedMoe S{HE, (const bf16_t*)(ws + WS_WD) + (size_t)NEXP * DM * FFE, FFE, 4, (size_t)DM * FFE * 2, tab, LIST, 0, F.G, F.bid};
        pg8::EpiMoe2 E{Y, LIST, GATEW, tab}; pg8::gemm_phase(F.lds, S, E);
    } SEAM(14);
    if (IN(15)) { ln_phase<false, 2, true, false>(F, XB, Y, Y + (size_t)NTOK * DM, ln_g + 3 * DM, ln_b + 3 * DM, args.out, nullptr, nullptr, nullptr, nullptr, nullptr); }
#undef IN
#undef SEAM
}


extern "C" void kernel_launch(void* const* d_in, const int* in_sizes, int n_in, void* d_out, int out_size, void* d_ws, size_t ws_size, hipStream_t stream) {
    static int grid = 0;
    if (grid == 0) {
        if (n_in != 13 || in_sizes[0] != NTOK * DM || out_size != NTOK * DM || ws_size < WS_END) {
            fprintf(stderr, "kernel_launch: unexpected shapes (n_in %d, in0 %d, out %d, ws %zu < %zu)\n", n_in, n_in > 0 ? in_sizes[0] : -1, out_size, ws_size, (size_t)WS_END); grid = -1; return; }
        int dev = 0, cus = 0, per_cu = 0;
        if (hipGetDevice(&dev) != hipSuccess || hipDeviceGetAttribute(&cus, hipDeviceAttributeMultiprocessorCount, dev) != hipSuccess) { grid = -1; return; }
        if (hipFuncSetAttribute((const void*)yoco_fwd, hipFuncAttributeMaxDynamicSharedMemorySize, LDS_BYTES) != hipSuccess) { fprintf(stderr, "kernel_launch: hipFuncSetAttribute failed\n"); grid = -1; return; }
        if (hipOccupancyMaxActiveBlocksPerMultiprocessor(&per_cu, (const void*)yoco_fwd, 512, LDS_BYTES) != hipSuccess || per_cu < 1)
            fprintf(stderr, "kernel_launch: occupancy query reports %d\n", per_cu);
        (void)hipGetLastError();
        grid = cus;
    }
    if (grid < 0) return;
    (void)hipMemsetAsync((char*)d_ws + WS_CTL, 0, CTL_BYTES, stream);
    Args a; memset(&a, 0, sizeof(a));
    for (int i = 0; i < 13; ++i) a.in[i] = (const float*)d_in[i];
    a.out = (float*)d_out; a.ws = (unsigned char*)d_ws;
#if MK_N_LAUNCHES == 1
    a.ph_lo = 0; a.ph_hi = NPH;
    hipLaunchKernelGGL(yoco_fwd, dim3(grid), dim3(512), LDS_BYTES, stream, a);
#else
    for (int p = 0; p < NPH; ++p) { a.ph_lo = p; a.ph_hi = p + 1; hipLaunchKernelGGL(yoco_fwd, dim3(grid), dim3(512), LDS_BYTES, stream, a);
#ifdef REPMASK
        if ((REPMASK >> p) & 1) hipLaunchKernelGGL(yoco_fwd, dim3(grid), dim3(512), LDS_BYTES, stream, a);
#endif
    }
#endif
}
```

```cpp
#include <hip/hip_runtime.h>
#include <cstdio>
#include <cstdint>
#include <cstring>

#ifndef MK_N_LAUNCHES
#define MK_N_LAUNCHES 1
#endif

#define LAS __attribute__((address_space(3)))
#define DI __device__ __forceinline__
typedef unsigned short bf16_t;
typedef short bf16x8 __attribute__((ext_vector_type(8)));
typedef short s16x4 __attribute__((ext_vector_type(4)));
typedef float f32x2 __attribute__((ext_vector_type(2)));
typedef float f32x4 __attribute__((ext_vector_type(4)));
typedef float f32x16 __attribute__((ext_vector_type(16)));
typedef unsigned u32x2 __attribute__((ext_vector_type(2)));
typedef unsigned u32x4 __attribute__((ext_vector_type(4)));
typedef unsigned long long u64;

constexpr int NB = 16, SEQ = 2048, DM = 1024, NTOK = NB * SEQ, NH = 8, HD = 128;
constexpr int AIN = 3656, NIN = 3840;
constexpr int NEXP = 16, FFE = 256, LISTCAP = NTOK;
constexpr int TOPK = 256;
constexpr float LN_EPS = 1e-5f;
constexpr float DN_ALPHA = 1.41421356237309515f;
constexpr int NPH = 16;
constexpr int LDS_BYTES = 160 * 1024;
constexpr int MISC_OFF = LDS_BYTES - 1024;

constexpr size_t MiB = 1u << 20;
constexpr size_t WS_CTL = 0, CTL_BYTES = 64 * 1024;
constexpr size_t WS_WAIN = 1 * MiB;
constexpr size_t WS_WAOUT = WS_WAIN + (size_t)NIN * DM * 2;
constexpr size_t WS_WBQKV = WS_WAOUT + 2 * MiB;
constexpr size_t WS_WBOUT = WS_WBQKV + 6 * MiB;
constexpr size_t WS_WGU = WS_WBOUT + 2 * MiB;
constexpr size_t WS_WD = WS_WGU + 32 * MiB;
constexpr size_t WS_ROPE = WS_WD + 16 * MiB;
constexpr size_t WS_MOE = WS_ROPE + 2 * MiB;
constexpr size_t WS_XB = WS_MOE + 6 * MiB;
constexpr size_t WS_R1 = WS_XB + 64 * MiB;
constexpr size_t WS_HF = WS_R1 + 192 * MiB;
constexpr size_t WS_XB8 = WS_HF + 128 * MiB;
constexpr size_t WS_END = WS_XB8 + 32 * MiB;
constexpr size_t WS_SCL = WS_ROPE + 1536 * 1024;
constexpr size_t SCL_SA = 0, SCL_SBIN = 128 * 1024, SCL_SBQKV = 144 * 1024, SCL_SBGU = 160 * 1024;
constexpr size_t R1_HE = 128 * MiB;
constexpr size_t HF_QI = 0, HF_KI = 32 * MiB, HF_WI = 36 * MiB, HF_MASK = 40 * MiB;
constexpr int CW_BAR = 0;
constexpr int CW_CNT = 4096;

DI unsigned cvt_pk_bf16(float lo, float hi) { unsigned r; asm volatile("v_cvt_pk_bf16_f32 %0, %1, %2" : "=v"(r) : "v"(lo), "v"(hi)); return r; }
DI float bf2f(bf16_t b) { return __uint_as_float(((unsigned)b) << 16); }
#define DPPF0(x, ctrl) __uint_as_float(__builtin_amdgcn_update_dpp(0u, __float_as_uint(x), ctrl, 0xf, 0xf, true))
DI float wave_sum(float v) {
    v += DPPF0(v, 0xB1); v += DPPF0(v, 0x4E); v += DPPF0(v, 0x141); v += DPPF0(v, 0x140);
    const float r0 = __uint_as_float(__builtin_amdgcn_readlane(__float_as_uint(v), 0)), r1 = __uint_as_float(__builtin_amdgcn_readlane(__float_as_uint(v), 16));
    const float r2 = __uint_as_float(__builtin_amdgcn_readlane(__float_as_uint(v), 32)), r3 = __uint_as_float(__builtin_amdgcn_readlane(__float_as_uint(v), 48));
    return (r0 + r1) + (r2 + r3);
}
DI float wave_max(float v) {
#pragma unroll
    for (int d = 32; d >= 1; d >>= 1) v = fmaxf(v, __shfl_xor(v, d));
    return v;
}
DI float wave_min(float v) {
#pragma unroll
    for (int d = 32; d >= 1; d >>= 1) v = fminf(v, __shfl_xor(v, d));
    return v;
}
#define LDS_WAIT() asm volatile("s_waitcnt lgkmcnt(0)" ::: "memory")

#define XB_TMO      128
#define XB_XCNT(j)  (256  + 64 * (j))
#define XB_XSUB(j)  (1280 + 64 * (j))
#define XB_XGEN(j)  (2304 + 64 * (j))
#define XB_TOP      3328
#define XB_TOPGEN   3392
#define XCD_BAR_WORDS 3456
#define XB_SPIN_CAP (1u << 22)

DI unsigned xb_ld(unsigned* p)              { return __hip_atomic_load(p, __ATOMIC_RELAXED, __HIP_MEMORY_SCOPE_AGENT); }
DI unsigned xb_add(unsigned* p, unsigned v) { return __hip_atomic_fetch_add(p, v, __ATOMIC_RELAXED, __HIP_MEMORY_SCOPE_AGENT); }
DI unsigned xb_xcc_id() { return (unsigned)__builtin_amdgcn_s_getreg((3 << 11) | 20) & 0xFu; }
#define XB_SPIN(cond, bar) do { unsigned _sp = 0; while (cond) { __builtin_amdgcn_s_sleep(1); \
    if ((++_sp & 255u) == 0u) { if (xb_ld(&(bar)[XB_TMO])) break; if (_sp > XB_SPIN_CAP) { atomicAdd(&(bar)[XB_TMO], 1u); break; } } } } while (0)

struct XcdBarrier { unsigned* bar; unsigned x; volatile LAS unsigned* st; };

DI XcdBarrier xcd_barrier_post(unsigned* bar, volatile LAS unsigned* st) {
    XcdBarrier b; b.bar = bar; b.x = xb_xcc_id(); b.st = st;
    if (threadIdx.x == 0) (void)xb_add(&bar[XB_XCNT(b.x)], 1u);
    return b;
}
DI void xcd_barrier_complete(unsigned* bar, unsigned x, unsigned& nloc, unsigned& nx) {
    const unsigned G = gridDim.x * gridDim.y * gridDim.z;
    unsigned sum, cnt, mine, sp = 0u;
    for (;;) {
        sum = 0u; cnt = 0u; mine = 0u;
#pragma unroll
        for (unsigned j = 0; j < 16; ++j) { const unsigned c = xb_ld(&bar[XB_XCNT(j)]); sum += c; cnt += (c > 0u) ? 1u : 0u; mine = (j == x) ? c : mine; }
        if (sum == G) break;
        __builtin_amdgcn_s_sleep(1);
        if ((++sp & 255u) == 0u) { if (xb_ld(&bar[XB_TMO])) break; if (sp > XB_SPIN_CAP) { atomicAdd(&bar[XB_TMO], 1u); break; } }
    }
    nloc = mine > 0u ? mine : 1u; nx = cnt > 0u ? cnt : 1u;
}
DI void xcd_barrier(const XcdBarrier& b) {
    asm volatile("s_waitcnt vmcnt(0)" ::: "memory");
    __syncthreads();
    if (threadIdx.x == 0) {
        unsigned* bar = b.bar;
        __builtin_amdgcn_s_waitcnt(0);
        unsigned nloc = b.st[0], nx = b.st[1];
        if (nloc == 0u) { xcd_barrier_complete(bar, b.x, nloc, nx); b.st[0] = nloc; b.st[1] = nx; }
        const unsigned old = xb_add(&bar[XB_XSUB(b.x)], 1u);
        const unsigned gen = old / nloc;
        if (old + 1u == (gen + 1u) * nloc) {
            __builtin_amdgcn_fence(__ATOMIC_RELEASE, "agent");
            asm volatile("s_waitcnt vmcnt(0)" ::: "memory");
            const unsigned og = xb_add(&bar[XB_TOP], 1u);
            const unsigned tg = og / nx;
            if (og + 1u == (tg + 1u) * nx) xb_add(&bar[XB_TOPGEN], 1u);
            else XB_SPIN(xb_ld(&bar[XB_TOPGEN]) == tg, bar);
            __builtin_amdgcn_fence(__ATOMIC_ACQUIRE, "agent");
            xb_add(&bar[XB_XGEN(b.x)], 1u);
            asm volatile("s_waitcnt vmcnt(0)" ::: "memory");
        } else {
            XB_SPIN(xb_ld(&bar[XB_XGEN(b.x)]) == gen, bar);
            __builtin_amdgcn_fence(__ATOMIC_ACQUIRE, "agent");
            asm volatile("s_waitcnt vmcnt(0)" ::: "memory");
        }
    }
    __syncthreads();
}

namespace pg8 {
constexpr int BM = 256, BK = 64, HALF = 128, HTB = HALF * BK * 2, STAGE_BYTES = 8 * HTB, NXCD = 8, WGM = 8;
DI int lds_byte(int r, int c) { const int st = (r >> 4) * 2 + (c >> 5), rr = r & 15, cc = c & 31, ob = rr * 64 + cc * 2; return st * 1024 + (ob ^ (((ob >> 9) & 1) << 5)); }
DI void stage_rc(int b, int& R, int& C) { const int st = b / 1024, sb = b % 1024, swz = sb ^ (((sb >> 9) & 1) << 5); R = (st >> 1) * 16 + swz / 64; C = (st & 1) * 32 + (swz % 64) / 2; }
DI int perm32(int rho) { const int n = rho >> 4, i = rho & 15; return 8 * (i >> 2) + 4 * n + (i & 3); }

struct Unit { int pm, pn, e, rb, par; };

DI int xcd_remap(int wgid, int nwg) { const int q = nwg / NXCD, r = nwg % NXCD, xcd = wgid % NXCD, off = wgid / NXCD; return (xcd < r ? xcd * (q + 1) : r * (q + 1) + (xcd - r) * q) + off; }

struct SchedDense {
    static constexpr bool GATHER = false;
    const bf16_t* A; const bf16_t* Bt; int K; int nM, nN, nwg, G, c; const float* sA = nullptr; const float* sB = nullptr;
    DI void init(const bf16_t* A_, const bf16_t* Bt_, int M, int N, int K_, int G_, int c_) { A = A_; Bt = Bt_; K = K_; nM = M / BM; nN = N / BM; nwg = nM * nN; G = G_; c = c_; }
    DI bool next(int i, Unit& u) const {
        const long L = (long)i * G + c; if (L >= nwg) return false;
        const int wgid = xcd_remap((int)L, nwg);
        const int nig = WGM * nN, gid = wgid / nig, fm = gid * WGM, gsz = (nM - fm) < WGM ? (nM - fm) : WGM;
        u.pm = fm + ((wgid % nig) % gsz); u.pn = (wgid % nig) / gsz; u.e = 0; u.rb = 0; return true;
    }
    DI const char* abase(const Unit& u) const { return (const char*)A + (size_t)u.pm * BM * K * 2; }
    DI const char* bbase(const Unit& u) const { return (const char*)Bt + (size_t)u.pn * BM * K * 2; }
    DI bool has_pref() const { return sA != nullptr; }
    DI const float* pref_ptr(const Unit& u, int tid) const { return tid < 256 ? sA + u.pm * BM + tid : sB + u.pn * BM + tid - 256; }
    DI void aoffs(const Unit&, int tid, unsigned (&v)[2][2]) const {
#pragma unroll
        for (int i = 0; i < 2; ++i) { int R, C; stage_rc(tid * 16 + i * 8192, R, C); v[0][i] = (unsigned)(R * K + C) * 2u; v[1][i] = v[0][i] + (unsigned)(HALF * K) * 2u; }
    }
};
struct SchedMoe {
    static constexpr bool GATHER = true;
    const bf16_t* A; const bf16_t* Bt; int K, nN; size_t bstride; const LAS int* tab; const int* list; int gather; int G, c; const float* sA = nullptr; const float* sB = nullptr;
    DI bool next(int i, Unit& u) const {
        const int total = tab[16] * nN; const long L = (long)i * G + c; if (L >= total) return false;
        const int wgid = xcd_remap((int)L, total);
        const int rt = wgid / nN; u.pn = wgid % nN; u.pm = rt;
        int e = 0;
#pragma unroll 1
        for (; e < 15; ++e) if (rt < tab[e + 1]) break;
        u.e = e; u.rb = (rt - tab[e]) * BM; return true;
    }
    DI const char* abase(const Unit& u) const { return gather ? (const char*)A : (const char*)A + (size_t)u.pm * BM * K * 2; }
    DI const char* bbase(const Unit& u) const { return (const char*)Bt + (size_t)u.e * bstride + (size_t)u.pn * BM * K * 2; }
    const float* gw = nullptr; const float* lsc = nullptr;
    DI bool has_pref() const { return true; }
    DI const float* pref_ptr(const Unit& u, int tid) const { const int cnt = tab[17 + u.e]; int rr = u.rb + (tid & 255); rr = rr < cnt ? rr : cnt - 1; const size_t li = (size_t)u.e * LISTCAP + rr;
        if (gather) return tid < 256 ? lsc + li : sB + u.e * 512 + u.pn * BM + tid - 256;
        return tid < 256 ? (const float*)(list + li) : gw + li; }
    DI void aoffs(const Unit& u, int tid, unsigned (&v)[2][2]) const {
        const int cnt = tab[17 + u.e];
#pragma unroll
        for (int i = 0; i < 2; ++i) { int R, C; stage_rc(tid * 16 + i * 8192, R, C);
#pragma unroll
            for (int h = 0; h < 2; ++h) {
                int row = R + h * HALF;
                if (gather) { int r = u.rb + row; r = r < cnt ? r : cnt - 1; row = list[(size_t)u.e * LISTCAP + r] >> 1; }
                v[h][i] = (unsigned)(row * K + C) * 2u; } }
    }
};

typedef int i32x4 __attribute__((ext_vector_type(4)));
template <class Epi, class Sched, bool INT8 = false>
DI void gemm_phase(LAS unsigned char* lds, const Sched& S, const Epi& E) {
    const int tid = threadIdx.x, wid = __builtin_amdgcn_readfirstlane(tid >> 6), lane = tid & 63, wr = wid >> 2, wc = wid & 3, fr = lane & 15, fq = lane >> 4;
    const int K = S.K, nt = K / BK;
    unsigned voffB[2], vA[2][2], vN[2][2];
#pragma unroll
    for (int i = 0; i < 2; ++i) { int R, C; stage_rc(tid * 16 + i * 8192, R, C); const int Rb = Epi::PERM ? ((R & ~31) + perm32(R & 31)) : R; voffB[i] = (unsigned)(Rb * K + C) * 2u; }
    const size_t kstep = (size_t)(BK * 2);
    const size_t hstep = (size_t)HALF * K * 2;
    const unsigned ldsw = (unsigned)wid * 1024u;
    const int aoff = lds_byte(wr * 64 + fr, fq * 8), boff = lds_byte(wc * 32 + fr, fq * 8);
#define PG8_SA(b, h) (((b) * 2 + (h)) * HTB)
#define PG8_SB(b, h) ((4 + (b) * 2 + (h)) * HTB)
#define PG8_STAGE(bufoff, gbase, voff) do { _Pragma("unroll") for (int _i = 0; _i < 2; ++_i) \
        __builtin_amdgcn_global_load_lds((const unsigned*)((const char*)(gbase) + (voff)[_i]), (LAS unsigned*)(lds + (bufoff) + ldsw + _i * 8192), 16, 0, 0); } while (0)
#define PG8_LDA(dst, b, h) do { _Pragma("unroll") for (int m = 0; m < 4; ++m) _Pragma("unroll") for (int k = 0; k < 2; ++k) dst[m][k] = *(const LAS bf16x8*)(lds + PG8_SA(b, h) + aoff + m * 2048 + k * 1024); } while (0)
#define PG8_LDB(dst, b, h) do { _Pragma("unroll") for (int n = 0; n < 2; ++n) _Pragma("unroll") for (int k = 0; k < 2; ++k) dst[n][k] = *(const LAS bf16x8*)(lds + PG8_SB(b, h) + boff + n * 2048 + k * 1024); } while (0)
#define PG8_MMA(ai, bj, At, Bt) do { __builtin_amdgcn_s_setprio(1); _Pragma("unroll") for (int m = 0; m < 4; ++m) _Pragma("unroll") for (int n = 0; n < 2; ++n) _Pragma("unroll") for (int k = 0; k < 2; ++k) { \
        if constexpr (INT8) acc[ai][bj][m][n] = __builtin_bit_cast(f32x4, __builtin_amdgcn_mfma_i32_16x16x64_i8(__builtin_bit_cast(i32x4, Bt[n][k]), __builtin_bit_cast(i32x4, At[m][k]), __builtin_bit_cast(i32x4, acc[ai][bj][m][n]), 0, 0, 0)); \
        else acc[ai][bj][m][n] = __builtin_amdgcn_mfma_f32_16x16x32_bf16(Bt[n][k], At[m][k], acc[ai][bj][m][n], 0, 0, 0); } __builtin_amdgcn_s_setprio(0); } while (0)
#define PG8_WAIT_V(n) asm volatile("s_waitcnt vmcnt(" #n ")" ::: "memory")
#define PG8_WAIT_L(n) asm volatile("s_waitcnt lgkmcnt(" #n ")" ::: "memory")
#define PG8_BAR __builtin_amdgcn_s_barrier()
#define PG8_SCHED __builtin_amdgcn_sched_barrier(0)
    LAS float* xl = (LAS float*)(lds + STAGE_BYTES);
    Unit cur, nxt; int ui = 0;
    if (!S.next(0, cur)) return;
    f32x4 acc[2][2][4][2];
#pragma unroll
    for (int a = 0; a < 2; ++a)
#pragma unroll
        for (int b = 0; b < 2; ++b)
#pragma unroll
            for (int m = 0; m < 4; ++m)
#pragma unroll
                for (int n = 0; n < 2; ++n) acc[a][b][m][n] = (f32x4){0.f, 0.f, 0.f, 0.f};
    bf16x8 At[4][2], B0[2][2], B1[2][2];
    const char* cA = S.abase(cur); const char* cB = S.bbase(cur);
    S.aoffs(cur, tid, vA);
    PG8_STAGE(PG8_SB(0, 0), cB, voffB); PG8_STAGE(PG8_SA(0, 0), cA, vA[0]); PG8_STAGE(PG8_SB(0, 1), cB + hstep, voffB); PG8_STAGE(PG8_SA(0, 1), cA, vA[1]);
    if (wr == 1) PG8_BAR;
    PG8_WAIT_V(4); PG8_BAR;
    PG8_STAGE(PG8_SB(1, 0), cB + kstep, voffB); PG8_STAGE(PG8_SA(1, 0), cA + kstep, vA[0]); PG8_STAGE(PG8_SB(1, 1), cB + hstep + kstep, voffB);
    PG8_WAIT_V(6); PG8_BAR;
    for (;;) {
        const bool has_next = S.next(ui + 1, nxt);
        if (S.has_pref()) __builtin_amdgcn_global_load_lds((const unsigned*)S.pref_ptr(cur, tid), (LAS unsigned*)(xl + (ui & 1) * 512 + wid * 64), 4, 0, 0);
        const char* nA = has_next ? S.abase(nxt) : cA; const char* nB = has_next ? S.bbase(nxt) : cB;
        if (Sched::GATHER) { if (has_next) S.aoffs(nxt, tid, vN); else { vN[0][0] = vA[0][0]; vN[0][1] = vA[0][1]; vN[1][0] = vA[1][0]; vN[1][1] = vA[1][1]; } }
        for (int t = 0; t < nt; t += 2) {
            const bool last = (t == nt - 2);
            const char* a1 = cA + (size_t)(t + 1) * kstep;
            const char* a2 = last ? nA : cA + (size_t)(t + 2) * kstep; const char* b2 = last ? nB : cB + (size_t)(t + 2) * kstep;
            const char* a3 = a2 + kstep; const char* b3 = b2 + kstep;
            unsigned o2[2][2];
#pragma unroll
            for (int h = 0; h < 2; ++h)
#pragma unroll
                for (int i = 0; i < 2; ++i) o2[h][i] = (Sched::GATHER && last) ? vN[h][i] : vA[h][i];
            PG8_LDB(B0, 0, 0); PG8_SCHED; PG8_LDA(At, 0, 0); PG8_STAGE(PG8_SA(1, 1), a1, vA[1]);
            PG8_WAIT_L(8); PG8_BAR; PG8_WAIT_L(0); PG8_MMA(0, 0, At, B0); PG8_BAR; PG8_SCHED;
            PG8_LDB(B1, 0, 1); PG8_STAGE(PG8_SB(0, 0), b2, voffB);
            PG8_BAR; PG8_WAIT_L(0); PG8_MMA(0, 1, At, B1); PG8_BAR;
            PG8_LDA(At, 0, 1); PG8_STAGE(PG8_SA(0, 0), a2, o2[0]);
            PG8_BAR; PG8_WAIT_L(0); PG8_MMA(1, 0, At, B0); PG8_BAR; PG8_SCHED;
            PG8_STAGE(PG8_SB(0, 1), b2 + hstep, voffB);
            PG8_WAIT_V(6); PG8_BAR; PG8_MMA(1, 1, At, B1); PG8_BAR;
            PG8_LDB(B0, 1, 0); PG8_SCHED; PG8_LDA(At, 1, 0); PG8_STAGE(PG8_SA(0, 1), a2, o2[1]);
            PG8_WAIT_L(8); PG8_BAR; PG8_WAIT_L(0); PG8_MMA(0, 0, At, B0); PG8_BAR; PG8_SCHED;
            PG8_LDB(B1, 1, 1); PG8_STAGE(PG8_SB(1, 0), b3, voffB);
            PG8_BAR; PG8_WAIT_L(0); PG8_MMA(0, 1, At, B1); PG8_BAR;
            PG8_LDA(At, 1, 1); PG8_STAGE(PG8_SA(1, 0), a3, o2[0]);
            PG8_BAR; PG8_WAIT_L(0); PG8_MMA(1, 0, At, B0); PG8_BAR; PG8_SCHED;
            PG8_STAGE(PG8_SB(1, 1), b3 + hstep, voffB);
            PG8_WAIT_V(6); PG8_BAR; PG8_MMA(1, 1, At, B1); PG8_BAR;
        }
        if constexpr (INT8) {
            const int rb_ = wr * 64 + fr, cb_ = wc * 32 + (Epi::PERM ? 8 * fq : 4 * fq);
            float ra[2][4]; f32x4 cs[2][2];
#pragma unroll
            for (int a = 0; a < 2; ++a)
#pragma unroll
                for (int m = 0; m < 4; ++m) ra[a][m] = xl[(ui & 1) * 512 + rb_ + a * HALF + m * 16];
#pragma unroll
            for (int b = 0; b < 2; ++b)
#pragma unroll
                for (int n = 0; n < 2; ++n) cs[b][n] = *(const LAS f32x4*)(xl + (ui & 1) * 512 + 256 + cb_ + b * HALF + (Epi::PERM ? 4 * n : 16 * n));
#pragma unroll
            for (int a = 0; a < 2; ++a)
#pragma unroll
                for (int b = 0; b < 2; ++b)
#pragma unroll
                    for (int m = 0; m < 4; ++m)
#pragma unroll
                        for (int n = 0; n < 2; ++n) { const i32x4 v_ = __builtin_bit_cast(i32x4, acc[a][b][m][n]);
                            acc[a][b][m][n] = (f32x4){(float)v_[0], (float)v_[1], (float)v_[2], (float)v_[3]} * ra[a][m] * cs[b][n]; }
        }
        cur.par = ui & 1;
        E(acc, cur, wr, wc, fr, fq);
        if (!has_next) break;
#pragma unroll
        for (int a = 0; a < 2; ++a)
#pragma unroll
            for (int b = 0; b < 2; ++b)
#pragma unroll
                for (int m = 0; m < 4; ++m)
#pragma unroll
                    for (int n = 0; n < 2; ++n) acc[a][b][m][n] = (f32x4){0.f, 0.f, 0.f, 0.f};
        cur = nxt; cA = nA; cB = nB; ++ui;
        if (Sched::GATHER) { vA[0][0] = vN[0][0]; vA[0][1] = vN[0][1]; vA[1][0] = vN[1][0]; vA[1][1] = vN[1][1]; }
    }
    PG8_WAIT_V(0);
    if (wr == 0) PG8_BAR;
    PG8_BAR;
#undef PG8_SA
#undef PG8_SB
#undef PG8_STAGE
#undef PG8_LDA
#undef PG8_LDB
#undef PG8_MMA
#undef PG8_WAIT_V
#undef PG8_WAIT_L
#undef PG8_BAR
#undef PG8_SCHED
}

DI u32x4 pack8(f32x4 a, f32x4 b) { u32x4 w; w.x = cvt_pk_bf16(a[0], a[1]); w.y = cvt_pk_bf16(a[2], a[3]); w.z = cvt_pk_bf16(b[0], b[1]); w.w = cvt_pk_bf16(b[2], b[3]); return w; }

struct EpiF32 {
    static constexpr bool PERM = false;
    float* C; int ldc;
    DI void operator()(const f32x4 (&acc)[2][2][4][2], const Unit& u, int wr, int wc, int fr, int fq) const {
        const int row0 = u.pm * BM + wr * 64 + fr, col0 = u.pn * BM + wc * 32 + 4 * fq;
#pragma unroll
        for (int ai = 0; ai < 2; ++ai)
#pragma unroll
            for (int m = 0; m < 4; ++m) { float* rowp = C + (size_t)(row0 + ai * HALF + m * 16) * ldc + col0;
#pragma unroll
                for (int bj = 0; bj < 2; ++bj)
#pragma unroll
                    for (int n = 0; n < 2; ++n) *(f32x4*)(rowp + bj * HALF + n * 16) = acc[ai][bj][m][n]; }
    }
};
struct EpiBf16Split {
    static constexpr bool PERM = true;
    bf16_t* O; int ldc; int split_cols; size_t split_stride;
    DI void operator()(const f32x4 (&acc)[2][2][4][2], const Unit& u, int wr, int wc, int fr, int fq) const {
        const int row0 = u.pm * BM + wr * 64 + fr; int colt = u.pn * BM; bf16_t* base = O;
        { const int t = colt / split_cols; base += (size_t)t * split_stride; colt -= t * split_cols; }
        const int col0 = colt + wc * 32 + 8 * fq;
#pragma unroll
        for (int ai = 0; ai < 2; ++ai)
#pragma unroll
            for (int m = 0; m < 4; ++m) { bf16_t* rowp = base + (size_t)(row0 + ai * HALF + m * 16) * ldc + col0;
#pragma unroll
                for (int bj = 0; bj < 2; ++bj) *(u32x4*)(rowp + bj * HALF) = pack8(acc[ai][bj][m][0], acc[ai][bj][m][1]); }
    }
};
template <int HALFD>
DI void rope4(int t, int dp, f32x4& c4, f32x4& s4) {
#pragma unroll
    for (int j = 0; j < 4; ++j) { const float inv2pi = __builtin_amdgcn_exp2f((float)(dp + j) * (-13.287712379549449f / HALFD)) * 0.15915494309189535f;
        const float x = __builtin_amdgcn_fractf((float)t * inv2pi); c4[j] = __builtin_amdgcn_cosf(x); s4[j] = __builtin_amdgcn_sinf(x); }
}
struct EpiInProj {
    static constexpr bool PERM = true;
    bf16_t* QKV; bf16_t* QI; bf16_t* KI; float* WI;
    DI void operator()(const f32x4 (&acc)[2][2][4][2], const Unit& u, int wr, int wc, int fr, int fq) const {
        const int row0 = u.pm * BM + wr * 64 + fr;
        if (u.pn < 8) {
            bf16_t* base = QKV + (size_t)(u.pn >> 2) * NTOK * DM; const int col0 = (u.pn & 3) * BM + wc * 32 + 8 * fq, dp = 16 * wc + 4 * fq;
#pragma unroll
            for (int ai = 0; ai < 2; ++ai)
#pragma unroll
                for (int m = 0; m < 4; ++m) { const int row = row0 + ai * HALF + m * 16, t = row & (SEQ - 1);
                    f32x4 c4, s4; rope4<64>(t, dp, c4, s4);
#pragma unroll
                    for (int bj = 0; bj < 2; ++bj) { const f32x4 x1 = acc[ai][bj][m][0], x2 = acc[ai][bj][m][1];
                        *(u32x4*)(base + (size_t)row * DM + col0 + bj * HALF) = pack8(x1 * c4 - x2 * s4, x1 * s4 + x2 * c4); } }
        } else if (u.pn < 12) {
            bf16_t* base = QKV + (size_t)2 * NTOK * DM; const int col0 = (u.pn - 8) * BM + wc * 32 + 8 * fq;
#pragma unroll
            for (int ai = 0; ai < 2; ++ai)
#pragma unroll
                for (int m = 0; m < 4; ++m) { const int row = row0 + ai * HALF + m * 16;
#pragma unroll
                    for (int bj = 0; bj < 2; ++bj) *(u32x4*)(base + (size_t)row * DM + col0 + bj * HALF) = pack8(acc[ai][bj][m][0], acc[ai][bj][m][1]); }
        } else if (u.pn < 14) {
            const int col0 = (u.pn - 12) * BM + wc * 32 + 8 * fq, dp = 16 * (wc & 1) + 4 * fq;
#pragma unroll
            for (int ai = 0; ai < 2; ++ai)
#pragma unroll
                for (int m = 0; m < 4; ++m) { const int row = row0 + ai * HALF + m * 16, t = row & (SEQ - 1);
                    f32x4 c4, s4; rope4<32>(t, dp, c4, s4);
#pragma unroll
                    for (int bj = 0; bj < 2; ++bj) { const f32x4 x1 = acc[ai][bj][m][0], x2 = acc[ai][bj][m][1];
                        *(u32x4*)(QI + (size_t)row * 512 + col0 + bj * HALF) = pack8(x1 * c4 - x2 * s4, x1 * s4 + x2 * c4); } }
        } else {
            if (wc < 2) { const int col0 = wc * 32 + 8 * fq, dp = 16 * wc + 4 * fq;
#pragma unroll
                for (int ai = 0; ai < 2; ++ai)
#pragma unroll
                    for (int m = 0; m < 4; ++m) { const int row = row0 + ai * HALF + m * 16, t = row & (SEQ - 1);
                        f32x4 c4, s4; rope4<32>(t, dp, c4, s4);
                        const f32x4 x1 = acc[ai][0][m][0], x2 = acc[ai][0][m][1];
                        *(u32x4*)(KI + (size_t)row * 64 + col0) = pack8(x1 * c4 - x2 * s4, x1 * s4 + x2 * c4); }
            } else if (wc == 2 && fq == 0) {
                const float sc = 0.35355339059327373f;
#pragma unroll
                for (int ai = 0; ai < 2; ++ai)
#pragma unroll
                    for (int m = 0; m < 4; ++m) { const int row = row0 + ai * HALF + m * 16;
                        *(f32x4*)(WI + (size_t)row * 8) = acc[ai][0][m][0] * sc; *(f32x4*)(WI + (size_t)row * 8 + 4) = acc[ai][0][m][1] * sc; }
            }
        }
    }
};
struct EpiMoe1 {
    static constexpr bool PERM = true;
    bf16_t* HE;
    DI void operator()(const f32x4 (&acc)[2][2][4][2], const Unit& u, int wr, int wc, int fr, int fq) const {
        const int row0 = u.pm * BM + wr * 64 + fr, hc0 = 128 * u.pn + 16 * wc + 4 * fq;
#pragma unroll
        for (int ai = 0; ai < 2; ++ai)
#pragma unroll
            for (int m = 0; m < 4; ++m) { const int row = row0 + ai * HALF + m * 16;
#pragma unroll
                for (int bj = 0; bj < 2; ++bj) { const f32x4 g = acc[ai][bj][m][0], up = acc[ai][bj][m][1]; f32x4 h;
#pragma unroll
                    for (int j = 0; j < 4; ++j) h[j] = g[j] * __builtin_amdgcn_rcpf(1.0f + __builtin_amdgcn_exp2f(-1.4426950408889634f * g[j])) * up[j];
                    u32x2 w; w.x = cvt_pk_bf16(h[0], h[1]); w.y = cvt_pk_bf16(h[2], h[3]);
                    *(u32x2*)(HE + (size_t)row * FFE + hc0 + 64 * bj) = w; } }
    }
};
struct EpiMoe2 {
    static constexpr bool PERM = true;
    bf16_t* Y; const LAS float* xl; const LAS int* tab;
    DI void operator()(const f32x4 (&acc)[2][2][4][2], const Unit& u, int wr, int wc, int fr, int fq) const {
        const int cnt = tab[17 + u.e], col0 = u.pn * BM + wc * 32 + 8 * fq;
        int ent[8]; float gw[8];
#pragma unroll
        for (int i = 0; i < 8; ++i) { const int rl = u.par * 512 + (i >> 2) * HALF + wr * 64 + (i & 3) * 16 + fr; ent[i] = __float_as_int(xl[rl]); gw[i] = xl[256 + rl]; }
#pragma unroll
        for (int i = 0; i < 8; ++i) { const int ai = i >> 2, m = i & 3, r = u.rb + ai * HALF + wr * 64 + m * 16 + fr;
            if (r < cnt) { bf16_t* dst = Y + ((size_t)(ent[i] & 1) * NTOK + (size_t)(ent[i] >> 1)) * DM + col0;
#pragma unroll
                for (int bj = 0; bj < 2; ++bj) *(u32x4*)(dst + bj * HALF) = pack8(acc[ai][bj][m][0] * gw[i], acc[ai][bj][m][1] * gw[i]); } }
    }
};
}

struct Args { const float* in[13]; float* out; unsigned char* ws; int ph_lo, ph_hi; };
struct Frame {
    LAS unsigned char* lds; int tid, lane, wave, G, bid;
    unsigned char* ws; unsigned* ctl;
};

DI int src_col(int mode, int p) {
    if (mode == 0) return p;
    if (mode == 1) {
        if (p < 2048) { const int hd = p >> 7, pp = p & 127; return (hd << 7) + ((pp >> 3) << 2) + (pp & 3) + 64 * ((pp >> 2) & 1); }
        if (p < 3072) return p;
        if (p < 3648) { const int q = p - 3072, hd = q >> 6, pp = q & 63; return 3072 + (hd << 6) + ((pp >> 3) << 2) + (pp & 3) + 32 * ((pp >> 2) & 1); }
        if (p < AIN) return p;
        return -1; }
    return ((p >> 3) << 2) + (p & 3);
}
DI float dpp_wave_max_f(float v);
DI float quant_row(const f32x4 (&v)[4], int lane, signed char* dst, float* sdst) {
    float mx = 0.f;
#pragma unroll
    for (int i = 0; i < 4; ++i) mx = fmaxf(mx, fmaxf(fmaxf(fabsf(v[i][0]), fabsf(v[i][1])), fmaxf(fabsf(v[i][2]), fabsf(v[i][3]))));
    mx = dpp_wave_max_f(mx);
    const float inv = mx > 0.f ? 127.0f / mx : 0.f;
#pragma unroll
    for (int i = 0; i < 4; ++i) { const int q0 = (int)__builtin_rintf(v[i][0] * inv), q1 = (int)__builtin_rintf(v[i][1] * inv), q2 = (int)__builtin_rintf(v[i][2] * inv), q3 = (int)__builtin_rintf(v[i][3] * inv);
        *(int*)(dst + 4 * lane + 256 * i) = (q0 & 0xFF) | ((q1 & 0xFF) << 8) | ((q2 & 0xFF) << 16) | (q3 << 24); }
    if (lane == 0) *sdst = mx * (1.0f / 127.0f);
    return mx * (1.0f / 127.0f);
}
DI void wq8_unit(const Frame& F, const float* W0, const float* W2, int ldw, int mode, signed char* Bt8, float* sB, int n0) {
    LAS float* T = (LAS float*)F.lds;
    LAS unsigned* cmax = (LAS unsigned*)(F.lds + 1024 * 33 * 4);
    const int n4 = (F.tid & 7) * 4, src = src_col(mode, n0 + n4); const float* W = (mode == 2 && (((n0 + n4) >> 2) & 1)) ? W2 : W0;
    if (F.tid < 32) cmax[F.tid] = 0u;
    __syncthreads();
    f32x4 m4 = {0.f, 0.f, 0.f, 0.f}, vv[16];
#pragma unroll
    for (int i = 0; i < 16; ++i) vv[i] = src >= 0 ? *(const f32x4*)(W + (size_t)((F.tid >> 3) + 64 * i) * ldw + src) : (f32x4){0.f, 0.f, 0.f, 0.f};
#pragma unroll
    for (int i = 0; i < 16; ++i) { const int kk = (F.tid >> 3) + 64 * i; const f32x4 v = vv[i];
        m4[0] = fmaxf(m4[0], fabsf(v[0])); m4[1] = fmaxf(m4[1], fabsf(v[1])); m4[2] = fmaxf(m4[2], fabsf(v[2])); m4[3] = fmaxf(m4[3], fabsf(v[3]));
        T[kk * 33 + n4] = v[0]; T[kk * 33 + n4 + 1] = v[1]; T[kk * 33 + n4 + 2] = v[2]; T[kk * 33 + n4 + 3] = v[3]; }
#pragma unroll
    for (int j = 0; j < 4; ++j) __hip_atomic_fetch_max(cmax + n4 + j, __float_as_uint(m4[j]), __ATOMIC_RELAXED, __HIP_MEMORY_SCOPE_WORKGROUP);
    __syncthreads();
    if (F.tid < 32) sB[n0 + F.tid] = __uint_as_float(cmax[F.tid]) * (1.0f / 127.0f);
    { const int nl = F.tid & 31, kb = (F.tid >> 5) * 64; const float mx = __uint_as_float(cmax[nl]), inv = mx > 0.f ? 127.0f / mx : 0.f;
#pragma unroll 2
      for (int k8 = 0; k8 < 64; k8 += 8) { int q[8];
#pragma unroll
          for (int j = 0; j < 8; ++j) q[j] = (int)__builtin_rintf(T[(kb + k8 + j) * 33 + nl] * inv);
          u32x2 w; w.x = (unsigned)((q[0] & 0xFF) | ((q[1] & 0xFF) << 8) | ((q[2] & 0xFF) << 16) | (q[3] << 24)); w.y = (unsigned)((q[4] & 0xFF) | ((q[5] & 0xFF) << 8) | ((q[6] & 0xFF) << 16) | (q[7] << 24));
          *(u32x2*)(Bt8 + (size_t)(n0 + nl) * DM + kb + k8) = w; } }
    __syncthreads();
}
DI void p0_prologue(const Frame& F, const Args& a) {
    const size_t gtid = (size_t)F.bid * 512 + F.tid, gthreads = (size_t)F.G * 512;
    { signed char* xq = (signed char*)(F.ws + WS_XB8); float* SA = (float*)(F.ws + WS_SCL + SCL_SA);
      const int gw = F.bid * 8 + F.wave, nw = F.G * 8, lane = F.lane;
      f32x4 rr[4][4];
#define XQ_LOAD(slot, r_) do { const int r2_ = (r_) < NTOK ? (r_) : gw; _Pragma("unroll") for (int i = 0; i < 4; ++i) rr[slot][i] = *(const f32x4*)(a.in[0] + (size_t)r2_ * DM + 4 * lane + 256 * i); } while (0)
      XQ_LOAD(0, gw); XQ_LOAD(1, gw + nw); XQ_LOAD(2, gw + 2 * nw);
      for (int row = gw; row < NTOK; row += 4 * nw) {
          XQ_LOAD(3, row + 3 * nw);
          quant_row(rr[0], lane, xq + (size_t)row * DM, SA + row);
          XQ_LOAD(0, row + 4 * nw);
          if (row + nw < NTOK) quant_row(rr[1], lane, xq + (size_t)(row + nw) * DM, SA + row + nw);
          XQ_LOAD(1, row + 5 * nw);
          if (row + 2 * nw < NTOK) quant_row(rr[2], lane, xq + (size_t)(row + 2 * nw) * DM, SA + row + 2 * nw);
          XQ_LOAD(2, row + 6 * nw);
          if (row + 3 * nw < NTOK) quant_row(rr[3], lane, xq + (size_t)(row + 3 * nw) * DM, SA + row + 3 * nw);
      }
#undef XQ_LOAD
    }
    { constexpr int T_SQ = 256, T_GU = 512 / 32, T_DN = 64, U_IN = NIN / 32, U_Q = DM / 32, U_KV = 2 * DM / 32;
      constexpr int O1 = U_IN, O2 = O1 + U_Q, O3 = O2 + U_KV;
      float* SBIN = (float*)(F.ws + WS_SCL + SCL_SBIN); float* SBQKV = (float*)(F.ws + WS_SCL + SCL_SBQKV);
      constexpr int NHEAVY = U_IN + U_Q + U_KV + 32 * T_GU;
      for (int tile = F.bid; tile < NHEAVY; tile += F.G) {
          if (tile < O1) wq8_unit(F, a.in[1], nullptr, AIN, 1, (signed char*)(F.ws + WS_WAIN), SBIN, tile * 32);
          else if (tile < O2) wq8_unit(F, a.in[3], nullptr, DM, 0, (signed char*)(F.ws + WS_WBQKV), SBQKV, (tile - O1) * 32);
          else if (tile < O3) wq8_unit(F, a.in[4], nullptr, 2 * DM, 0, (signed char*)(F.ws + WS_WBQKV) + (size_t)DM * DM, SBQKV + DM, (tile - O2) * 32);
          else { const int t = tile - O3, le = t >> 4, tt = t & 15;
              wq8_unit(F, a.in[8] + (size_t)le * DM * FFE, a.in[9] + (size_t)le * DM * FFE, FFE, 2, (signed char*)(F.ws + WS_WGU) + (size_t)le * 512 * DM, (float*)(F.ws + WS_SCL + SCL_SBGU) + le * 512, tt * 32); }
      }
      constexpr int NLIGHT = 2 * T_SQ + 32 * T_DN;
      LAS float* T = (LAS float*)F.lds;
      for (int g = F.bid; g < NLIGHT / 4; g += F.G) {
          const float* Wp[4]; bf16_t* Bp[4]; int ldw[4], Kk[4], k0[4], n0[4];
#pragma unroll
          for (int u = 0; u < 4; ++u) { const int L = 4 * g + u;
              if (L < T_SQ) { Wp[u] = a.in[2]; Bp[u] = (bf16_t*)(F.ws + WS_WAOUT); ldw[u] = DM; Kk[u] = DM; k0[u] = (L & 15) * 64; n0[u] = (L >> 4) * 64; }
              else if (L < 2 * T_SQ) { const int t = L - T_SQ; Wp[u] = a.in[5]; Bp[u] = (bf16_t*)(F.ws + WS_WBOUT); ldw[u] = DM; Kk[u] = DM; k0[u] = (t & 15) * 64; n0[u] = (t >> 4) * 64; }
              else { const int t = L - 2 * T_SQ, le = t >> 6, tt = t & 63; Wp[u] = a.in[10] + (size_t)le * FFE * DM; Bp[u] = (bf16_t*)(F.ws + WS_WD) + (size_t)le * DM * FFE; ldw[u] = DM; Kk[u] = FFE; k0[u] = (tt & 3) * 64; n0[u] = (tt >> 2) * 64; } }
          f32x4 v[4][2];
          { const int n4 = (F.tid & 15) * 4;
#pragma unroll
            for (int u = 0; u < 4; ++u)
#pragma unroll
                for (int i = 0; i < 2; ++i) v[u][i] = *(const f32x4*)(Wp[u] + (size_t)(k0[u] + (F.tid >> 4) + 32 * i) * ldw[u] + n0[u] + n4);
#pragma unroll
            for (int u = 0; u < 4; ++u)
#pragma unroll
                for (int i = 0; i < 2; ++i) { const int kl = (F.tid >> 4) + 32 * i; LAS float* Tu = T + u * 64 * 65;
                    Tu[kl * 65 + n4] = v[u][i][0]; Tu[kl * 65 + n4 + 1] = v[u][i][1]; Tu[kl * 65 + n4 + 2] = v[u][i][2]; Tu[kl * 65 + n4 + 3] = v[u][i][3]; } }
          __syncthreads();
          { const int nl = F.tid >> 3, kl = (F.tid & 7) * 8;
#pragma unroll
            for (int u = 0; u < 4; ++u) { const LAS float* Tu = T + u * 64 * 65; float w8[8];
#pragma unroll
                for (int j = 0; j < 8; ++j) w8[j] = Tu[(kl + j) * 65 + nl];
                u32x4 w; w.x = cvt_pk_bf16(w8[0], w8[1]); w.y = cvt_pk_bf16(w8[2], w8[3]); w.z = cvt_pk_bf16(w8[4], w8[5]); w.w = cvt_pk_bf16(w8[6], w8[7]);
                *(u32x4*)(Bp[u] + (size_t)(n0[u] + nl) * Kk[u] + k0[u] + kl) = w; } }
          __syncthreads();
      } }
}

constexpr int SCP = 2064;
DI unsigned ord_key(float v) { const unsigned b = __float_as_uint(v); return b ^ (((int)b >> 31) | 0x80000000u); }
DI unsigned popc64(u64 m) { return (unsigned)__builtin_popcountll(m); }

#define DPPF(x, ctrl) __uint_as_float(__builtin_amdgcn_update_dpp(0u, __float_as_uint(x), ctrl, 0xf, 0xf, true))
DI float dpp_wave_max(float v) {
    v = fmaxf(v, DPPF(v, 0xB1)); v = fmaxf(v, DPPF(v, 0x4E)); v = fmaxf(v, DPPF(v, 0x141)); v = fmaxf(v, DPPF(v, 0x140));
    const float r0 = __uint_as_float(__builtin_amdgcn_readlane(__float_as_uint(v), 0)), r1 = __uint_as_float(__builtin_amdgcn_readlane(__float_as_uint(v), 16));
    const float r2 = __uint_as_float(__builtin_amdgcn_readlane(__float_as_uint(v), 32)), r3 = __uint_as_float(__builtin_amdgcn_readlane(__float_as_uint(v), 48));
    return fmaxf(fmaxf(r0, r1), fmaxf(r2, r3));
}
DI float dpp_wave_max_f(float v) { return dpp_wave_max(v); }
DI float dpp_wave_min(float v) {
    v = fminf(v, DPPF(v, 0xB1)); v = fminf(v, DPPF(v, 0x4E)); v = fminf(v, DPPF(v, 0x141)); v = fminf(v, DPPF(v, 0x140));
    const float r0 = __uint_as_float(__builtin_amdgcn_readlane(__float_as_uint(v), 0)), r1 = __uint_as_float(__builtin_amdgcn_readlane(__float_as_uint(v), 16));
    const float r2 = __uint_as_float(__builtin_amdgcn_readlane(__float_as_uint(v), 32)), r3 = __uint_as_float(__builtin_amdgcn_readlane(__float_as_uint(v), 48));
    return fminf(fminf(r0, r1), fminf(r2, r3));
}
DI unsigned dpp_scan_add(unsigned v) {
    v += (unsigned)__builtin_amdgcn_update_dpp(0, (int)v, 0x111, 0xf, 0xf, false);
    v += (unsigned)__builtin_amdgcn_update_dpp(0, (int)v, 0x112, 0xf, 0xf, false);
    v += (unsigned)__builtin_amdgcn_update_dpp(0, (int)v, 0x114, 0xf, 0xf, false);
    v += (unsigned)__builtin_amdgcn_update_dpp(0, (int)v, 0x118, 0xf, 0xf, false);
    v += (unsigned)__builtin_amdgcn_update_dpp(0, (int)v, 0x142, 0xa, 0xf, false);
    v += (unsigned)__builtin_amdgcn_update_dpp(0, (int)v, 0x143, 0xc, 0xf, false);
    return v;
}
DI void select_topk(const LAS float* srow, int nj, LAS unsigned* hist, LAS unsigned* cand, LAS unsigned* ccnt, int lane, u64* mrow) {
    const LAS float* sp = srow + lane;
    float v[32];
#pragma unroll
    for (int g = 0; g < 4; ++g) { if (8 * g < nj) {
#pragma unroll
        for (int j = 8 * g; j < 8 * g + 8; ++j) v[j] = sp[j * 64]; } else {
#pragma unroll
        for (int j = 8 * g; j < 8 * g + 8; ++j) v[j] = -__builtin_inff(); } }
    int njv = nj; asm volatile("" : "+v"(njv));
#pragma unroll
    for (int j = 0; j < 32; ++j) v[j] = (j < njv) ? v[j] : -__builtin_inff();
    float vmx = v[0], vmn = v[0];
#pragma unroll
    for (int j = 1; j < 32; ++j) { vmx = fmaxf(vmx, v[j]); vmn = fminf(vmn, v[j] > -3.0e38f ? v[j] : vmn); }
    vmx = dpp_wave_max(vmx); vmn = dpp_wave_min(vmn);
    unsigned T = 0u, n_gt = 0u, n_ge = 0u;
    bool fast = false;
    if (vmx > vmn) {
        const float scale = 256.0f / (vmx - vmn);
        *(LAS u32x4*)(hist + 4 * lane) = (u32x4){0u, 0u, 0u, 0u};
        if (lane == 0) *ccnt = 0u;
        LDS_WAIT();
#pragma unroll
        for (int j = 0; j < 32; ++j) if (j < njv) { int b = (int)((v[j] - vmn) * scale); b = b > 255 ? 255 : b; __hip_atomic_fetch_add(hist + b, 1u, __ATOMIC_RELAXED, __HIP_MEMORY_SCOPE_WORKGROUP); }
        LDS_WAIT();
        const u32x4 h4 = *(const LAS u32x4*)(hist + 4 * (63 - lane));
        const unsigned c4 = h4.x + h4.y + h4.z + h4.w;
        const unsigned P = dpp_scan_add(c4);
        const u64 bal = __ballot(P >= (unsigned)TOPK);
        const int Ls = __builtin_ctzll(bal);
        const unsigned P_L = __builtin_amdgcn_readlane(P, Ls), c_L = __builtin_amdgcn_readlane(c4, Ls);
        const unsigned hb0 = __builtin_amdgcn_readlane(h4.x, Ls), hb1 = __builtin_amdgcn_readlane(h4.y, Ls), hb2 = __builtin_amdgcn_readlane(h4.z, Ls), hb3 = __builtin_amdgcn_readlane(h4.w, Ls);
        const int bin0 = 4 * (63 - Ls);
        unsigned cum = P_L - c_L; int bstar; unsigned mc;
        if (cum + hb3 >= (unsigned)TOPK) { bstar = bin0 + 3; mc = hb3; }
        else { cum += hb3; if (cum + hb2 >= (unsigned)TOPK) { bstar = bin0 + 2; mc = hb2; }
        else { cum += hb2; if (cum + hb1 >= (unsigned)TOPK) { bstar = bin0 + 1; mc = hb1; }
        else { cum += hb1; bstar = bin0; mc = hb0; } } }
        if (mc <= 256u) {
            fast = true;
            unsigned cbase = 0;
#pragma unroll
            for (int j = 0; j < 32; ++j) { int b = (int)((v[j] - vmn) * scale); b = b > 255 ? 255 : b;
                const u64 m = __ballot(b == bstar);
                if (m) { if (b == bstar) cand[(cbase + __builtin_amdgcn_mbcnt_hi((unsigned)(m >> 32), __builtin_amdgcn_mbcnt_lo((unsigned)m, 0u))) & 255u] = ord_key(v[j]); cbase += popc64(m); } }
            LDS_WAIT();
            const unsigned r = (unsigned)TOPK - cum;
            if (mc <= 64u) {
                const unsigned cu = ((unsigned)lane < mc) ? cand[lane] : 0u;
#pragma unroll 1
                for (int bit = 31; bit >= 0; --bit) { const unsigned ct = T | (1u << bit); if (popc64(__ballot(cu >= ct)) >= r) T = ct; }
                n_gt = cum + popc64(__ballot(cu > T)); n_ge = cum + popc64(__ballot(cu >= T));
            } else {
                unsigned cu[4];
#pragma unroll
                for (int ch = 0; ch < 4; ++ch) cu[ch] = ((unsigned)(lane + 64 * ch) < mc) ? cand[lane + 64 * ch] : 0u;
#pragma unroll 1
                for (int bit = 31; bit >= 0; --bit) { const unsigned ct = T | (1u << bit); unsigned cnt = 0;
#pragma unroll
                    for (int ch = 0; ch < 4; ++ch) cnt += popc64(__ballot(cu[ch] >= ct));
                    if (cnt >= r) T = ct; }
                unsigned cge = 0, cgt = 0;
#pragma unroll
                for (int ch = 0; ch < 4; ++ch) { cge += popc64(__ballot(cu[ch] >= T)); cgt += popc64(__ballot(cu[ch] > T)); }
                n_gt = cum + cgt; n_ge = cum + cge;
            }
        }
    }
    if (!fast) {
#pragma unroll 1
        for (int bit = 31; bit >= 0; --bit) { const unsigned ct = T | (1u << bit); unsigned cnt = 0;
#pragma unroll
            for (int j = 0; j < 32; ++j) cnt += popc64(__ballot(j < njv && ord_key(v[j]) >= ct));
            if (cnt >= (unsigned)TOPK) T = ct; }
        n_gt = 0; n_ge = 0;
#pragma unroll
        for (int j = 0; j < 32; ++j) { const unsigned u = ord_key(v[j]); n_ge += popc64(__ballot(j < njv && u >= T)); n_gt += popc64(__ballot(j < njv && u > T)); }
    }
    const unsigned mneed = (unsigned)TOPK - n_gt, n_eq = n_ge - n_gt;
    u64 myword = 0ull;
    if (n_eq == mneed) {
#pragma unroll
        for (int j = 0; j < 32; ++j) { const u64 w = __ballot(ord_key(v[j]) >= T); myword = (lane == j) ? w : myword; }
    } else {
        unsigned running = 0; const u64 ltmask = (1ull << lane) - 1ull;
#pragma unroll
        for (int j = 0; j < 32; ++j) { const unsigned u = ord_key(v[j]); const u64 eqm = __ballot(u == T); const unsigned pre = running + popc64(eqm & ltmask);
            const u64 w = __ballot(u > T || (u == T && pre < mneed)); running += popc64(eqm); myword = (lane == j) ? w : myword; }
    }
    if (lane < 32) mrow[lane] = myword;
}

DI void indexer_phase(const Frame& F) {
    const bf16_t* QI = (const bf16_t*)(F.ws + WS_HF + HF_QI); const bf16_t* KI = (const bf16_t*)(F.ws + WS_HF + HF_KI);
    const float* WI = (const float*)(F.ws + WS_HF + HF_WI); u64* MASK = (u64*)(F.ws + WS_HF + HF_MASK);
    LAS float* sc = (LAS float*)F.lds;
    LAS unsigned* hist = (LAS unsigned*)(F.lds + 16 * SCP * 4) + F.wave * 256;
    LAS unsigned* cand = (LAS unsigned*)(F.lds + 16 * SCP * 4 + 8192) + F.wave * 256;
    LAS unsigned* ccnt = (LAS unsigned*)(F.lds + 16 * SCP * 4 + 16384) + F.wave * 16;
    const int lane = F.lane, fr = lane & 15, fq = lane >> 4;
    constexpr int NITEM = NB * 32 * 4;
    bf16x8 qa[8][2]; f32x4 wq[4][2];
#define IDX_ITEM(i_, c_, b_, tok0_) const int L_##i_ = (i_) * F.G + (((i_) & 1) ? (F.G - 1 - F.bid) : F.bid); const int c_ = 31 - L_##i_ / 64, b_ = (L_##i_ % 64) >> 2, tok0_ = b_ * SEQ + c_ * 64 + ((L_##i_ % 64) & 3) * 16
#define IDX_LOADQ(tok0_) do { _Pragma("unroll") for (int h = 0; h < 8; ++h) _Pragma("unroll") for (int ks = 0; ks < 2; ++ks) qa[h][ks] = *(const bf16x8*)(QI + (size_t)((tok0_) + fr) * 512 + h * 64 + ks * 32 + fq * 8); \
        _Pragma("unroll") for (int j = 0; j < 4; ++j) { wq[j][0] = *(const f32x4*)(WI + (size_t)((tok0_) + 4 * fq + j) * 8); wq[j][1] = *(const f32x4*)(WI + (size_t)((tok0_) + 4 * fq + j) * 8 + 4); } } while (0)
    { IDX_ITEM(0, c0, b0, t0); (void)b0; if (F.bid < NITEM && c0 >= 4) IDX_LOADQ(t0); }
    for (int i = 0;; ++i) {
        const int L = i * F.G + ((i & 1) ? (F.G - 1 - F.bid) : F.bid); if (L >= NITEM) break;
        const int c = 31 - L / 64, rr = L % 64, b = rr >> 2, g4 = rr & 3;
        const int tok0 = b * SEQ + c * 64 + g4 * 16, nk = 64 * (c + 1);
        const int Ln = (i + 1) * F.G + (((i + 1) & 1) ? (F.G - 1 - F.bid) : F.bid);
        const int cn = 31 - Ln / 64, tokn = ((Ln % 64) >> 2) * SEQ + cn * 64 + ((Ln % 64) & 3) * 16; const bool pre = Ln < NITEM && cn >= 4;
        if (c >= 4) {
            const int ntile = nk / 16, ntw = (ntile - F.wave + 7) >> 3;
            const bf16_t* kbase = KI + (size_t)(b * SEQ + fr) * 64 + fq * 8;
            bf16x8 kA[4][2], kB[4][2];
#define IDX_LOAD(dst, i0) do { _Pragma("unroll") for (int u = 0; u < 4; ++u) { int i_ = (i0) + u; i_ = i_ < ntw ? i_ : ntw - 1; const bf16_t* kp = kbase + (size_t)(F.wave + 8 * i_) * 16 * 64; \
                dst[u][0] = *(const bf16x8*)kp; dst[u][1] = *(const bf16x8*)(kp + 32); } } while (0)
#define IDX_COMP(srcb, i0) do { _Pragma("unroll") for (int u = 0; u < 4; ++u) { const int i_ = (i0) + u; if (i_ < ntw) { const int kt = F.wave + 8 * i_; f32x4 s = {0.f, 0.f, 0.f, 0.f}; \
                _Pragma("unroll") for (int h = 0; h < 8; ++h) { f32x4 acc = {0.f, 0.f, 0.f, 0.f}; \
                    acc = __builtin_amdgcn_mfma_f32_16x16x32_bf16(qa[h][0], srcb[u][0], acc, 0, 0, 0); \
                    acc = __builtin_amdgcn_mfma_f32_16x16x32_bf16(qa[h][1], srcb[u][1], acc, 0, 0, 0); \
                    _Pragma("unroll") for (int j = 0; j < 4; ++j) s[j] += wq[j][h >> 2][h & 3] * fmaxf(acc[j], 0.f); } \
                _Pragma("unroll") for (int j = 0; j < 4; ++j) sc[(4 * fq + j) * SCP + kt * 16 + fr] = s[j]; } } } while (0)
            IDX_LOAD(kA, 0);
            for (int i0 = 0; i0 < ntw; i0 += 8) {
                IDX_LOAD(kB, i0 + 4);
                IDX_COMP(kA, i0);
                IDX_LOAD(kA, i0 + 8);
                IDX_COMP(kB, i0 + 4);
            }
#undef IDX_LOAD
#undef IDX_COMP
            __syncthreads();
            if (pre) IDX_LOADQ(tokn);
#pragma unroll 1
            for (int qq = 0; qq < 2; ++qq) { const int ql = 2 * F.wave + qq;
                select_topk(sc + ql * SCP, c + 1, hist, cand, ccnt, lane, MASK + (size_t)(tok0 + ql) * 32); }
            __syncthreads();
        } else {
            const int q = F.tid >> 5, w = F.tid & 31;
            MASK[(size_t)(tok0 + q) * 32 + w] = (w <= c) ? ~0ull : 0ull;
            if (pre) IDX_LOADQ(tokn);
        }
    }
#undef IDX_ITEM
#undef IDX_LOADQ
}

namespace att {
constexpr float SCALE = 0.08838834764831845f;
constexpr float THR = 8.f;
constexpr int NW = 8, QBLK = 32, KVBLK = 64, QB = NW * QBLK;
constexpr int SHM_V = KVBLK * HD * 2, SHM_K = KVBLK * HD * 2;
#define KSWZ(row, colB) ((row) * 256 + ((colB) ^ (((row) & 7) << 4)))
#define SBAR() __builtin_amdgcn_sched_barrier(0)
DI int v_st(int k, int c) { const int kk = (k & ~0xC) | ((k & 4) << 1) | ((k & 8) >> 1); return ((kk >> 3) * 4 + (c >> 5)) * 512 + ((kk & 7) * 32 + (c & 31)) * 2; }
DI int v_rd_base(int lane) { return ((lane & 3) << 3) | (((lane >> 2) & 3) << 6) | (((lane >> 4) & 1) << 5) | (((lane >> 5) & 1) << 8); }
constexpr int v_rd_off(int d0, int ks, int half) { return d0 * 512 + ks * 4096 + half * 2048; }
DI int crow(int r, int hi) { return (r & 3) + 8 * (r >> 2) + 4 * hi; }

DI void partialSM(f32x16& p0, f32x16& p1, float& m_reg, float& mn, float& alpha) {
    float pmax = p0[0];
#pragma unroll
    for (int r = 1; r < 16; ++r) pmax = fmaxf(pmax, p0[r]);
#pragma unroll
    for (int r = 0; r < 16; ++r) pmax = fmaxf(pmax, p1[r]);
    { auto rr = __builtin_amdgcn_permlane32_swap(__float_as_uint(pmax), __float_as_uint(pmax), false, false);
      pmax = fmaxf(__uint_as_float(rr[0]), __uint_as_float(rr[1])); }
    constexpr float C2 = 1.4426950408889634f * SCALE;
    if (__builtin_expect(__all((pmax - m_reg) * SCALE <= THR), 1)) { mn = m_reg; alpha = 1.f; }
    else { mn = fmaxf(m_reg, pmax); alpha = __builtin_amdgcn_exp2f((m_reg - mn) * C2); m_reg = mn; }
    const float mnL = -mn * C2;
#pragma unroll
    for (int r = 0; r < 16; ++r) p0[r] = fmaf(p0[r], C2, mnL);
#pragma unroll
    for (int r = 0; r < 16; ++r) p1[r] = fmaf(p1[r], C2, mnL);
#pragma unroll
    for (int r = 0; r < 16; ++r) p0[r] = __builtin_amdgcn_exp2f(p0[r]);
}
#define PK4(P, B_, OUT) do { unsigned a0 = cvt_pk_bf16(P[B_+0], P[B_+1]), a1 = cvt_pk_bf16(P[B_+2], P[B_+3]);                          \
        unsigned b0 = cvt_pk_bf16(P[B_+4], P[B_+5]), b1 = cvt_pk_bf16(P[B_+6], P[B_+7]);                                             \
        auto r0 = __builtin_amdgcn_permlane32_swap(a0, b0, false, false); auto r1 = __builtin_amdgcn_permlane32_swap(a1, b1, false, false); \
        u32x4 w = {r0[0], r1[0], r0[1], r1[1]}; OUT = *reinterpret_cast<bf16x8*>(&w); } while (0)
DI void finishSM(f32x16& p0, f32x16& p1, float alpha, float& l_reg, bf16x8& pa0, bf16x8& pa1, bf16x8& pa2, bf16x8& pa3) {
#pragma unroll
    for (int r = 0; r < 16; ++r) p1[r] = __builtin_amdgcn_exp2f(p1[r]);
    float ps = 0;
#pragma unroll
    for (int r = 0; r < 16; ++r) ps += p0[r];
#pragma unroll
    for (int r = 0; r < 16; ++r) ps += p1[r];
    { auto rr = __builtin_amdgcn_permlane32_swap(__float_as_uint(ps), __float_as_uint(ps), false, false);
      ps = __uint_as_float(rr[0]) + __uint_as_float(rr[1]); }
    l_reg = l_reg * alpha + ps;
    PK4(p0, 0, pa0); PK4(p0, 8, pa1); PK4(p1, 0, pa2); PK4(p1, 8, pa3);
}
DI void packP(const f32x16& p0, const f32x16& p1, bf16x8& pa0, bf16x8& pa1, bf16x8& pa2, bf16x8& pa3) {
    PK4(p0, 0, pa0); PK4(p0, 8, pa1); PK4(p1, 0, pa2); PK4(p1, 8, pa3);
}
template <int KB>
DI void qkt(f32x16& p0, f32x16& p1, const LAS char* K_lds, int r32, int hi, const bf16x8* qr) {
    p0 = f32x16{}; p1 = f32x16{};
    const LAS char* kb[4];
#pragma unroll
    for (int dd = 0; dd < 4; ++dd) kb[dd] = K_lds + KB * SHM_K + KSWZ(r32, (dd * 16 + hi * 8) * 2);
#pragma unroll
    for (int d0 = 0; d0 < 8; ++d0) { const LAS char* a = kb[d0 & 3] + (d0 >> 2) * 128;
        bf16x8 b0 = *reinterpret_cast<const LAS bf16x8*>(a);
        bf16x8 b1 = *reinterpret_cast<const LAS bf16x8*>(a + 32 * 256);
        p0 = __builtin_amdgcn_mfma_f32_32x32x16_bf16(b0, qr[d0], p0, 0, 0, 0);
        p1 = __builtin_amdgcn_mfma_f32_32x32x16_bf16(b1, qr[d0], p1, 0, 0, 0); }
}
template <int VB>
DI void pv_tile(f32x16* o, int vb0, bf16x8 pa0, bf16x8 pa1, bf16x8 pa2, bf16x8 pa3) {
#define TRRD(dst, off) asm volatile("ds_read_b64_tr_b16 %0, %1 offset:%2" : "=&v"(dst) : "v"(vb0), "i"(off) : "memory")
#define PV_D0(d0) do { s16x4 l0, l1, l2, l3, h0, h1, h2, h3; constexpr int b_ = VB * SHM_V + v_rd_off(d0, 0, 0);   \
        TRRD(l0, b_); TRRD(h0, b_ + 2048); TRRD(l1, b_ + 4096); TRRD(h1, b_ + 6144); TRRD(l2, b_ + 8192); TRRD(h2, b_ + 10240); TRRD(l3, b_ + 12288); TRRD(h3, b_ + 14336); \
        asm volatile("s_waitcnt lgkmcnt(0)" ::: "memory"); SBAR();   \
        o[d0] = __builtin_amdgcn_mfma_f32_32x32x16_bf16(pa0, (bf16x8){l0[0], l0[1], l0[2], l0[3], h0[0], h0[1], h0[2], h0[3]}, o[d0], 0, 0, 0);   \
        o[d0] = __builtin_amdgcn_mfma_f32_32x32x16_bf16(pa1, (bf16x8){l1[0], l1[1], l1[2], l1[3], h1[0], h1[1], h1[2], h1[3]}, o[d0], 0, 0, 0);   \
        o[d0] = __builtin_amdgcn_mfma_f32_32x32x16_bf16(pa2, (bf16x8){l2[0], l2[1], l2[2], l2[3], h2[0], h2[1], h2[2], h2[3]}, o[d0], 0, 0, 0);   \
        o[d0] = __builtin_amdgcn_mfma_f32_32x32x16_bf16(pa3, (bf16x8){l3[0], l3[1], l3[2], l3[3], h3[0], h3[1], h3[2], h3[3]}, o[d0], 0, 0, 0); } while (0)
    PV_D0(0); PV_D0(1); PV_D0(2); PV_D0(3);
#undef PV_D0
#undef TRRD
}
struct Stage { bf16x8 k0, k1, v0, v1; };
DI void sload(Stage& s, const bf16_t* Kp, const bf16_t* Vp, size_t tokbase, int k0, int sr, int hcol) {
    const size_t o0 = (tokbase + k0 + sr) * DM + hcol, o1 = o0 + (size_t)32 * DM;
    s.v0 = *(const bf16x8*)(Vp + o0); s.v1 = *(const bf16x8*)(Vp + o1); s.k0 = *(const bf16x8*)(Kp + o0); s.k1 = *(const bf16x8*)(Kp + o1);
}
DI void swrite(const Stage& s, LAS char* V_lds, LAS char* K_lds, int bf, int kws, int vst0, int vst1) {
    *(LAS bf16x8*)(V_lds + bf * SHM_V + vst0) = s.v0; *(LAS bf16x8*)(V_lds + bf * SHM_V + vst1) = s.v1;
    *(LAS bf16x8*)(K_lds + bf * SHM_K + kws) = s.k0; *(LAS bf16x8*)(K_lds + bf * SHM_K + kws + 32 * 256) = s.k1;
}
DI void store_o(const f32x16* o, const float* rli, bf16_t* Ow, int r32, int hi) {
#pragma unroll
    for (int r = 0; r < 16; ++r) { const int orow = crow(r, hi);
#pragma unroll
        for (int d0 = 0; d0 < 4; ++d0) { const float v = o[d0][r] * rli[r]; const float vn = __shfl_xor(v, 1);
            if ((r32 & 1) == 0) *(unsigned*)(Ow + (size_t)orow * DM + d0 * 32 + r32) = cvt_pk_bf16(v, vn); } }
}

DI void attnA_phase(const Frame& F) {
    const bf16_t* Q = (const bf16_t*)(F.ws + WS_R1); const bf16_t* Kt = Q + (size_t)NTOK * DM; const bf16_t* Vt = Kt + (size_t)NTOK * DM;
    bf16_t* O = (bf16_t*)(F.ws + WS_HF + 64 * MiB); const u64* MASK = (const u64*)(F.ws + WS_HF + HF_MASK);
    LAS char* V_lds = (LAS char*)F.lds; LAS char* K_lds = V_lds + 2 * SHM_V;
    const int tid = F.tid, wid = F.wave, lane = F.lane, r32 = lane & 31, hi = lane >> 5;
    LAS float* wsl = (LAS float*)(F.lds + 2 * SHM_V + 2 * SHM_K) + wid * 64; LAS float* li_l = wsl; LAS float* al_l = wsl + 32;
    const int sr = tid >> 4, sc = (tid & 15) * 8, vst0 = v_st(sr, sc), vst1 = v_st(32 + sr, sc), kws = KSWZ(sr, sc * 2);
    const int vb0 = (int)(uintptr_t)V_lds + v_rd_base(lane);
    constexpr int NITEM = NB * NH * 8;
    for (int it = F.bid; it < NITEM; it += F.G) {
        int bh, qb;
        if (F.G == 256) { const int pass = it >> 8, xcd = F.bid & 7, slot = F.bid >> 3, grp = slot >> 3, mem = slot & 7; bh = (pass * 4 + grp) * 8 + xcd; qb = (pass & 1) ? 7 - mem : mem; }
        else { bh = it >> 3; qb = it & 7; }
        const int b = bh >> 3, h = bh & 7, q0 = qb * QB, NT = 4 * (qb + 1);
        const size_t tokbase = (size_t)b * SEQ; const int hcol = h * HD + sc;
        const int qrow = q0 + wid * QBLK + r32, myc = (q0 + wid * QBLK) >> 6;
        bf16x8 qr[8];
#pragma unroll
        for (int d0 = 0; d0 < 8; ++d0) qr[d0] = *(const bf16x8*)(Q + (tokbase + qrow) * DM + h * HD + d0 * 16 + hi * 8);
        const u64* mrow = MASK + (tokbase + qrow) * 32;
        float m_reg = -1e30f, l_reg = 0.f; f32x16 o[4] = {};
        Stage st; sload(st, Kt, Vt, tokbase, 0, sr, hcol);
        u64 mw = mrow[0], mwn = mrow[1];
        asm volatile("s_waitcnt vmcnt(0)" ::: "memory");
        swrite(st, V_lds, K_lds, 0, kws, vst0, vst1);
        __syncthreads();
        f32x16 pA0, pA1, pB0, pB1; float mnA, mnB, alA = 1.f, alB = 1.f; bf16x8 pa0, pa1, pa2, pa3;
#define A_MSEL(P, M, BIT) do { const unsigned t_ = (unsigned)__builtin_amdgcn_sbfe((int)(M), (BIT), 1); P = __uint_as_float((__float_as_uint(P) & t_) | (__float_as_uint(ninf_) & ~t_)); } while (0)
#define A_MASK(P0, P1) do { const unsigned mlo = (unsigned)mw >> (4 * hi), mhi = (unsigned)(mw >> 32) >> (4 * hi); const float ninf_ = -__builtin_inff(); \
            _Pragma("unroll") for (int r = 0; r < 16; ++r) { A_MSEL(P0[r], mlo, (r & 3) + 8 * (r >> 2)); A_MSEL(P1[r], mhi, (r & 3) + 8 * (r >> 2)); } } while (0)
#define A_RESC(a) do { if (__any((a) < 1.f)) { if (hi == 0) al_l[r32] = (a); LDS_WAIT();                              \
                _Pragma("unroll") for (int d_ = 0; d_ < 4; ++d_) _Pragma("unroll") for (int r = 0; r < 16; ++r) o[d_][r] *= al_l[crow(r, hi)]; } } while (0)
        sload(st, Kt, Vt, tokbase, KVBLK, sr, hcol);
        qkt<0>(pA0, pA1, K_lds, r32, hi, qr);
        A_MASK(pA0, pA1); partialSM(pA0, pA1, m_reg, mnA, alA);
        asm volatile("s_waitcnt vmcnt(0)" ::: "memory"); swrite(st, V_lds, K_lds, 1, kws, vst0, vst1); mw = mwn;
        __syncthreads();
#define A_HALF(PX0, PX1, mnX, alX, PY0, PY1, alY, t, KB, VB, SB) do { const bool actT = (t) <= myc, actP = (t) - 1 <= myc, more = (t) + 1 < NT; \
        if (more) mwn = mrow[(t) + 1];                                                                              \
        SBAR(); if (actT) qkt<KB>(PX0, PX1, K_lds, r32, hi, qr);                                                    \
        if (actP) { finishSM(PY0, PY1, alY, l_reg, pa0, pa1, pa2, pa3); } SBAR();                                   \
        if (more) sload(st, Kt, Vt, tokbase, ((t) + 1) * KVBLK, sr, hcol);                                          \
        SBAR(); if (actP) pv_tile<VB>(o, vb0, pa0, pa1, pa2, pa3);                                                  \
        if (actT) { A_MASK(PX0, PX1); partialSM(PX0, PX1, m_reg, mnX, alX); }                                       \
        __syncthreads();                                                                                            \
        if (more) { asm volatile("s_waitcnt vmcnt(0)" ::: "memory"); swrite(st, V_lds, K_lds, SB, kws, vst0, vst1); } \
        mw = mwn;                                                                                                   \
        if (actT) A_RESC(alX);                                                                                      \
        __syncthreads(); } while (0)
        for (int t = 1; t + 1 < NT; t += 2) {
            A_HALF(pB0, pB1, mnB, alB, pA0, pA1, alA, t, 1, 0, 0);
            A_HALF(pA0, pA1, mnA, alA, pB0, pB1, alB, t + 1, 0, 1, 1);
        }
        { const bool actT = NT - 1 <= myc, actP = NT - 2 <= myc;
          SBAR(); if (actT) qkt<1>(pB0, pB1, K_lds, r32, hi, qr);
          if (actP) { finishSM(pA0, pA1, alA, l_reg, pa0, pa1, pa2, pa3); SBAR(); pv_tile<0>(o, vb0, pa0, pa1, pa2, pa3); }
          if (actT) { A_MASK(pB0, pB1); partialSM(pB0, pB1, m_reg, mnB, alB); A_RESC(alB);
                      finishSM(pB0, pB1, alB, l_reg, pa0, pa1, pa2, pa3); SBAR(); pv_tile<1>(o, vb0, pa0, pa1, pa2, pa3); } }
#undef A_HALF
#undef A_MASK
#undef A_MSEL
#undef A_RESC
        if (hi == 0) li_l[r32] = l_reg; LDS_WAIT();
        float rli[16];
#pragma unroll
        for (int r = 0; r < 16; ++r) rli[r] = __builtin_amdgcn_rcpf(li_l[crow(r, hi)]);
        store_o(o, rli, O + (tokbase + q0 + wid * QBLK) * DM + h * HD, r32, hi);
        __syncthreads();
    }
}

DI void attnB_phase(const Frame& F) {
    const bf16_t* Q = (const bf16_t*)(F.ws + WS_R1); const bf16_t* Kt = Q + (size_t)NTOK * DM; const bf16_t* Vt = Kt + (size_t)NTOK * DM;
    bf16_t* O = (bf16_t*)(F.ws + WS_HF + 64 * MiB);
    LAS char* V_lds = (LAS char*)F.lds; LAS char* K_lds = V_lds + 3 * SHM_V;
    const int tid = F.tid, wid = F.wave, lane = F.lane, r32 = lane & 31, hi = lane >> 5;
    LAS int* flags = (LAS int*)(F.lds + 3 * SHM_V + 3 * SHM_K);
    const int vb0 = (int)(uintptr_t)V_lds + v_rd_base(lane);
    unsigned offK[2], offV[2];
#pragma unroll
    for (int i = 0; i < 2; ++i) { const int p = i * 512 + wid * 64 + lane;
        { const int row = p >> 4, ch = (p & 15) ^ (row & 7); offK[i] = (unsigned)(row * DM + ch * 8) * 2u; }
        { const int sub = p >> 5, kk = (sub >> 2) * 8 + ((p & 31) >> 2), col = (sub & 3) * 32 + (p & 3) * 8, k = (kk & ~0xC) | ((kk & 4) << 1) | ((kk & 8) >> 1); offV[i] = (unsigned)(k * DM + col) * 2u; } }
    const unsigned ldsw = (unsigned)wid * 1024u;
    constexpr float C2 = 1.4426950408889634f * SCALE;
    constexpr int NITEM = NB * NH * 8;
    for (int it = F.bid; it < NITEM; it += F.G) {
        int bh, qb;
        if (F.G == 256) { const int pass = it >> 8, xcd = F.bid & 7, slot = F.bid >> 3, grp = slot >> 3, mem = slot & 7; bh = (pass * 4 + grp) * 8 + xcd; qb = (pass & 1) ? 7 - mem : mem; }
        else { bh = it >> 3; qb = it & 7; }
        const int b = bh >> 3, h = bh & 7, q0 = qb * QB;
        const size_t tokbase = (size_t)b * SEQ;
        const int qw0 = q0 + wid * QBLK, qrow = qw0 + r32, t_hi = 4 * (qb + 1) - 1, t_w = (qw0 + QBLK - 1) >> 6;
        const char* Kb = (const char*)(Kt + tokbase * DM + h * HD); const char* Vb = (const char*)(Vt + tokbase * DM + h * HD);
        bf16x8 qr[8];
#pragma unroll
        for (int d0 = 0; d0 < 8; ++d0) qr[d0] = *(const bf16x8*)(Q + (tokbase + qrow) * DM + h * HD + d0 * 16 + hi * 8);
        float carry = 1.f; int done_w = 0; f32x16 o[4] = {};
#define B_DMA(t_, SLOT) do { const size_t tb_ = (size_t)(t_) * KVBLK * DM * 2; _Pragma("unroll") for (int i = 0; i < 2; ++i) { \
            __builtin_amdgcn_global_load_lds((const unsigned*)(Kb + tb_ + offK[i]), (LAS unsigned*)(K_lds + (SLOT) * SHM_K + ldsw + i * 8192), 16, 0, 0); \
            __builtin_amdgcn_global_load_lds((const unsigned*)(Vb + tb_ + offV[i]), (LAS unsigned*)(V_lds + (SLOT) * SHM_V + ldsw + i * 8192), 16, 0, 0); } } while (0)
        asm volatile("s_waitcnt vmcnt(0)" ::: "memory");
        B_DMA(t_hi, 0); B_DMA(t_hi - 1, 1);
        asm volatile("s_waitcnt vmcnt(4)" ::: "memory");
        __builtin_amdgcn_s_barrier(); asm volatile("" ::: "memory");
        bool stop = false;
#define B_STEP(itn, SLOT, SLOTW) do { const int t = t_hi - (itn); const bool more = t > 0, more2 = t > 1;              \
        if (more2) B_DMA(t - 2, SLOTW);                                                                             \
        if (t <= t_w && !done_w) { f32x16 p0, p1, l0v, l1v; bf16x8 pa0, pa1, pa2, pa3;                               \
            qkt<SLOT>(p0, p1, K_lds, r32, hi, qr);                                                                  \
            const int dq = qrow - t * KVBLK - 4 * hi;                                                               \
              \
            _Pragma("unroll") for (int r = 0; r < 16; ++r) { const int cr = (r & 3) + 8 * (r >> 2);                 \
                const float e0 = __builtin_amdgcn_exp2f(-fmaxf(p0[r] * C2, -100.f)), e1 = __builtin_amdgcn_exp2f(-fmaxf(p1[r] * C2, -100.f)); \
                const float g0 = __builtin_amdgcn_rcpf(1.0f + e0), g1 = __builtin_amdgcn_rcpf(1.0f + e1);         \
                const bool v0 = cr < dq, v1 = cr + 32 < dq;                                                         \
                p0[r] = v0 ? g0 : 0.f; p1[r] = v1 ? g1 : 0.f;                                                       \
                l0v[r] = v0 ? e0 * g0 : 1.f; l1v[r] = v1 ? e1 * g1 : 1.f; }                                         \
            float gs[8];                                                                                            \
            _Pragma("unroll") for (int g = 0; g < 4; ++g) { gs[g] = (l0v[4 * g] * l0v[4 * g + 1]) * (l0v[4 * g + 2] * l0v[4 * g + 3]); \
                                                            gs[4 + g] = (l1v[4 * g] * l1v[4 * g + 1]) * (l1v[4 * g + 2] * l1v[4 * g + 3]); } \
            float acc = carry;                                                                                      \
            _Pragma("unroll") for (int g = 7; g >= 0; --g) {                                                        \
                auto rr = __builtin_amdgcn_permlane32_swap(__float_as_uint(gs[g]), __float_as_uint(gs[g]), false, false); \
                const float slo = __uint_as_float(rr[0]), shi = __uint_as_float(rr[1]);                             \
                float run = acc * (hi ? 1.f : shi);                                                                 \
                _Pragma("unroll") for (int j = 3; j >= 0; --j) { const int r = 4 * (g & 3) + j;                     \
                    if (g >= 4) { const float a_ = p1[r] * run; run *= l1v[r]; p1[r] = a_; }                        \
                    else        { const float a_ = p0[r] * run; run *= l0v[r]; p0[r] = a_; } }                      \
                acc *= slo * shi; }                                                                                 \
            carry = acc;                                                                                            \
            packP(p0, p1, pa0, pa1, pa2, pa3); SBAR();                                                              \
            pv_tile<SLOT>(o, vb0, pa0, pa1, pa2, pa3);                                                              \
            done_w = __all(carry < 1.0e-37f) ? 1 : 0; }                                                                     \
        if (lane == 0) flags[((itn) & 1) * 8 + wid] = done_w;                                                       \
        if (more2) asm volatile("s_waitcnt vmcnt(4)" ::: "memory"); else asm volatile("s_waitcnt vmcnt(0)" ::: "memory");     \
        LDS_WAIT(); __builtin_amdgcn_s_barrier(); asm volatile("" ::: "memory");                                    \
        { int alld = 1; _Pragma("unroll") for (int w = 0; w < 8; ++w) alld &= flags[((itn) & 1) * 8 + w]; stop = (alld != 0) || !more; } } while (0)
        for (int itn = 0;; itn += 3) { B_STEP(itn, 0, 2); if (stop) break; B_STEP(itn + 1, 1, 0); if (stop) break; B_STEP(itn + 2, 2, 1); if (stop) break; }
#undef B_STEP
#undef B_DMA
        asm volatile("s_waitcnt vmcnt(0)" ::: "memory");
        float rli[16];
#pragma unroll
        for (int r = 0; r < 16; ++r) rli[r] = 1.0f;
        store_o(o, rli, O + (tokbase + qw0) * DM + h * HD, r32, hi);
        __syncthreads();
    }
}
#undef PK4
}

DI void route16(const float (&lg)[16], const float (&bias)[16], int& e0, int& e1, float& w0, float& w1) {
    float mx = lg[0];
#pragma unroll
    for (int i = 1; i < 16; ++i) mx = fmaxf(mx, lg[i]);
    float pr[16], sum = 0.f;
#pragma unroll
    for (int i = 0; i < 16; ++i) { pr[i] = __builtin_amdgcn_exp2f((lg[i] - mx) * 1.4426950408889634f); sum += pr[i]; }
    float sel[16];
#pragma unroll
    for (int i = 0; i < 16; ++i) { pr[i] = pr[i] / sum; sel[i] = pr[i] + bias[i]; }
    float gsc[4];
#pragma unroll
    for (int g = 0; g < 4; ++g) { const float a = sel[4 * g], b = sel[4 * g + 1], c = sel[4 * g + 2], d = sel[4 * g + 3];
        gsc[g] = fmaxf(fmaxf(fmaxf(a + b, a + c), fmaxf(a + d, b + c)), fmaxf(b + d, c + d)); }
    int g = 0; float best = gsc[0];
#pragma unroll
    for (int i = 1; i < 4; ++i) if (gsc[i] > best) { best = gsc[i]; g = i; }
    float xs[4], ps[4];
#pragma unroll
    for (int j = 0; j < 4; ++j) { xs[j] = (g == 0) ? sel[j] : (g == 1) ? sel[4 + j] : (g == 2) ? sel[8 + j] : sel[12 + j];
                                  ps[j] = (g == 0) ? pr[j] : (g == 1) ? pr[4 + j] : (g == 2) ? pr[8 + j] : pr[12 + j]; }
    int i1 = 0; float b1 = xs[0];
#pragma unroll
    for (int j = 1; j < 4; ++j) if (xs[j] > b1) { b1 = xs[j]; i1 = j; }
    int i2 = -1; float b2 = -__builtin_inff();
#pragma unroll
    for (int j = 0; j < 4; ++j) if (j != i1 && (i2 < 0 || xs[j] > b2)) { b2 = xs[j]; i2 = j; }
    const float p1 = (i1 == 0) ? ps[0] : (i1 == 1) ? ps[1] : (i1 == 2) ? ps[2] : ps[3];
    const float p2 = (i2 == 0) ? ps[0] : (i2 == 1) ? ps[1] : (i2 == 2) ? ps[2] : ps[3];
    const float s = p1 + p2;
    e0 = 4 * g + i1; e1 = 4 * g + i2; w0 = p1 / s; w1 = p2 / s;
}

DI f32x4 bf4(u32x2 a) { f32x4 r; r[0] = __uint_as_float(a.x << 16); r[1] = __uint_as_float(a.x & 0xFFFF0000u); r[2] = __uint_as_float(a.y << 16); r[3] = __uint_as_float(a.y & 0xFFFF0000u); return r; }
struct LnRow { f32x4 hp[4]; u32x2 hb[4], ya[4], yb[4]; };
template <bool HPF, int NADD>
DI void ln_load(LnRow& R, size_t row, int lane, const void* hprev, const bf16_t* y0, const bf16_t* y1) {
#pragma unroll
    for (int i = 0; i < 4; ++i) { const size_t off = row * DM + 4 * lane + 256 * i;
        if (HPF) R.hp[i] = *(const f32x4*)((const float*)hprev + off); else R.hb[i] = *(const u32x2*)((const bf16_t*)hprev + off);
        R.ya[i] = *(const u32x2*)(y0 + off);
        if (NADD == 2) R.yb[i] = *(const u32x2*)(y1 + off); }
}
template <bool HPF, int NADD, bool OUTF>
DI float ln_row(LnRow& R, f32x4 (&v)[4], size_t row, int lane, const f32x4 (&g4)[4], const f32x4 (&b4)[4], void* out, signed char* out8, float* sc8) {
#pragma unroll
    for (int i = 0; i < 4; ++i) { f32x4 ad = bf4(R.ya[i]); if (NADD == 2) ad = ad + bf4(R.yb[i]);
        const f32x4 hp = HPF ? R.hp[i] : bf4(R.hb[i]);
        v[i] = hp * DN_ALPHA + ad; }
    float s = 0.f;
#pragma unroll
    for (int i = 0; i < 4; ++i) s += (v[i][0] + v[i][1]) + (v[i][2] + v[i][3]);
    const float mean = wave_sum(s) * (1.0f / DM);
    float q = 0.f;
#pragma unroll
    for (int i = 0; i < 4; ++i) { v[i] = v[i] - mean; q += (v[i][0] * v[i][0] + v[i][1] * v[i][1]) + (v[i][2] * v[i][2] + v[i][3] * v[i][3]); }
    const float rstd = __builtin_amdgcn_rsqf(wave_sum(q) * (1.0f / DM) + LN_EPS);
#pragma unroll
    for (int i = 0; i < 4; ++i) { v[i] = v[i] * rstd * g4[i] + b4[i]; const size_t off = row * DM + 4 * lane + 256 * i;
        if (OUTF) *(f32x4*)((float*)out + off) = v[i];
        else { u32x2 w; w.x = cvt_pk_bf16(v[i][0], v[i][1]); w.y = cvt_pk_bf16(v[i][2], v[i][3]); *(u32x2*)((bf16_t*)out + off) = w; } }
    return out8 ? quant_row(v, lane, out8 + row * DM, sc8 + row) : 0.f;
}
DI float tr_reduce16(float (&pe)[16], int lane) {
    float r8[8], r4[4], r2[2], r1;
#pragma unroll
    for (int k = 0; k < 8; ++k) { const bool od = lane & 1; const float keep = od ? pe[2 * k + 1] : pe[2 * k], send = od ? pe[2 * k] : pe[2 * k + 1]; r8[k] = keep + __shfl_xor(send, 1); }
#pragma unroll
    for (int k = 0; k < 4; ++k) { const bool od = lane & 2; const float keep = od ? r8[2 * k + 1] : r8[2 * k], send = od ? r8[2 * k] : r8[2 * k + 1]; r4[k] = keep + __shfl_xor(send, 2); }
#pragma unroll
    for (int k = 0; k < 2; ++k) { const bool od = lane & 4; const float keep = od ? r4[2 * k + 1] : r4[2 * k], send = od ? r4[2 * k] : r4[2 * k + 1]; r2[k] = keep + __shfl_xor(send, 4); }
    { const bool od = lane & 8; const float keep = od ? r2[1] : r2[0], send = od ? r2[0] : r2[1]; r1 = keep + __shfl_xor(send, 8); }
    r1 += __shfl_xor(r1, 16); r1 += __shfl_xor(r1, 32);
    return r1;
}
DI void router_rows2(const f32x4 (&va)[4], const f32x4 (&vb)[4], const LAS float* wrT, int lane, float& la, float& lb) {
    float pa[16], pb[16];
#pragma unroll
    for (int e = 0; e < 16; ++e) { float a = 0.f, b = 0.f;
#pragma unroll
        for (int i = 0; i < 4; ++i) { const f32x4 w = *(const LAS f32x4*)(wrT + e * DM + 4 * lane + 256 * i);
            a += (va[i][0] * w[0] + va[i][1] * w[1]) + (va[i][2] * w[2] + va[i][3] * w[3]);
            b += (vb[i][0] * w[0] + vb[i][1] * w[1]) + (vb[i][2] * w[2] + vb[i][3] * w[3]); }
        pa[e] = a; pb[e] = b; }
    la = tr_reduce16(pa, lane); lb = tr_reduce16(pb, lane);
}
template <bool HPF, int NADD, bool OUTF, bool ROUTER>
DI void ln_phase(const Frame& F, const void* hprev, const bf16_t* y0, const bf16_t* y1, const float* gam, const float* bet, void* out,
                 const float* router_w, const float* router_b, unsigned* cnt, int* list, float* gatew, signed char* out8 = nullptr, float* sc8 = nullptr, float* lscale = nullptr) {
    LAS float* wrT = (LAS float*)F.lds;
    LAS float* lsc = (LAS float*)(F.lds + 16 * DM * 4) + F.wave * 272;
    float rb[16];
    if (ROUTER) {
        { f32x4 rw[8];
#pragma unroll
          for (int i = 0; i < 8; ++i) rw[i] = *(const f32x4*)(router_w + (size_t)(F.tid + 512 * i) * 4);
#pragma unroll
          for (int i = 0; i < 8; ++i) { const int q = F.tid + 512 * i, c = q >> 2, e4 = (q & 3) * 4;
#pragma unroll
              for (int j = 0; j < 4; ++j) wrT[(e4 + j) * DM + c] = rw[i][j]; } }
#pragma unroll
        for (int e = 0; e < 16; ++e) rb[e] = router_b[e];
        __syncthreads();
    }
    const int lane = F.lane;
    f32x4 g4[4], b4[4];
#pragma unroll
    for (int i = 0; i < 4; ++i) { g4[i] = *(const f32x4*)(gam + 4 * lane + 256 * i); b4[i] = *(const f32x4*)(bet + 4 * lane + 256 * i); }
    for (int c0 = F.bid * 8; c0 < NTOK / 16; c0 += F.G * 8) {
        const int chunk = c0 + F.wave; const bool cvalid = chunk < NTOK / 16;
        const size_t row0 = (size_t)(cvalid ? chunk : 0) * 16;
        float my_sc = 0.f;
        if (cvalid) {
            LnRow RA, RB; f32x4 va[4], vb[4];
            ln_load<HPF, NADD>(RA, row0, lane, hprev, y0, y1);
#pragma unroll 1
            for (int ri = 0; ri < 16; ri += 2) {
                ln_load<HPF, NADD>(RB, row0 + ri + 1, lane, hprev, y0, y1);
                { const float rs_ = ln_row<HPF, NADD, OUTF>(RA, va, row0 + ri, lane, g4, b4, out, out8, sc8); my_sc = (lane == ri) ? rs_ : my_sc; }
                if (ri + 2 < 16) ln_load<HPF, NADD>(RA, row0 + ri + 2, lane, hprev, y0, y1);
                { const float rs_ = ln_row<HPF, NADD, OUTF>(RB, vb, row0 + ri + 1, lane, g4, b4, out, out8, sc8); my_sc = (lane == ri + 1) ? rs_ : my_sc; }
                if (ROUTER) { float la, lb; router_rows2(va, vb, wrT, lane, la, lb); if (lane < 16) { lsc[ri * 17 + lane] = la; lsc[(ri + 1) * 17 + lane] = lb; } }
            }
        }
        if (ROUTER) {
            LDS_WAIT();
            float lg[16];
#pragma unroll
            for (int e = 0; e < 16; ++e) lg[e] = lsc[(lane & 15) * 17 + e];
            LDS_WAIT();
            int my_e0, my_e1; float my_w0, my_w1; route16(lg, rb, my_e0, my_e1, my_w0, my_w1);
            const size_t row = row0 + lane; const bool act = lane < 16 && cvalid;
            const u64 ltmask = (1ull << lane) - 1ull;
            LAS unsigned* wcnt = (LAS unsigned*)(F.lds + 16 * DM * 4 + 8 * 272 * 4);
            LAS unsigned* wbase = wcnt + 128;
            unsigned mycnt = 0;
#pragma unroll
            for (int e = 0; e < NEXP; ++e) { const unsigned n = popc64(__ballot(act && my_e0 == e)) + popc64(__ballot(act && my_e1 == e)); mycnt = (lane == e) ? n : mycnt; }
            if (lane < 16) wcnt[F.wave * 16 + lane] = mycnt;
            __syncthreads();
            if (F.wave == 0 && lane < 16) { unsigned tot = 0, pre[8];
#pragma unroll
                for (int w = 0; w < 8; ++w) { pre[w] = tot; tot += wcnt[w * 16 + lane]; }
                const unsigned base = tot ? atomicAdd(cnt + 64 * lane, tot) : 0u;
#pragma unroll
                for (int w = 0; w < 8; ++w) wbase[w * 16 + lane] = base + pre[w]; }
            __syncthreads();
#pragma unroll 1
            for (int e = 0; e < NEXP; ++e) {
                const u64 m0 = __ballot(act && my_e0 == e), m1 = __ballot(act && my_e1 == e);
                const unsigned n0 = popc64(m0);
                if (m0 | m1) { const unsigned base = wbase[F.wave * 16 + e];
                    if (act && my_e0 == e) { const size_t p = (size_t)e * LISTCAP + base + popc64(m0 & ltmask); list[p] = (int)(row * 2); gatew[p] = my_w0; lscale[p] = my_sc; }
                    if (act && my_e1 == e) { const size_t p = (size_t)e * LISTCAP + base + n0 + popc64(m1 & ltmask); list[p] = (int)(row * 2 + 1); gatew[p] = my_w1; lscale[p] = my_sc; } }
            }
            __syncthreads();
        }
    }
    if (ROUTER) __syncthreads();
}

DI void moe_table(const Frame& F, const unsigned* cnt) {
    LAS int* tab = (LAS int*)(F.lds + MISC_OFF + 64);
    if (F.tid < NEXP) tab[17 + F.tid] = (int)__hip_atomic_load(cnt + 64 * F.tid, __ATOMIC_RELAXED, __HIP_MEMORY_SCOPE_AGENT);
    __syncthreads();
    if (F.tid == 0) { int acc = 0;
        for (int e = 0; e < NEXP; ++e) { tab[e] = acc; acc += (tab[17 + e] + 255) >> 8; }
        tab[16] = acc; }
    __syncthreads();
}

__global__ void __launch_bounds__(512, 2) yoco_fwd(Args args) {
    extern __shared__ __attribute__((aligned(16))) unsigned char lds_raw[];
    Frame F;
    F.lds = (LAS unsigned char*)lds_raw; F.tid = threadIdx.x; F.lane = F.tid & 63; F.wave = __builtin_amdgcn_readfirstlane(F.tid >> 6);
    F.G = gridDim.x; F.bid = blockIdx.x; F.ws = args.ws; F.ctl = (unsigned*)(args.ws + WS_CTL);
    volatile LAS unsigned* misc = (volatile LAS unsigned*)(F.lds + MISC_OFF);
    if (F.tid < 4) misc[F.tid] = 0u;
    __syncthreads();
    XcdBarrier bar; bar.bar = F.ctl + CW_BAR; bar.x = 0; bar.st = misc;
    const int lo = args.ph_lo, hi = args.ph_hi;
    if (hi - lo > 1) bar = xcd_barrier_post(F.ctl + CW_BAR, misc);
#define IN(k) (lo <= (k) && (k) < hi)
#define SEAM(k) do { if (IN(k) && IN((k) + 1)) xcd_barrier(bar); } while (0)
    unsigned char* ws = args.ws;
    bf16_t* XB = (bf16_t*)(ws + WS_XB);
    bf16_t* QKV = (bf16_t*)(ws + WS_R1); bf16_t* MIX = (bf16_t*)(ws + WS_R1); bf16_t* OB = (bf16_t*)(ws + WS_HF + 64 * MiB);
    bf16_t* Y = (bf16_t*)(ws + WS_R1); bf16_t* HE = (bf16_t*)(ws + WS_R1 + R1_HE);
    int* LIST = (int*)(ws + WS_MOE); float* GATEW = (float*)(ws + WS_MOE + 2 * MiB); float* LSCALE = (float*)(ws + WS_MOE + 4 * MiB);
    const float* ln_g = args.in[11]; const float* ln_b = args.in[12];
    LAS int* tab = (LAS int*)(F.lds + MISC_OFF + 64);

    if (IN(0)) { p0_prologue(F, args); } SEAM(0);
    if (IN(1)) {
        pg8::SchedDense S; S.init((const bf16_t*)(ws + WS_XB8), (const bf16_t*)(ws + WS_WAIN), NTOK, NIN, DM / 2, F.G, F.bid);
        S.sA = (const float*)(ws + WS_SCL + SCL_SA); S.sB = (const float*)(ws + WS_SCL + SCL_SBIN);
        pg8::EpiInProj E{QKV, (bf16_t*)(ws + WS_HF + HF_QI), (bf16_t*)(ws + WS_HF + HF_KI), (float*)(ws + WS_HF + HF_WI)};
        pg8::gemm_phase<pg8::EpiInProj, pg8::SchedDense, true>(F.lds, S, E);
    } SEAM(1);
    if (IN(2)) { indexer_phase(F); } SEAM(2);
    if (IN(3)) { att::attnA_phase(F); } SEAM(3);
    if (IN(4)) {
        pg8::SchedDense S; S.init(OB, (const bf16_t*)(ws + WS_WAOUT), NTOK, DM, DM, F.G, F.bid);
        pg8::EpiBf16Split E{MIX, DM, DM, 0}; pg8::gemm_phase(F.lds, S, E);
    } SEAM(4);
    if (IN(5)) { ln_phase<true, 1, false, true>(F, args.in[0], MIX, nullptr, ln_g, ln_b, XB, args.in[6], args.in[7], F.ctl + CW_CNT, LIST, GATEW, (signed char*)(ws + WS_XB8), (float*)(ws + WS_SCL + SCL_SA), LSCALE); } SEAM(5);
    if (IN(6)) {
        moe_table(F, F.ctl + CW_CNT);
        pg8::SchedMoe S{(const bf16_t*)(ws + WS_XB8), (const bf16_t*)(ws + WS_WGU), DM / 2, 2, (size_t)512 * DM, tab, LIST, 1, F.G, F.bid, (const float*)(ws + WS_SCL + SCL_SA), (const float*)(ws + WS_SCL + SCL_SBGU)}; S.lsc = LSCALE;
        pg8::EpiMoe1 E{HE}; pg8::gemm_phase<pg8::EpiMoe1, pg8::SchedMoe, true>(F.lds, S, E);
    } SEAM(6);
    if (IN(7)) {
        moe_table(F, F.ctl + CW_CNT);
        pg8::SchedMoe S{HE, (const bf16_t*)(ws + WS_WD), FFE, 4, (size_t)DM * FFE * 2, tab, LIST, 0, F.G, F.bid}; S.gw = GATEW;
        pg8::EpiMoe2 E{Y, (const LAS float*)(F.lds + pg8::STAGE_BYTES), tab}; pg8::gemm_phase(F.lds, S, E);
    } SEAM(7);
    if (IN(8)) { ln_phase<false, 2, false, false>(F, XB, Y, Y + (size_t)NTOK * DM, ln_g + DM, ln_b + DM, XB, nullptr, nullptr, nullptr, nullptr, nullptr, (signed char*)(ws + WS_XB8), (float*)(ws + WS_SCL + SCL_SA)); } SEAM(8);
    if (IN(9)) {
        pg8::SchedDense S; S.init((const bf16_t*)(ws + WS_XB8), (const bf16_t*)(ws + WS_WBQKV), NTOK, 3 * DM, DM / 2, F.G, F.bid);
        S.sA = (const float*)(ws + WS_SCL + SCL_SA); S.sB = (const float*)(ws + WS_SCL + SCL_SBQKV);
        pg8::EpiBf16Split E{QKV, DM, DM, (size_t)NTOK * DM}; pg8::gemm_phase<pg8::EpiBf16Split, pg8::SchedDense, true>(F.lds, S, E);
    } SEAM(9);
    if (IN(10)) { att::attnB_phase(F); } SEAM(10);
    if (IN(11)) {
        pg8::SchedDense S; S.init(OB, (const bf16_t*)(ws + WS_WBOUT), NTOK, DM, DM, F.G, F.bid);
        pg8::EpiBf16Split E{MIX, DM, DM, 0}; pg8::gemm_phase(F.lds, S, E);
    } SEAM(11);
    if (IN(12)) { ln_phase<false, 1, false, true>(F, XB, MIX, nullptr, ln_g + 2 * DM, ln_b + 2 * DM, XB, args.in[6], args.in[7], F.ctl + CW_CNT + 2048, LIST, GATEW, (signed char*)(ws + WS_XB8), (float*)(ws + WS_SCL + SCL_SA), LSCALE); } SEAM(12);
    if (IN(13)) {
        moe_table(F, F.ctl + CW_CNT + 2048);
        pg8::SchedMoe S{(const bf16_t*)(ws + WS_XB8), (const bf16_t*)((const signed char*)(ws + WS_WGU) + (size_t)NEXP * 512 * DM), DM / 2, 2, (size_t)512 * DM, tab, LIST, 1, F.G, F.bid, (const float*)(ws + WS_SCL + SCL_SA), (const float*)(ws + WS_SCL + SCL_SBGU) + NEXP * 512}; S.lsc = LSCALE;
        pg8::EpiMoe1 E{HE}; pg8::gemm_phase<pg8::EpiMoe1, pg8::SchedMoe, true>(F.lds, S, E);
    } SEAM(13);
    if (IN(14)) {
        moe_table(F, F.ctl + CW_CNT + 2048);
        pg8::SchedMoe S{HE, (const bf16_t*)(ws + WS_WD) + (size_t)NEXP * DM * FFE, FFE, 4, (size_t)DM * FFE * 2, tab, LIST, 0, F.G, F.bid}; S.gw = GATEW;
        pg8::EpiMoe2 E{Y, (const LAS float*)(F.lds + pg8::STAGE_BYTES), tab}; pg8::gemm_phase(F.lds, S, E);
    } SEAM(14);
    if (IN(15)) { ln_phase<false, 2, true, false>(F, XB, Y, Y + (size_t)NTOK * DM, ln_g + 3 * DM, ln_b + 3 * DM, args.out, nullptr, nullptr, nullptr, nullptr, nullptr); }
#undef IN
#undef SEAM
}


extern "C" void kernel_launch(void* const* d_in, const int* in_sizes, int n_in, void* d_out, int out_size, void* d_ws, size_t ws_size, hipStream_t stream) {
    static int grid = 0;
    if (grid == 0) {
        if (n_in != 13 || in_sizes[0] != NTOK * DM || out_size != NTOK * DM || ws_size < WS_END) {
            fprintf(stderr, "kernel_launch: unexpected shapes (n_in %d, in0 %d, out %d, ws %zu < %zu)\n", n_in, n_in > 0 ? in_sizes[0] : -1, out_size, ws_size, (size_t)WS_END); grid = -1; return; }
        int dev = 0, cus = 0, per_cu = 0;
        if (hipGetDevice(&dev) != hipSuccess || hipDeviceGetAttribute(&cus, hipDeviceAttributeMultiprocessorCount, dev) != hipSuccess) { grid = -1; return; }
        if (hipFuncSetAttribute((const void*)yoco_fwd, hipFuncAttributeMaxDynamicSharedMemorySize, LDS_BYTES) != hipSuccess) { fprintf(stderr, "kernel_launch: hipFuncSetAttribute failed\n"); grid = -1; return; }
        if (hipOccupancyMaxActiveBlocksPerMultiprocessor(&per_cu, (const void*)yoco_fwd, 512, LDS_BYTES) != hipSuccess || per_cu < 1)
            fprintf(stderr, "kernel_launch: occupancy query reports %d\n", per_cu);
        (void)hipGetLastError();
        grid = cus;
    }
    if (grid < 0) return;
    (void)hipMemsetAsync((char*)d_ws + WS_CTL, 0, CTL_BYTES, stream);
    Args a; memset(&a, 0, sizeof(a));
    for (int i = 0; i < 13; ++i) a.in[i] = (const float*)d_in[i];
    a.out = (float*)d_out; a.ws = (unsigned char*)d_ws;
#if MK_N_LAUNCHES == 1
    a.ph_lo = 0; a.ph_hi = NPH;
    hipLaunchKernelGGL(yoco_fwd, dim3(grid), dim3(512), LDS_BYTES, stream, a);
#else
    for (int p = 0; p < NPH; ++p) { a.ph_lo = p; a.ph_hi = p + 1; hipLaunchKernelGGL(yoco_fwd, dim3(grid), dim3(512), LDS_BYTES, stream, a);
#ifdef REPMASK
        if ((REPMASK >> p) & 1) hipLaunchKernelGGL(yoco_fwd, dim3(grid), dim3(512), LDS_BYTES, stream, a);
#endif
    }
#endif
}
```

```cpp
#include <hip/hip_runtime.h>
#include <cstdio>
#include <cstdint>
#include <cstring>

#ifndef MK_N_LAUNCHES
#define MK_N_LAUNCHES 1
#endif

#define LAS __attribute__((address_space(3)))
#define DI __device__ __forceinline__
typedef unsigned short bf16_t;
typedef short bf16x8 __attribute__((ext_vector_type(8)));
typedef short s16x4 __attribute__((ext_vector_type(4)));
typedef float f32x2 __attribute__((ext_vector_type(2)));
typedef float f32x4 __attribute__((ext_vector_type(4)));
typedef float f32x16 __attribute__((ext_vector_type(16)));
typedef unsigned u32x2 __attribute__((ext_vector_type(2)));
typedef unsigned u32x4 __attribute__((ext_vector_type(4)));
typedef unsigned long long u64;

constexpr int NB = 16, SEQ = 2048, DM = 1024, NTOK = NB * SEQ, NH = 8, HD = 128;
constexpr int AIN = 3656, NIN = 3840;
constexpr int NEXP = 16, FFE = 256, LISTCAP = NTOK;
constexpr int TOPK = 256;
constexpr float LN_EPS = 1e-5f;
constexpr float DN_ALPHA = 1.41421356237309515f;
constexpr int NPH = 16;
constexpr int LDS_BYTES = 160 * 1024;
constexpr int MISC_OFF = LDS_BYTES - 1024;

constexpr size_t MiB = 1u << 20;
constexpr size_t WS_CTL = 0, CTL_BYTES = 64 * 1024;
constexpr size_t WS_WAIN = 1 * MiB;
constexpr size_t WS_WAOUT = WS_WAIN + (size_t)NIN * DM * 2;
constexpr size_t WS_WBQKV = WS_WAOUT + 2 * MiB;
constexpr size_t WS_WBOUT = WS_WBQKV + 6 * MiB;
constexpr size_t WS_WGU = WS_WBOUT + 2 * MiB;
constexpr size_t WS_WD = WS_WGU + 32 * MiB;
constexpr size_t WS_ROPE = WS_WD + 16 * MiB;
constexpr size_t WS_MOE = WS_ROPE + 2 * MiB;
constexpr size_t WS_XB = WS_MOE + 6 * MiB;
constexpr size_t WS_R1 = WS_XB + 64 * MiB;
constexpr size_t WS_HF = WS_R1 + 192 * MiB;
constexpr size_t WS_XB8 = WS_HF + 128 * MiB;
constexpr size_t WS_END = WS_XB8 + 32 * MiB;
constexpr size_t WS_SCL = WS_ROPE + 1536 * 1024;
constexpr size_t SCL_SA = 0, SCL_SBIN = 128 * 1024, SCL_SBQKV = 144 * 1024, SCL_SBGU = 160 * 1024;
constexpr size_t R1_HE = 128 * MiB;
constexpr size_t HF_QI = 0, HF_KI = 32 * MiB, HF_WI = 36 * MiB, HF_MASK = 40 * MiB;
constexpr int CW_BAR = 0;
constexpr int CW_CNT = 4096;

DI unsigned cvt_pk_bf16(float lo, float hi) { unsigned r; asm volatile("v_cvt_pk_bf16_f32 %0, %1, %2" : "=v"(r) : "v"(lo), "v"(hi)); return r; }
DI float bf2f(bf16_t b) { return __uint_as_float(((unsigned)b) << 16); }
#define DPPF0(x, ctrl) __uint_as_float(__builtin_amdgcn_update_dpp(0u, __float_as_uint(x), ctrl, 0xf, 0xf, true))
DI float wave_sum(float v) {
    v += DPPF0(v, 0xB1); v += DPPF0(v, 0x4E); v += DPPF0(v, 0x141); v += DPPF0(v, 0x140);
    const float r0 = __uint_as_float(__builtin_amdgcn_readlane(__float_as_uint(v), 0)), r1 = __uint_as_float(__builtin_amdgcn_readlane(__float_as_uint(v), 16));
    const float r2 = __uint_as_float(__builtin_amdgcn_readlane(__float_as_uint(v), 32)), r3 = __uint_as_float(__builtin_amdgcn_readlane(__float_as_uint(v), 48));
    return (r0 + r1) + (r2 + r3);
}
DI float wave_max(float v) {
#pragma unroll
    for (int d = 32; d >= 1; d >>= 1) v = fmaxf(v, __shfl_xor(v, d));
    return v;
}
DI float wave_min(float v) {
#pragma unroll
    for (int d = 32; d >= 1; d >>= 1) v = fminf(v, __shfl_xor(v, d));
    return v;
}
#define LDS_WAIT() asm volatile("s_waitcnt lgkmcnt(0)" ::: "memory")

#define XB_TMO      128
#define XB_XCNT(j)  (256  + 64 * (j))
#define XB_XSUB(j)  (1280 + 64 * (j))
#define XB_XGEN(j)  (2304 + 64 * (j))
#define XB_TOP      3328
#define XB_TOPGEN   3392
#define XCD_BAR_WORDS 3456
#define XB_SPIN_CAP (1u << 22)

DI unsigned xb_ld(unsigned* p)              { return __hip_atomic_load(p, __ATOMIC_RELAXED, __HIP_MEMORY_SCOPE_AGENT); }
DI unsigned xb_add(unsigned* p, unsigned v) { return __hip_atomic_fetch_add(p, v, __ATOMIC_RELAXED, __HIP_MEMORY_SCOPE_AGENT); }
DI unsigned xb_xcc_id() { return (unsigned)__builtin_amdgcn_s_getreg((3 << 11) | 20) & 0xFu; }
#define XB_SPIN(cond, bar) do { unsigned _sp = 0; while (cond) { __builtin_amdgcn_s_sleep(1); \
    if ((++_sp & 255u) == 0u) { if (xb_ld(&(bar)[XB_TMO])) break; if (_sp > XB_SPIN_CAP) { atomicAdd(&(bar)[XB_TMO], 1u); break; } } } } while (0)

struct XcdBarrier { unsigned* bar; unsigned x; volatile LAS unsigned* st; };

DI XcdBarrier xcd_barrier_post(unsigned* bar, volatile LAS unsigned* st) {
    XcdBarrier b; b.bar = bar; b.x = xb_xcc_id(); b.st = st;
    if (threadIdx.x == 0) (void)xb_add(&bar[XB_XCNT(b.x)], 1u);
    return b;
}
DI void xcd_barrier_complete(unsigned* bar, unsigned x, unsigned& nloc, unsigned& nx) {
    const unsigned G = gridDim.x * gridDim.y * gridDim.z;
    unsigned sum, cnt, mine, sp = 0u;
    for (;;) {
        sum = 0u; cnt = 0u; mine = 0u;
#pragma unroll
        for (unsigned j = 0; j < 16; ++j) { const unsigned c = xb_ld(&bar[XB_XCNT(j)]); sum += c; cnt += (c > 0u) ? 1u : 0u; mine = (j == x) ? c : mine; }
        if (sum == G) break;
        __builtin_amdgcn_s_sleep(1);
        if ((++sp & 255u) == 0u) { if (xb_ld(&bar[XB_TMO])) break; if (sp > XB_SPIN_CAP) { atomicAdd(&bar[XB_TMO], 1u); break; } }
    }
    nloc = mine > 0u ? mine : 1u; nx = cnt > 0u ? cnt : 1u;
}
DI void xcd_barrier(const XcdBarrier& b) {
    asm volatile("s_waitcnt vmcnt(0)" ::: "memory");
    __syncthreads();
    if (threadIdx.x == 0) {
        unsigned* bar = b.bar;
        __builtin_amdgcn_s_waitcnt(0);
        unsigned nloc = b.st[0], nx = b.st[1];
        if (nloc == 0u) { xcd_barrier_complete(bar, b.x, nloc, nx); b.st[0] = nloc; b.st[1] = nx; }
        const unsigned old = xb_add(&bar[XB_XSUB(b.x)], 1u);
        const unsigned gen = old / nloc;
        if (old + 1u == (gen + 1u) * nloc) {
            __builtin_amdgcn_fence(__ATOMIC_RELEASE, "agent");
            asm volatile("s_waitcnt vmcnt(0)" ::: "memory");
            const unsigned og = xb_add(&bar[XB_TOP], 1u);
            const unsigned tg = og / nx;
            if (og + 1u == (tg + 1u) * nx) xb_add(&bar[XB_TOPGEN], 1u);
            else XB_SPIN(xb_ld(&bar[XB_TOPGEN]) == tg, bar);
            __builtin_amdgcn_fence(__ATOMIC_ACQUIRE, "agent");
            xb_add(&bar[XB_XGEN(b.x)], 1u);
            asm volatile("s_waitcnt vmcnt(0)" ::: "memory");
        } else {
            XB_SPIN(xb_ld(&bar[XB_XGEN(b.x)]) == gen, bar);
            __builtin_amdgcn_fence(__ATOMIC_ACQUIRE, "agent");
            asm volatile("s_waitcnt vmcnt(0)" ::: "memory");
        }
    }
    __syncthreads();
}

namespace pg8 {
constexpr int BM = 256, BK = 64, HALF = 128, HTB = HALF * BK * 2, STAGE_BYTES = 8 * HTB, NXCD = 8, WGM = 8;
DI int lds_byte(int r, int c) { const int st = (r >> 4) * 2 + (c >> 5), rr = r & 15, cc = c & 31, ob = rr * 64 + cc * 2; return st * 1024 + (ob ^ (((ob >> 9) & 1) << 5)); }
DI void stage_rc(int b, int& R, int& C) { const int st = b / 1024, sb = b % 1024, swz = sb ^ (((sb >> 9) & 1) << 5); R = (st >> 1) * 16 + swz / 64; C = (st & 1) * 32 + (swz % 64) / 2; }
DI int perm32(int rho) { const int n = rho >> 4, i = rho & 15; return 8 * (i >> 2) + 4 * n + (i & 3); }

struct Unit { int pm, pn, e, rb, par; };

DI int xcd_remap(int wgid, int nwg) { const int q = nwg / NXCD, r = nwg % NXCD, xcd = wgid % NXCD, off = wgid / NXCD; return (xcd < r ? xcd * (q + 1) : r * (q + 1) + (xcd - r) * q) + off; }

struct SchedDense {
    static constexpr bool GATHER = false;
    const bf16_t* A; const bf16_t* Bt; int K; int nM, nN, nwg, G, c; const float* sA = nullptr; const float* sB = nullptr;
    DI void init(const bf16_t* A_, const bf16_t* Bt_, int M, int N, int K_, int G_, int c_) { A = A_; Bt = Bt_; K = K_; nM = M / BM; nN = N / BM; nwg = nM * nN; G = G_; c = c_; }
    DI bool next(int i, Unit& u) const {
        const long L = (long)i * G + c; if (L >= nwg) return false;
        const int wgid = xcd_remap((int)L, nwg);
        const int nig = WGM * nN, gid = wgid / nig, fm = gid * WGM, gsz = (nM - fm) < WGM ? (nM - fm) : WGM;
        u.pm = fm + ((wgid % nig) % gsz); u.pn = (wgid % nig) / gsz; u.e = 0; u.rb = 0; return true;
    }
    DI const char* abase(const Unit& u) const { return (const char*)A + (size_t)u.pm * BM * K * 2; }
    DI const char* bbase(const Unit& u) const { return (const char*)Bt + (size_t)u.pn * BM * K * 2; }
    DI bool has_pref() const { return sA != nullptr; }
    DI const float* pref_ptr(const Unit& u, int tid) const { return tid < 256 ? sA + u.pm * BM + tid : sB + u.pn * BM + tid - 256; }
    DI void aoffs(const Unit&, int tid, unsigned (&v)[2][2]) const {
#pragma unroll
        for (int i = 0; i < 2; ++i) { int R, C; stage_rc(tid * 16 + i * 8192, R, C); v[0][i] = (unsigned)(R * K + C) * 2u; v[1][i] = v[0][i] + (unsigned)(HALF * K) * 2u; }
    }
};
struct SchedMoe {
    static constexpr bool GATHER = true;
    const bf16_t* A; const bf16_t* Bt; int K, nN; size_t bstride; const LAS int* tab; const int* list; int gather; int G, c; const float* sA = nullptr; const float* sB = nullptr;
    DI bool next(int i, Unit& u) const {
        const int total = tab[16] * nN; const long L = (long)i * G + c; if (L >= total) return false;
        const int wgid = xcd_remap((int)L, total);
        const int rt = wgid / nN; u.pn = wgid % nN; u.pm = rt;
        int e = 0;
#pragma unroll 1
        for (; e < 15; ++e) if (rt < tab[e + 1]) break;
        u.e = e; u.rb = (rt - tab[e]) * BM; return true;
    }
    DI const char* abase(const Unit& u) const { return gather ? (const char*)A : (const char*)A + (size_t)u.pm * BM * K * 2; }
    DI const char* bbase(const Unit& u) const { return (const char*)Bt + (size_t)u.e * bstride + (size_t)u.pn * BM * K * 2; }
    const float* gw = nullptr; const float* lsc = nullptr;
    DI bool has_pref() const { return true; }
    DI const float* pref_ptr(const Unit& u, int tid) const { const int cnt = tab[17 + u.e]; int rr = u.rb + (tid & 255); rr = rr < cnt ? rr : cnt - 1; const size_t li = (size_t)u.e * LISTCAP + rr;
        if (gather) return tid < 256 ? lsc + li : sB + u.e * 512 + u.pn * BM + tid - 256;
        return tid < 256 ? (const float*)(list + li) : gw + li; }
    DI void aoffs(const Unit& u, int tid, unsigned (&v)[2][2]) const {
        const int cnt = tab[17 + u.e];
#pragma unroll
        for (int i = 0; i < 2; ++i) { int R, C; stage_rc(tid * 16 + i * 8192, R, C);
#pragma unroll
            for (int h = 0; h < 2; ++h) {
                int row = R + h * HALF;
                if (gather) { int r = u.rb + row; r = r < cnt ? r : cnt - 1; row = list[(size_t)u.e * LISTCAP + r] >> 1; }
                v[h][i] = (unsigned)(row * K + C) * 2u; } }
    }
};

typedef int i32x4 __attribute__((ext_vector_type(4)));
template <class Epi, class Sched, bool INT8 = false>
DI void gemm_phase(LAS unsigned char* lds, const Sched& S, const Epi& E) {
    const int tid = threadIdx.x, wid = __builtin_amdgcn_readfirstlane(tid >> 6), lane = tid & 63, wr = wid >> 2, wc = wid & 3, fr = lane & 15, fq = lane >> 4;
    const int K = S.K, nt = K / BK;
    unsigned voffB[2], vA[2][2], vN[2][2];
#pragma unroll
    for (int i = 0; i < 2; ++i) { int R, C; stage_rc(tid * 16 + i * 8192, R, C); const int Rb = Epi::PERM ? ((R & ~31) + perm32(R & 31)) : R; voffB[i] = (unsigned)(Rb * K + C) * 2u; }
    const size_t kstep = (size_t)(BK * 2);
    const size_t hstep = (size_t)HALF * K * 2;
    const unsigned ldsw = (unsigned)wid * 1024u;
    const int aoff = lds_byte(wr * 64 + fr, fq * 8), boff = lds_byte(wc * 32 + fr, fq * 8);
#define PG8_SA(b, h) (((b) * 2 + (h)) * HTB)
#define PG8_SB(b, h) ((4 + (b) * 2 + (h)) * HTB)
#define PG8_STAGE(bufoff, gbase, voff) do { _Pragma("unroll") for (int _i = 0; _i < 2; ++_i) \
        __builtin_amdgcn_global_load_lds((const unsigned*)((const char*)(gbase) + (voff)[_i]), (LAS unsigned*)(lds + (bufoff) + ldsw + _i * 8192), 16, 0, 0); } while (0)
#define PG8_LDA(dst, b, h) do { _Pragma("unroll") for (int m = 0; m < 4; ++m) _Pragma("unroll") for (int k = 0; k < 2; ++k) dst[m][k] = *(const LAS bf16x8*)(lds + PG8_SA(b, h) + aoff + m * 2048 + k * 1024); } while (0)
#define PG8_LDB(dst, b, h) do { _Pragma("unroll") for (int n = 0; n < 2; ++n) _Pragma("unroll") for (int k = 0; k < 2; ++k) dst[n][k] = *(const LAS bf16x8*)(lds + PG8_SB(b, h) + boff + n * 2048 + k * 1024); } while (0)
#define PG8_MMA(ai, bj, At, Bt) do { __builtin_amdgcn_s_setprio(1); _Pragma("unroll") for (int m = 0; m < 4; ++m) _Pragma("unroll") for (int n = 0; n < 2; ++n) _Pragma("unroll") for (int k = 0; k < 2; ++k) { \
        if constexpr (INT8) acc[ai][bj][m][n] = __builtin_bit_cast(f32x4, __builtin_amdgcn_mfma_i32_16x16x64_i8(__builtin_bit_cast(i32x4, Bt[n][k]), __builtin_bit_cast(i32x4, At[m][k]), __builtin_bit_cast(i32x4, acc[ai][bj][m][n]), 0, 0, 0)); \
        else acc[ai][bj][m][n] = __builtin_amdgcn_mfma_f32_16x16x32_bf16(Bt[n][k], At[m][k], acc[ai][bj][m][n], 0, 0, 0); } __builtin_amdgcn_s_setprio(0); } while (0)
#define PG8_WAIT_V(n) asm volatile("s_waitcnt vmcnt(" #n ")" ::: "memory")
#define PG8_WAIT_L(n) asm volatile("s_waitcnt lgkmcnt(" #n ")" ::: "memory")
#define PG8_BAR __builtin_amdgcn_s_barrier()
#define PG8_SCHED __builtin_amdgcn_sched_barrier(0)
    LAS float* xl = (LAS float*)(lds + STAGE_BYTES);
    Unit cur, nxt; int ui = 0;
    if (!S.next(0, cur)) return;
    f32x4 acc[2][2][4][2];
#pragma unroll
    for (int a = 0; a < 2; ++a)
#pragma unroll
        for (int b = 0; b < 2; ++b)
#pragma unroll
            for (int m = 0; m < 4; ++m)
#pragma unroll
                for (int n = 0; n < 2; ++n) acc[a][b][m][n] = (f32x4){0.f, 0.f, 0.f, 0.f};
    bf16x8 At[4][2], B0[2][2], B1[2][2];
    const char* cA = S.abase(cur); const char* cB = S.bbase(cur);
    S.aoffs(cur, tid, vA);
    PG8_STAGE(PG8_SB(0, 0), cB, voffB); PG8_STAGE(PG8_SA(0, 0), cA, vA[0]); PG8_STAGE(PG8_SB(0, 1), cB + hstep, voffB); PG8_STAGE(PG8_SA(0, 1), cA, vA[1]);
    if (wr == 1) PG8_BAR;
    PG8_WAIT_V(4); PG8_BAR;
    PG8_STAGE(PG8_SB(1, 0), cB + kstep, voffB); PG8_STAGE(PG8_SA(1, 0), cA + kstep, vA[0]); PG8_STAGE(PG8_SB(1, 1), cB + hstep + kstep, voffB);
    PG8_WAIT_V(6); PG8_BAR;
    for (;;) {
        const bool has_next = S.next(ui + 1, nxt);
        if (S.has_pref()) __builtin_amdgcn_global_load_lds((const unsigned*)S.pref_ptr(cur, tid), (LAS unsigned*)(xl + (ui & 1) * 512 + wid * 64), 4, 0, 0);
        const char* nA = has_next ? S.abase(nxt) : cA; const char* nB = has_next ? S.bbase(nxt) : cB;
        if (Sched::GATHER) { if (has_next) S.aoffs(nxt, tid, vN); else { vN[0][0] = vA[0][0]; vN[0][1] = vA[0][1]; vN[1][0] = vA[1][0]; vN[1][1] = vA[1][1]; } }
        for (int t = 0; t < nt; t += 2) {
            const bool last = (t == nt - 2);
            const char* a1 = cA + (size_t)(t + 1) * kstep;
            const char* a2 = last ? nA : cA + (size_t)(t + 2) * kstep; const char* b2 = last ? nB : cB + (size_t)(t + 2) * kstep;
            const char* a3 = a2 + kstep; const char* b3 = b2 + kstep;
            unsigned o2[2][2];
#pragma unroll
            for (int h = 0; h < 2; ++h)
#pragma unroll
                for (int i = 0; i < 2; ++i) o2[h][i] = (Sched::GATHER && last) ? vN[h][i] : vA[h][i];
            PG8_LDB(B0, 0, 0); PG8_SCHED; PG8_LDA(At, 0, 0); PG8_STAGE(PG8_SA(1, 1), a1, vA[1]);
            PG8_WAIT_L(8); PG8_BAR; PG8_WAIT_L(0); PG8_MMA(0, 0, At, B0); PG8_BAR; PG8_SCHED;
            PG8_LDB(B1, 0, 1); PG8_STAGE(PG8_SB(0, 0), b2, voffB);
            PG8_BAR; PG8_WAIT_L(0); PG8_MMA(0, 1, At, B1); PG8_BAR;
            PG8_LDA(At, 0, 1); PG8_STAGE(PG8_SA(0, 0), a2, o2[0]);
            PG8_BAR; PG8_WAIT_L(0); PG8_MMA(1, 0, At, B0); PG8_BAR; PG8_SCHED;
            PG8_STAGE(PG8_SB(0, 1), b2 + hstep, voffB);
            PG8_WAIT_V(6); PG8_BAR; PG8_MMA(1, 1, At, B1); PG8_BAR;
            PG8_LDB(B0, 1, 0); PG8_SCHED; PG8_LDA(At, 1, 0); PG8_STAGE(PG8_SA(0, 1), a2, o2[1]);
            PG8_WAIT_L(8); PG8_BAR; PG8_WAIT_L(0); PG8_MMA(0, 0, At, B0); PG8_BAR; PG8_SCHED;
            PG8_LDB(B1, 1, 1); PG8_STAGE(PG8_SB(1, 0), b3, voffB);
            PG8_BAR; PG8_WAIT_L(0); PG8_MMA(0, 1, At, B1); PG8_BAR;
            PG8_LDA(At, 1, 1); PG8_STAGE(PG8_SA(1, 0), a3, o2[0]);
            PG8_BAR; PG8_WAIT_L(0); PG8_MMA(1, 0, At, B0); PG8_BAR; PG8_SCHED;
            PG8_STAGE(PG8_SB(1, 1), b3 + hstep, voffB);
            PG8_WAIT_V(6); PG8_BAR; PG8_MMA(1, 1, At, B1); PG8_BAR;
        }
        if constexpr (INT8) {
            const int rb_ = wr * 64 + fr, cb_ = wc * 32 + (Epi::PERM ? 8 * fq : 4 * fq);
            float ra[2][4]; f32x4 cs[2][2];
#pragma unroll
            for (int a = 0; a < 2; ++a)
#pragma unroll
                for (int m = 0; m < 4; ++m) ra[a][m] = xl[(ui & 1) * 512 + rb_ + a * HALF + m * 16];
#pragma unroll
            for (int b = 0; b < 2; ++b)
#pragma unroll
                for (int n = 0; n < 2; ++n) cs[b][n] = *(const LAS f32x4*)(xl + (ui & 1) * 512 + 256 + cb_ + b * HALF + (Epi::PERM ? 4 * n : 16 * n));
#pragma unroll
            for (int a = 0; a < 2; ++a)
#pragma unroll
                for (int b = 0; b < 2; ++b)
#pragma unroll
                    for (int m = 0; m < 4; ++m)
#pragma unroll
                        for (int n = 0; n < 2; ++n) { const i32x4 v_ = __builtin_bit_cast(i32x4, acc[a][b][m][n]);
                            acc[a][b][m][n] = (f32x4){(float)v_[0], (float)v_[1], (float)v_[2], (float)v_[3]} * ra[a][m] * cs[b][n]; }
        }
        cur.par = ui & 1;
        E(acc, cur, wr, wc, fr, fq);
        if (!has_next) break;
#pragma unroll
        for (int a = 0; a < 2; ++a)
#pragma unroll
            for (int b = 0; b < 2; ++b)
#pragma unroll
                for (int m = 0; m < 4; ++m)
#pragma unroll
                    for (int n = 0; n < 2; ++n) acc[a][b][m][n] = (f32x4){0.f, 0.f, 0.f, 0.f};
        cur = nxt; cA = nA; cB = nB; ++ui;
        if (Sched::GATHER) { vA[0][0] = vN[0][0]; vA[0][1] = vN[0][1]; vA[1][0] = vN[1][0]; vA[1][1] = vN[1][1]; }
    }
    PG8_WAIT_V(0);
    if (wr == 0) PG8_BAR;
    PG8_BAR;
#undef PG8_SA
#undef PG8_SB
#undef PG8_STAGE
#undef PG8_LDA
#undef PG8_LDB
#undef PG8_MMA
#undef PG8_WAIT_V
#undef PG8_WAIT_L
#undef PG8_BAR
#undef PG8_SCHED
}

DI u32x4 pack8(f32x4 a, f32x4 b) { u32x4 w; w.x = cvt_pk_bf16(a[0], a[1]); w.y = cvt_pk_bf16(a[2], a[3]); w.z = cvt_pk_bf16(b[0], b[1]); w.w = cvt_pk_bf16(b[2], b[3]); return w; }

struct EpiF32 {
    static constexpr bool PERM = false;
    float* C; int ldc;
    DI void operator()(const f32x4 (&acc)[2][2][4][2], const Unit& u, int wr, int wc, int fr, int fq) const {
        const int row0 = u.pm * BM + wr * 64 + fr, col0 = u.pn * BM + wc * 32 + 4 * fq;
#pragma unroll
        for (int ai = 0; ai < 2; ++ai)
#pragma unroll
            for (int m = 0; m < 4; ++m) { float* rowp = C + (size_t)(row0 + ai * HALF + m * 16) * ldc + col0;
#pragma unroll
                for (int bj = 0; bj < 2; ++bj)
#pragma unroll
                    for (int n = 0; n < 2; ++n) *(f32x4*)(rowp + bj * HALF + n * 16) = acc[ai][bj][m][n]; }
    }
};
struct EpiBf16Split {
    static constexpr bool PERM = true;
    bf16_t* O; int ldc; int split_cols; size_t split_stride;
    DI void operator()(const f32x4 (&acc)[2][2][4][2], const Unit& u, int wr, int wc, int fr, int fq) const {
        const int row0 = u.pm * BM + wr * 64 + fr; int colt = u.pn * BM; bf16_t* base = O;
        { const int t = colt / split_cols; base += (size_t)t * split_stride; colt -= t * split_cols; }
        const int col0 = colt + wc * 32 + 8 * fq;
#pragma unroll
        for (int ai = 0; ai < 2; ++ai)
#pragma unroll
            for (int m = 0; m < 4; ++m) { bf16_t* rowp = base + (size_t)(row0 + ai * HALF + m * 16) * ldc + col0;
#pragma unroll
                for (int bj = 0; bj < 2; ++bj) *(u32x4*)(rowp + bj * HALF) = pack8(acc[ai][bj][m][0], acc[ai][bj][m][1]); }
    }
};
template <int HALFD>
DI void rope4(int t, int dp, f32x4& c4, f32x4& s4) {
#pragma unroll
    for (int j = 0; j < 4; ++j) { const float inv2pi = __builtin_amdgcn_exp2f((float)(dp + j) * (-13.287712379549449f / HALFD)) * 0.15915494309189535f;
        const float x = __builtin_amdgcn_fractf((float)t * inv2pi); c4[j] = __builtin_amdgcn_cosf(x); s4[j] = __builtin_amdgcn_sinf(x); }
}
struct EpiInProj {
    static constexpr bool PERM = true;
    bf16_t* QKV; bf16_t* QI; bf16_t* KI; float* WI;
    DI void operator()(const f32x4 (&acc)[2][2][4][2], const Unit& u, int wr, int wc, int fr, int fq) const {
        const int row0 = u.pm * BM + wr * 64 + fr;
        if (u.pn < 8) {
            bf16_t* base = QKV + (size_t)(u.pn >> 2) * NTOK * DM; const int col0 = (u.pn & 3) * BM + wc * 32 + 8 * fq, dp = 16 * wc + 4 * fq;
#pragma unroll
            for (int ai = 0; ai < 2; ++ai)
#pragma unroll
                for (int m = 0; m < 4; ++m) { const int row = row0 + ai * HALF + m * 16, t = row & (SEQ - 1);
                    f32x4 c4, s4; rope4<64>(t, dp, c4, s4);
#pragma unroll
                    for (int bj = 0; bj < 2; ++bj) { const f32x4 x1 = acc[ai][bj][m][0], x2 = acc[ai][bj][m][1];
                        *(u32x4*)(base + (size_t)row * DM + col0 + bj * HALF) = pack8(x1 * c4 - x2 * s4, x1 * s4 + x2 * c4); } }
        } else if (u.pn < 12) {
            bf16_t* base = QKV + (size_t)2 * NTOK * DM; const int col0 = (u.pn - 8) * BM + wc * 32 + 8 * fq;
#pragma unroll
            for (int ai = 0; ai < 2; ++ai)
#pragma unroll
                for (int m = 0; m < 4; ++m) { const int row = row0 + ai * HALF + m * 16;
#pragma unroll
                    for (int bj = 0; bj < 2; ++bj) *(u32x4*)(base + (size_t)row * DM + col0 + bj * HALF) = pack8(acc[ai][bj][m][0], acc[ai][bj][m][1]); }
        } else if (u.pn < 14) {
            const int col0 = (u.pn - 12) * BM + wc * 32 + 8 * fq, dp = 16 * (wc & 1) + 4 * fq;
#pragma unroll
            for (int ai = 0; ai < 2; ++ai)
#pragma unroll
                for (int m = 0; m < 4; ++m) { const int row = row0 + ai * HALF + m * 16, t = row & (SEQ - 1);
                    f32x4 c4, s4; rope4<32>(t, dp, c4, s4);
#pragma unroll
                    for (int bj = 0; bj < 2; ++bj) { const f32x4 x1 = acc[ai][bj][m][0], x2 = acc[ai][bj][m][1];
                        *(u32x4*)(QI + (size_t)row * 512 + col0 + bj * HALF) = pack8(x1 * c4 - x2 * s4, x1 * s4 + x2 * c4); } }
        } else {
            if (wc < 2) { const int col0 = wc * 32 + 8 * fq, dp = 16 * wc + 4 * fq;
#pragma unroll
                for (int ai = 0; ai < 2; ++ai)
#pragma unroll
                    for (int m = 0; m < 4; ++m) { const int row = row0 + ai * HALF + m * 16, t = row & (SEQ - 1);
                        f32x4 c4, s4; rope4<32>(t, dp, c4, s4);
                        const f32x4 x1 = acc[ai][0][m][0], x2 = acc[ai][0][m][1];
                        *(u32x4*)(KI + (size_t)row * 64 + col0) = pack8(x1 * c4 - x2 * s4, x1 * s4 + x2 * c4); }
            } else if (wc == 2 && fq == 0) {
                const float sc = 0.35355339059327373f;
#pragma unroll
                for (int ai = 0; ai < 2; ++ai)
#pragma unroll
                    for (int m = 0; m < 4; ++m) { const int row = row0 + ai * HALF + m * 16;
                        *(f32x4*)(WI + (size_t)row * 8) = acc[ai][0][m][0] * sc; *(f32x4*)(WI + (size_t)row * 8 + 4) = acc[ai][0][m][1] * sc; }
            }
        }
    }
};
struct EpiMoe1 {
    static constexpr bool PERM = true;
    bf16_t* HE;
    DI void operator()(const f32x4 (&acc)[2][2][4][2], const Unit& u, int wr, int wc, int fr, int fq) const {
        const int row0 = u.pm * BM + wr * 64 + fr, hc0 = 128 * u.pn + 16 * wc + 4 * fq;
#pragma unroll
        for (int ai = 0; ai < 2; ++ai)
#pragma unroll
            for (int m = 0; m < 4; ++m) { const int row = row0 + ai * HALF + m * 16;
#pragma unroll
                for (int bj = 0; bj < 2; ++bj) { const f32x4 g = acc[ai][bj][m][0], up = acc[ai][bj][m][1]; f32x4 h;
#pragma unroll
                    for (int j = 0; j < 4; ++j) h[j] = g[j] * __builtin_amdgcn_rcpf(1.0f + __builtin_amdgcn_exp2f(-1.4426950408889634f * g[j])) * up[j];
                    u32x2 w; w.x = cvt_pk_bf16(h[0], h[1]); w.y = cvt_pk_bf16(h[2], h[3]);
                    *(u32x2*)(HE + (size_t)row * FFE + hc0 + 64 * bj) = w; } }
    }
};
struct EpiMoe2 {
    static constexpr bool PERM = true;
    bf16_t* Y; const LAS float* xl; const LAS int* tab;
    DI void operator()(const f32x4 (&acc)[2][2][4][2], const Unit& u, int wr, int wc, int fr, int fq) const {
        const int cnt = tab[17 + u.e], col0 = u.pn * BM + wc * 32 + 8 * fq;
        int ent[8]; float gw[8];
#pragma unroll
        for (int i = 0; i < 8; ++i) { const int rl = u.par * 512 + (i >> 2) * HALF + wr * 64 + (i & 3) * 16 + fr; ent[i] = __float_as_int(xl[rl]); gw[i] = xl[256 + rl]; }
#pragma unroll
        for (int i = 0; i < 8; ++i) { const int ai = i >> 2, m = i & 3, r = u.rb + ai * HALF + wr * 64 + m * 16 + fr;
            if (r < cnt) { bf16_t* dst = Y + ((size_t)(ent[i] & 1) * NTOK + (size_t)(ent[i] >> 1)) * DM + col0;
#pragma unroll
                for (int bj = 0; bj < 2; ++bj) *(u32x4*)(dst + bj * HALF) = pack8(acc[ai][bj][m][0] * gw[i], acc[ai][bj][m][1] * gw[i]); } }
    }
};
}

struct Args { const float* in[13]; float* out; unsigned char* ws; int ph_lo, ph_hi; };
struct Frame {
    LAS unsigned char* lds; int tid, lane, wave, G, bid;
    unsigned char* ws; unsigned* ctl;
};

DI int src_col(int mode, int p) {
    if (mode == 0) return p;
    if (mode == 1) {
        if (p < 2048) { const int hd = p >> 7, pp = p & 127; return (hd << 7) + ((pp >> 3) << 2) + (pp & 3) + 64 * ((pp >> 2) & 1); }
        if (p < 3072) return p;
        if (p < 3648) { const int q = p - 3072, hd = q >> 6, pp = q & 63; return 3072 + (hd << 6) + ((pp >> 3) << 2) + (pp & 3) + 32 * ((pp >> 2) & 1); }
        if (p < AIN) return p;
        return -1; }
    return ((p >> 3) << 2) + (p & 3);
}
DI float dpp_wave_max_f(float v);
DI float quant_row(const f32x4 (&v)[4], int lane, signed char* dst, float* sdst) {
    float mx = 0.f;
#pragma unroll
    for (int i = 0; i < 4; ++i) mx = fmaxf(mx, fmaxf(fmaxf(fabsf(v[i][0]), fabsf(v[i][1])), fmaxf(fabsf(v[i][2]), fabsf(v[i][3]))));
    mx = dpp_wave_max_f(mx);
    const float inv = mx > 0.f ? 127.0f / mx : 0.f;
#pragma unroll
    for (int i = 0; i < 4; ++i) { const int q0 = (int)__builtin_rintf(v[i][0] * inv), q1 = (int)__builtin_rintf(v[i][1] * inv), q2 = (int)__builtin_rintf(v[i][2] * inv), q3 = (int)__builtin_rintf(v[i][3] * inv);
        *(int*)(dst + 4 * lane + 256 * i) = (q0 & 0xFF) | ((q1 & 0xFF) << 8) | ((q2 & 0xFF) << 16) | (q3 << 24); }
    if (lane == 0) *sdst = mx * (1.0f / 127.0f);
    return mx * (1.0f / 127.0f);
}
DI void wq8_unit(const Frame& F, const float* W0, const float* W2, int ldw, int mode, signed char* Bt8, float* sB, int n0) {
    LAS float* T = (LAS float*)F.lds;
    LAS unsigned* cmax = (LAS unsigned*)(F.lds + 1024 * 33 * 4);
    const int n4 = (F.tid & 7) * 4, src = src_col(mode, n0 + n4); const float* W = (mode == 2 && (((n0 + n4) >> 2) & 1)) ? W2 : W0;
    if (F.tid < 32) cmax[F.tid] = 0u;
    __syncthreads();
    f32x4 m4 = {0.f, 0.f, 0.f, 0.f}, vv[16];
#pragma unroll
    for (int i = 0; i < 16; ++i) vv[i] = src >= 0 ? *(const f32x4*)(W + (size_t)((F.tid >> 3) + 64 * i) * ldw + src) : (f32x4){0.f, 0.f, 0.f, 0.f};
#pragma unroll
    for (int i = 0; i < 16; ++i) { const int kk = (F.tid >> 3) + 64 * i; const f32x4 v = vv[i];
        m4[0] = fmaxf(m4[0], fabsf(v[0])); m4[1] = fmaxf(m4[1], fabsf(v[1])); m4[2] = fmaxf(m4[2], fabsf(v[2])); m4[3] = fmaxf(m4[3], fabsf(v[3]));
        T[kk * 33 + n4] = v[0]; T[kk * 33 + n4 + 1] = v[1]; T[kk * 33 + n4 + 2] = v[2]; T[kk * 33 + n4 + 3] = v[3]; }
#pragma unroll
    for (int j = 0; j < 4; ++j) { float m = m4[j];
        m = fmaxf(m, __uint_as_float((unsigned)__builtin_amdgcn_update_dpp(0, (int)__float_as_uint(m), 0x128, 0xf, 0xf, false)));
        m = fmaxf(m, __shfl_xor(m, 16)); m = fmaxf(m, __shfl_xor(m, 32)); m4[j] = m; }
    if (F.lane < 8) {
#pragma unroll
        for (int j = 0; j < 4; ++j) __hip_atomic_fetch_max(cmax + n4 + j, __float_as_uint(m4[j]), __ATOMIC_RELAXED, __HIP_MEMORY_SCOPE_WORKGROUP); }
    __syncthreads();
    if (F.tid < 32) sB[n0 + F.tid] = __uint_as_float(cmax[F.tid]) * (1.0f / 127.0f);
    { const int nl = F.tid & 31, kb = (F.tid >> 5) * 64; const float mx = __uint_as_float(cmax[nl]), inv = mx > 0.f ? 127.0f / mx : 0.f;
#pragma unroll 2
      for (int k16 = 0; k16 < 64; k16 += 16) { int q[16];
#pragma unroll
          for (int j = 0; j < 16; ++j) q[j] = (int)__builtin_rintf(T[(kb + k16 + j) * 33 + nl] * inv);
          u32x4 w;
#pragma unroll
          for (int d = 0; d < 4; ++d) w[d] = (unsigned)((q[4 * d] & 0xFF) | ((q[4 * d + 1] & 0xFF) << 8) | ((q[4 * d + 2] & 0xFF) << 16) | (q[4 * d + 3] << 24));
          *(u32x4*)(Bt8 + (size_t)(n0 + nl) * DM + kb + k16) = w; } }
    __syncthreads();
}
constexpr int T_SQ = 256, T_GU = 512 / 32, T_DN = 64, U_IN = NIN / 32, U_Q = DM / 32, U_KV = 2 * DM / 32, HO1 = U_IN, HO2 = HO1 + U_Q, HO3 = HO2 + U_KV;
DI void heavy_job(const Frame& F, const Args& a, int tile) {
    float* SBIN = (float*)(F.ws + WS_SCL + SCL_SBIN); float* SBQKV = (float*)(F.ws + WS_SCL + SCL_SBQKV);
    if (tile < HO1) wq8_unit(F, a.in[1], nullptr, AIN, 1, (signed char*)(F.ws + WS_WAIN), SBIN, tile * 32);
    else if (tile < HO2) wq8_unit(F, a.in[3], nullptr, DM, 0, (signed char*)(F.ws + WS_WBQKV), SBQKV, (tile - HO1) * 32);
    else if (tile < HO3) wq8_unit(F, a.in[4], nullptr, 2 * DM, 0, (signed char*)(F.ws + WS_WBQKV) + (size_t)DM * DM, SBQKV + DM, (tile - HO2) * 32);
    else { const int t = tile - HO3, le = t >> 4, tt = t & 15;
        wq8_unit(F, a.in[8] + (size_t)le * DM * FFE, a.in[9] + (size_t)le * DM * FFE, FFE, 2, (signed char*)(F.ws + WS_WGU) + (size_t)le * 512 * DM, (float*)(F.ws + WS_SCL + SCL_SBGU) + le * 512, tt * 32); }
}
DI void light_group(const Frame& F, const Args& a, int L0, int L1, int L2, int L3) {
    LAS float* T = (LAS float*)F.lds;
    const float* Wp[4]; bf16_t* Bp[4]; int ldw[4], Kk[4], k0[4], n0[4];
#pragma unroll
    for (int u = 0; u < 4; ++u) { const int L = u == 0 ? L0 : u == 1 ? L1 : u == 2 ? L2 : L3;
        if (L < T_SQ) { Wp[u] = a.in[2]; Bp[u] = (bf16_t*)(F.ws + WS_WAOUT); ldw[u] = DM; Kk[u] = DM; k0[u] = (L & 15) * 64; n0[u] = (L >> 4) * 64; }
        else if (L < 2 * T_SQ) { const int t = L - T_SQ; Wp[u] = a.in[5]; Bp[u] = (bf16_t*)(F.ws + WS_WBOUT); ldw[u] = DM; Kk[u] = DM; k0[u] = (t & 15) * 64; n0[u] = (t >> 4) * 64; }
        else { const int t = L - 2 * T_SQ, le = t >> 6, tt = t & 63; Wp[u] = a.in[10] + (size_t)le * FFE * DM; Bp[u] = (bf16_t*)(F.ws + WS_WD) + (size_t)le * DM * FFE; ldw[u] = DM; Kk[u] = FFE; k0[u] = (tt & 3) * 64; n0[u] = (tt >> 2) * 64; } }
    f32x4 v[4][2];
    { const int n4 = (F.tid & 15) * 4;
#pragma unroll
      for (int u = 0; u < 4; ++u)
#pragma unroll
          for (int i = 0; i < 2; ++i) v[u][i] = *(const f32x4*)(Wp[u] + (size_t)(k0[u] + (F.tid >> 4) + 32 * i) * ldw[u] + n0[u] + n4);
#pragma unroll
      for (int u = 0; u < 4; ++u)
#pragma unroll
          for (int i = 0; i < 2; ++i) { const int kl = (F.tid >> 4) + 32 * i; LAS float* Tu = T + u * 64 * 65;
              Tu[kl * 65 + n4] = v[u][i][0]; Tu[kl * 65 + n4 + 1] = v[u][i][1]; Tu[kl * 65 + n4 + 2] = v[u][i][2]; Tu[kl * 65 + n4 + 3] = v[u][i][3]; } }
    __syncthreads();
    { const int nl = F.tid >> 3, kl = (F.tid & 7) * 8;
#pragma unroll
      for (int u = 0; u < 4; ++u) { const LAS float* Tu = T + u * 64 * 65; float w8[8];
#pragma unroll
          for (int j = 0; j < 8; ++j) w8[j] = Tu[(kl + j) * 65 + nl];
          u32x4 w; w.x = cvt_pk_bf16(w8[0], w8[1]); w.y = cvt_pk_bf16(w8[2], w8[3]); w.z = cvt_pk_bf16(w8[4], w8[5]); w.w = cvt_pk_bf16(w8[6], w8[7]);
          *(u32x4*)(Bp[u] + (size_t)(n0[u] + nl) * Kk[u] + k0[u] + kl) = w; } }
    __syncthreads();
}
constexpr int NHV = U_IN + U_Q + U_KV + 32 * T_GU, NLG = (2 * T_SQ + 32 * T_DN) / 4;
DI void bg_jobs(const Frame& F, const Args& a, int hlo, int hhi, int glo, int ghi, int rank, int n) {
    for (int h = hlo + rank; h < hhi; h += n)
        heavy_job(F, a, h < U_IN ? h : h < U_IN + 16 * T_GU ? HO3 + (h - U_IN) : h < U_IN + 16 * T_GU + U_Q + U_KV ? HO1 + (h - U_IN - 16 * T_GU) : HO3 + 16 * T_GU + (h - U_IN - 16 * T_GU - U_Q - U_KV));
    for (int g = glo + (n - 1 - rank); g < ghi; g += n) { int L[4];
#pragma unroll
        for (int u = 0; u < 4; ++u) { const int q = 4 * g + u;
            L[u] = q < T_SQ ? q : q < T_SQ + 16 * T_DN ? 2 * T_SQ + (q - T_SQ) : q < 2 * T_SQ + 16 * T_DN ? T_SQ + (q - T_SQ - 16 * T_DN) : 2 * T_SQ + 16 * T_DN + (q - 2 * T_SQ - 16 * T_DN); }
        light_group(F, a, L[0], L[1], L[2], L[3]); }
}
constexpr int BG_H0 = 256, BG_H1 = U_IN + 16 * T_GU, BG_H2 = BG_H1 + 240, BG_G0 = 64, BG_G1 = 320, BG_G2 = 560;
DI void idle_rank(int total, int G, int c, int& rank, int& n) { const int r = total % G; if (r == 0) { rank = c; n = G; } else { rank = c - r; n = G - r; } }
DI void p0_prologue(const Frame& F, const Args& a) {
    const size_t gtid = (size_t)F.bid * 512 + F.tid, gthreads = (size_t)F.G * 512;
    { signed char* xq = (signed char*)(F.ws + WS_XB8); float* SA = (float*)(F.ws + WS_SCL + SCL_SA);
      const int gw = F.bid * 8 + F.wave, nw = F.G * 8, lane = F.lane;
      f32x4 rr[4][4];
#define XQ_LOAD(slot, r_) do { const int r2_ = (r_) < NTOK ? (r_) : gw; _Pragma("unroll") for (int i = 0; i < 4; ++i) rr[slot][i] = *(const f32x4*)(a.in[0] + (size_t)r2_ * DM + 4 * lane + 256 * i); } while (0)
      XQ_LOAD(0, gw); XQ_LOAD(1, gw + nw); XQ_LOAD(2, gw + 2 * nw);
      for (int row = gw; row < NTOK; row += 4 * nw) {
          XQ_LOAD(3, row + 3 * nw);
          quant_row(rr[0], lane, xq + (size_t)row * DM, SA + row);
          XQ_LOAD(0, row + 4 * nw);
          if (row + nw < NTOK) quant_row(rr[1], lane, xq + (size_t)(row + nw) * DM, SA + row + nw);
          XQ_LOAD(1, row + 5 * nw);
          if (row + 2 * nw < NTOK) quant_row(rr[2], lane, xq + (size_t)(row + 2 * nw) * DM, SA + row + 2 * nw);
          XQ_LOAD(2, row + 6 * nw);
          if (row + 3 * nw < NTOK) quant_row(rr[3], lane, xq + (size_t)(row + 3 * nw) * DM, SA + row + 3 * nw);
      }
#undef XQ_LOAD
    }
    bg_jobs(F, a, 0, BG_H0, 0, BG_G0, F.bid, F.G);
}

constexpr int SCP = 2064;
DI unsigned ord_key(float v) { const unsigned b = __float_as_uint(v); return b ^ (((int)b >> 31) | 0x80000000u); }
DI unsigned popc64(u64 m) { return (unsigned)__builtin_popcountll(m); }

#define DPPF(x, ctrl) __uint_as_float(__builtin_amdgcn_update_dpp(0u, __float_as_uint(x), ctrl, 0xf, 0xf, true))
DI float dpp_wave_max(float v) {
    v = fmaxf(v, DPPF(v, 0xB1)); v = fmaxf(v, DPPF(v, 0x4E)); v = fmaxf(v, DPPF(v, 0x141)); v = fmaxf(v, DPPF(v, 0x140));
    const float r0 = __uint_as_float(__builtin_amdgcn_readlane(__float_as_uint(v), 0)), r1 = __uint_as_float(__builtin_amdgcn_readlane(__float_as_uint(v), 16));
    const float r2 = __uint_as_float(__builtin_amdgcn_readlane(__float_as_uint(v), 32)), r3 = __uint_as_float(__builtin_amdgcn_readlane(__float_as_uint(v), 48));
    return fmaxf(fmaxf(r0, r1), fmaxf(r2, r3));
}
DI float dpp_wave_max_f(float v) { return dpp_wave_max(v); }
DI float dpp_wave_min(float v) {
    v = fminf(v, DPPF(v, 0xB1)); v = fminf(v, DPPF(v, 0x4E)); v = fminf(v, DPPF(v, 0x141)); v = fminf(v, DPPF(v, 0x140));
    const float r0 = __uint_as_float(__builtin_amdgcn_readlane(__float_as_uint(v), 0)), r1 = __uint_as_float(__builtin_amdgcn_readlane(__float_as_uint(v), 16));
    const float r2 = __uint_as_float(__builtin_amdgcn_readlane(__float_as_uint(v), 32)), r3 = __uint_as_float(__builtin_amdgcn_readlane(__float_as_uint(v), 48));
    return fminf(fminf(r0, r1), fminf(r2, r3));
}
DI unsigned dpp_scan_add(unsigned v) {
    v += (unsigned)__builtin_amdgcn_update_dpp(0, (int)v, 0x111, 0xf, 0xf, false);
    v += (unsigned)__builtin_amdgcn_update_dpp(0, (int)v, 0x112, 0xf, 0xf, false);
    v += (unsigned)__builtin_amdgcn_update_dpp(0, (int)v, 0x114, 0xf, 0xf, false);
    v += (unsigned)__builtin_amdgcn_update_dpp(0, (int)v, 0x118, 0xf, 0xf, false);
    v += (unsigned)__builtin_amdgcn_update_dpp(0, (int)v, 0x142, 0xa, 0xf, false);
    v += (unsigned)__builtin_amdgcn_update_dpp(0, (int)v, 0x143, 0xc, 0xf, false);
    return v;
}
DI void select_topk(const LAS float* srow, int nj, LAS unsigned* hist, LAS unsigned* cand, LAS unsigned* ccnt, int lane, u64* mrow) {
    const LAS float* sp = srow + lane;
    float v[32];
#pragma unroll
    for (int g = 0; g < 4; ++g) { if (8 * g < nj) {
#pragma unroll
        for (int j = 8 * g; j < 8 * g + 8; ++j) v[j] = sp[j * 64]; } else {
#pragma unroll
        for (int j = 8 * g; j < 8 * g + 8; ++j) v[j] = -__builtin_inff(); } }
    int njv = nj; asm volatile("" : "+v"(njv));
#pragma unroll
    for (int j = 0; j < 32; ++j) v[j] = (j < njv) ? v[j] : -__builtin_inff();
    float vmx = v[0], vmn = v[0];
#pragma unroll
    for (int j = 1; j < 32; ++j) { vmx = fmaxf(vmx, v[j]); vmn = fminf(vmn, v[j] > -3.0e38f ? v[j] : vmn); }
    vmx = dpp_wave_max(vmx); vmn = dpp_wave_min(vmn);
    unsigned T = 0u, n_gt = 0u, n_ge = 0u;
    bool fast = false;
    if (vmx > vmn) {
        const float scale = 256.0f / (vmx - vmn);
        *(LAS u32x4*)(hist + 4 * lane) = (u32x4){0u, 0u, 0u, 0u};
        if (lane == 0) *ccnt = 0u;
        LDS_WAIT();
#pragma unroll
        for (int j = 0; j < 32; ++j) if (j < njv) { int b = (int)((v[j] - vmn) * scale); b = b > 255 ? 255 : b; __hip_atomic_fetch_add(hist + b, 1u, __ATOMIC_RELAXED, __HIP_MEMORY_SCOPE_WORKGROUP); }
        LDS_WAIT();
        const u32x4 h4 = *(const LAS u32x4*)(hist + 4 * (63 - lane));
        const unsigned c4 = h4.x + h4.y + h4.z + h4.w;
        const unsigned P = dpp_scan_add(c4);
        const u64 bal = __ballot(P >= (unsigned)TOPK);
        const int Ls = __builtin_ctzll(bal);
        const unsigned P_L = __builtin_amdgcn_readlane(P, Ls), c_L = __builtin_amdgcn_readlane(c4, Ls);
        const unsigned hb0 = __builtin_amdgcn_readlane(h4.x, Ls), hb1 = __builtin_amdgcn_readlane(h4.y, Ls), hb2 = __builtin_amdgcn_readlane(h4.z, Ls), hb3 = __builtin_amdgcn_readlane(h4.w, Ls);
        const int bin0 = 4 * (63 - Ls);
        unsigned cum = P_L - c_L; int bstar; unsigned mc;
        if (cum + hb3 >= (unsigned)TOPK) { bstar = bin0 + 3; mc = hb3; }
        else { cum += hb3; if (cum + hb2 >= (unsigned)TOPK) { bstar = bin0 + 2; mc = hb2; }
        else { cum += hb2; if (cum + hb1 >= (unsigned)TOPK) { bstar = bin0 + 1; mc = hb1; }
        else { cum += hb1; bstar = bin0; mc = hb0; } } }
        if (mc <= 256u) {
            fast = true;
            unsigned cbase = 0;
#pragma unroll
            for (int j = 0; j < 32; ++j) { int b = (int)((v[j] - vmn) * scale); b = b > 255 ? 255 : b;
                const u64 m = __ballot(b == bstar);
                if (m) { if (b == bstar) cand[(cbase + __builtin_amdgcn_mbcnt_hi((unsigned)(m >> 32), __builtin_amdgcn_mbcnt_lo((unsigned)m, 0u))) & 255u] = ord_key(v[j]); cbase += popc64(m); } }
            LDS_WAIT();
            const unsigned r = (unsigned)TOPK - cum;
            if (mc <= 64u) {
                const unsigned cu = ((unsigned)lane < mc) ? cand[lane] : 0u;
#pragma unroll 1
                for (int bit = 31; bit >= 0; --bit) { const unsigned ct = T | (1u << bit); if (popc64(__ballot(cu >= ct)) >= r) T = ct; }
                n_gt = cum + popc64(__ballot(cu > T)); n_ge = cum + popc64(__ballot(cu >= T));
            } else {
                unsigned cu[4];
#pragma unroll
                for (int ch = 0; ch < 4; ++ch) cu[ch] = ((unsigned)(lane + 64 * ch) < mc) ? cand[lane + 64 * ch] : 0u;
#pragma unroll 1
                for (int bit = 31; bit >= 0; --bit) { const unsigned ct = T | (1u << bit); unsigned cnt = 0;
#pragma unroll
                    for (int ch = 0; ch < 4; ++ch) cnt += popc64(__ballot(cu[ch] >= ct));
                    if (cnt >= r) T = ct; }
                unsigned cge = 0, cgt = 0;
#pragma unroll
                for (int ch = 0; ch < 4; ++ch) { cge += popc64(__ballot(cu[ch] >= T)); cgt += popc64(__ballot(cu[ch] > T)); }
                n_gt = cum + cgt; n_ge = cum + cge;
            }
        }
    }
    if (!fast) {
#pragma unroll 1
        for (int bit = 31; bit >= 0; --bit) { const unsigned ct = T | (1u << bit); unsigned cnt = 0;
#pragma unroll
            for (int j = 0; j < 32; ++j) cnt += popc64(__ballot(j < njv && ord_key(v[j]) >= ct));
            if (cnt >= (unsigned)TOPK) T = ct; }
        n_gt = 0; n_ge = 0;
#pragma unroll
        for (int j = 0; j < 32; ++j) { const unsigned u = ord_key(v[j]); n_ge += popc64(__ballot(j < njv && u >= T)); n_gt += popc64(__ballot(j < njv && u > T)); }
    }
    const unsigned mneed = (unsigned)TOPK - n_gt, n_eq = n_ge - n_gt;
    u64 myword = 0ull;
    if (n_eq == mneed) {
#pragma unroll
        for (int j = 0; j < 32; ++j) { const u64 w = __ballot(ord_key(v[j]) >= T); myword = (lane == j) ? w : myword; }
    } else {
        unsigned running = 0; const u64 ltmask = (1ull << lane) - 1ull;
#pragma unroll
        for (int j = 0; j < 32; ++j) { const unsigned u = ord_key(v[j]); const u64 eqm = __ballot(u == T); const unsigned pre = running + popc64(eqm & ltmask);
            const u64 w = __ballot(u > T || (u == T && pre < mneed)); running += popc64(eqm); myword = (lane == j) ? w : myword; }
    }
    if (lane < 32) mrow[lane] = myword;
}

DI void indexer_phase(const Frame& F) {
    const bf16_t* QI = (const bf16_t*)(F.ws + WS_HF + HF_QI); const bf16_t* KI = (const bf16_t*)(F.ws + WS_HF + HF_KI);
    const float* WI = (const float*)(F.ws + WS_HF + HF_WI); u64* MASK = (u64*)(F.ws + WS_HF + HF_MASK);
    LAS float* sc = (LAS float*)F.lds;
    LAS unsigned* hist = (LAS unsigned*)(F.lds + 16 * SCP * 4) + F.wave * 256;
    LAS unsigned* cand = (LAS unsigned*)(F.lds + 16 * SCP * 4 + 8192) + F.wave * 256;
    LAS unsigned* ccnt = (LAS unsigned*)(F.lds + 16 * SCP * 4 + 16384) + F.wave * 16;
    const int lane = F.lane, fr = lane & 15, fq = lane >> 4;
    constexpr int NITEM = NB * 32 * 4;
    bf16x8 qa[8][2]; f32x4 wq[4][2];
#define IDX_ITEM(i_, c_, b_, tok0_) const int L_##i_ = (i_) * F.G + (((i_) & 1) ? (F.G - 1 - F.bid) : F.bid); const int c_ = 31 - L_##i_ / 64, b_ = (L_##i_ % 64) >> 2, tok0_ = b_ * SEQ + c_ * 64 + ((L_##i_ % 64) & 3) * 16
#define IDX_LOADQ(tok0_) do { _Pragma("unroll") for (int h = 0; h < 8; ++h) _Pragma("unroll") for (int ks = 0; ks < 2; ++ks) qa[h][ks] = *(const bf16x8*)(QI + (size_t)((tok0_) + fr) * 512 + h * 64 + ks * 32 + fq * 8); \
        _Pragma("unroll") for (int j = 0; j < 4; ++j) { wq[j][0] = *(const f32x4*)(WI + (size_t)((tok0_) + 4 * fq + j) * 8); wq[j][1] = *(const f32x4*)(WI + (size_t)((tok0_) + 4 * fq + j) * 8 + 4); } } while (0)
    { IDX_ITEM(0, c0, b0, t0); (void)b0; if (F.bid < NITEM && c0 >= 4) IDX_LOADQ(t0); }
    for (int i = 0;; ++i) {
        const int L = i * F.G + ((i & 1) ? (F.G - 1 - F.bid) : F.bid); if (L >= NITEM) break;
        const int c = 31 - L / 64, rr = L % 64, b = rr >> 2, g4 = rr & 3;
        const int tok0 = b * SEQ + c * 64 + g4 * 16, nk = 64 * (c + 1);
        const int Ln = (i + 1) * F.G + (((i + 1) & 1) ? (F.G - 1 - F.bid) : F.bid);
        const int cn = 31 - Ln / 64, tokn = ((Ln % 64) >> 2) * SEQ + cn * 64 + ((Ln % 64) & 3) * 16; const bool pre = Ln < NITEM && cn >= 4;
        if (c >= 4) {
            const int ntile = nk / 16, ntw = (ntile - F.wave + 7) >> 3;
            const bf16_t* kbase = KI + (size_t)(b * SEQ + fr) * 64 + fq * 8;
            bf16x8 kA[4][2], kB[4][2];
#define IDX_LOAD(dst, i0) do { _Pragma("unroll") for (int u = 0; u < 4; ++u) { int i_ = (i0) + u; i_ = i_ < ntw ? i_ : ntw - 1; const bf16_t* kp = kbase + (size_t)(F.wave + 8 * i_) * 16 * 64; \
                dst[u][0] = *(const bf16x8*)kp; dst[u][1] = *(const bf16x8*)(kp + 32); } } while (0)
#define IDX_COMP(srcb, i0) do { _Pragma("unroll") for (int u = 0; u < 4; ++u) { const int i_ = (i0) + u; if (i_ < ntw) { const int kt = F.wave + 8 * i_; f32x4 s = {0.f, 0.f, 0.f, 0.f}; \
                _Pragma("unroll") for (int h = 0; h < 8; ++h) { f32x4 acc = {0.f, 0.f, 0.f, 0.f}; \
                    acc = __builtin_amdgcn_mfma_f32_16x16x32_bf16(qa[h][0], srcb[u][0], acc, 0, 0, 0); \
                    acc = __builtin_amdgcn_mfma_f32_16x16x32_bf16(qa[h][1], srcb[u][1], acc, 0, 0, 0); \
                    _Pragma("unroll") for (int j = 0; j < 4; ++j) s[j] += wq[j][h >> 2][h & 3] * fmaxf(acc[j], 0.f); } \
                _Pragma("unroll") for (int j = 0; j < 4; ++j) sc[(4 * fq + j) * SCP + kt * 16 + fr] = s[j]; } } } while (0)
            IDX_LOAD(kA, 0);
            for (int i0 = 0; i0 < ntw; i0 += 8) {
                IDX_LOAD(kB, i0 + 4);
                IDX_COMP(kA, i0);
                IDX_LOAD(kA, i0 + 8);
                IDX_COMP(kB, i0 + 4);
            }
#undef IDX_LOAD
#undef IDX_COMP
            __syncthreads();
            if (pre) IDX_LOADQ(tokn);
#pragma unroll 1
            for (int qq = 0; qq < 2; ++qq) { const int ql = 2 * F.wave + qq;
                select_topk(sc + ql * SCP, c + 1, hist, cand, ccnt, lane, MASK + (size_t)(tok0 + ql) * 32); }
            __syncthreads();
        } else {
            const int q = F.tid >> 5, w = F.tid & 31;
            MASK[(size_t)(tok0 + q) * 32 + w] = (w <= c) ? ~0ull : 0ull;
            if (pre) IDX_LOADQ(tokn);
        }
    }
#undef IDX_ITEM
#undef IDX_LOADQ
}

namespace att {
constexpr float SCALE = 0.08838834764831845f;
constexpr float THR = 8.f;
constexpr int NW = 8, QBLK = 32, KVBLK = 64, QB = NW * QBLK;
constexpr int SHM_V = KVBLK * HD * 2, SHM_K = KVBLK * HD * 2;
#define KSWZ(row, colB) ((row) * 256 + ((colB) ^ (((row) & 7) << 4)))
#define SBAR() __builtin_amdgcn_sched_barrier(0)
DI int v_st(int k, int c) { const int kk = (k & ~0xC) | ((k & 4) << 1) | ((k & 8) >> 1); return ((kk >> 3) * 4 + (c >> 5)) * 512 + ((kk & 7) * 32 + (c & 31)) * 2; }
DI int v_rd_base(int lane) { return ((lane & 3) << 3) | (((lane >> 2) & 3) << 6) | (((lane >> 4) & 1) << 5) | (((lane >> 5) & 1) << 8); }
constexpr int v_rd_off(int d0, int ks, int half) { return d0 * 512 + ks * 4096 + half * 2048; }
DI int crow(int r, int hi) { return (r & 3) + 8 * (r >> 2) + 4 * hi; }

DI void partialSM(f32x16& p0, f32x16& p1, float& m_reg, float& mn, float& alpha) {
    float pmax = p0[0];
#pragma unroll
    for (int r = 1; r < 16; ++r) pmax = fmaxf(pmax, p0[r]);
#pragma unroll
    for (int r = 0; r < 16; ++r) pmax = fmaxf(pmax, p1[r]);
    { auto rr = __builtin_amdgcn_permlane32_swap(__float_as_uint(pmax), __float_as_uint(pmax), false, false);
      pmax = fmaxf(__uint_as_float(rr[0]), __uint_as_float(rr[1])); }
    constexpr float C2 = 1.4426950408889634f * SCALE;
    if (__builtin_expect(__all((pmax - m_reg) * SCALE <= THR), 1)) { mn = m_reg; alpha = 1.f; }
    else { mn = fmaxf(m_reg, pmax); alpha = __builtin_amdgcn_exp2f((m_reg - mn) * C2); m_reg = mn; }
    const float mnL = -mn * C2;
#pragma unroll
    for (int r = 0; r < 16; ++r) p0[r] = fmaf(p0[r], C2, mnL);
#pragma unroll
    for (int r = 0; r < 16; ++r) p1[r] = fmaf(p1[r], C2, mnL);
#pragma unroll
    for (int r = 0; r < 16; ++r) p0[r] = __builtin_amdgcn_exp2f(p0[r]);
}
#define PK4(P, B_, OUT) do { unsigned a0 = cvt_pk_bf16(P[B_+0], P[B_+1]), a1 = cvt_pk_bf16(P[B_+2], P[B_+3]);                          \
        unsigned b0 = cvt_pk_bf16(P[B_+4], P[B_+5]), b1 = cvt_pk_bf16(P[B_+6], P[B_+7]);                                             \
        auto r0 = __builtin_amdgcn_permlane32_swap(a0, b0, false, false); auto r1 = __builtin_amdgcn_permlane32_swap(a1, b1, false, false); \
        u32x4 w = {r0[0], r1[0], r0[1], r1[1]}; OUT = *reinterpret_cast<bf16x8*>(&w); } while (0)
DI void finishSM(f32x16& p0, f32x16& p1, float alpha, float& l_reg, bf16x8& pa0, bf16x8& pa1, bf16x8& pa2, bf16x8& pa3) {
#pragma unroll
    for (int r = 0; r < 16; ++r) p1[r] = __builtin_amdgcn_exp2f(p1[r]);
    float ps = 0;
#pragma unroll
    for (int r = 0; r < 16; ++r) ps += p0[r];
#pragma unroll
    for (int r = 0; r < 16; ++r) ps += p1[r];
    { auto rr = __builtin_amdgcn_permlane32_swap(__float_as_uint(ps), __float_as_uint(ps), false, false);
      ps = __uint_as_float(rr[0]) + __uint_as_float(rr[1]); }
    l_reg = l_reg * alpha + ps;
    PK4(p0, 0, pa0); PK4(p0, 8, pa1); PK4(p1, 0, pa2); PK4(p1, 8, pa3);
}
DI void packP(const f32x16& p0, const f32x16& p1, bf16x8& pa0, bf16x8& pa1, bf16x8& pa2, bf16x8& pa3) {
    PK4(p0, 0, pa0); PK4(p0, 8, pa1); PK4(p1, 0, pa2); PK4(p1, 8, pa3);
}
template <int KB>
DI void qkt(f32x16& p0, f32x16& p1, const LAS char* K_lds, int r32, int hi, const bf16x8* qr) {
    p0 = f32x16{}; p1 = f32x16{};
    const LAS char* kb[4];
#pragma unroll
    for (int dd = 0; dd < 4; ++dd) kb[dd] = K_lds + KB * SHM_K + KSWZ(r32, (dd * 16 + hi * 8) * 2);
#pragma unroll
    for (int d0 = 0; d0 < 8; ++d0) { const LAS char* a = kb[d0 & 3] + (d0 >> 2) * 128;
        bf16x8 b0 = *reinterpret_cast<const LAS bf16x8*>(a);
        bf16x8 b1 = *reinterpret_cast<const LAS bf16x8*>(a + 32 * 256);
        p0 = __builtin_amdgcn_mfma_f32_32x32x16_bf16(b0, qr[d0], p0, 0, 0, 0);
        p1 = __builtin_amdgcn_mfma_f32_32x32x16_bf16(b1, qr[d0], p1, 0, 0, 0); }
}
template <int VB>
DI void pv_tile(f32x16* o, int vb0, bf16x8 pa0, bf16x8 pa1, bf16x8 pa2, bf16x8 pa3) {
#define TRRD(dst, off) asm volatile("ds_read_b64_tr_b16 %0, %1 offset:%2" : "=&v"(dst) : "v"(vb0), "i"(off) : "memory")
#define PV_D0(d0) do { s16x4 l0, l1, l2, l3, h0, h1, h2, h3; constexpr int b_ = VB * SHM_V + v_rd_off(d0, 0, 0);   \
        TRRD(l0, b_); TRRD(h0, b_ + 2048); TRRD(l1, b_ + 4096); TRRD(h1, b_ + 6144); TRRD(l2, b_ + 8192); TRRD(h2, b_ + 10240); TRRD(l3, b_ + 12288); TRRD(h3, b_ + 14336); \
        asm volatile("s_waitcnt lgkmcnt(0)" ::: "memory"); SBAR();   \
        o[d0] = __builtin_amdgcn_mfma_f32_32x32x16_bf16(pa0, (bf16x8){l0[0], l0[1], l0[2], l0[3], h0[0], h0[1], h0[2], h0[3]}, o[d0], 0, 0, 0);   \
        o[d0] = __builtin_amdgcn_mfma_f32_32x32x16_bf16(pa1, (bf16x8){l1[0], l1[1], l1[2], l1[3], h1[0], h1[1], h1[2], h1[3]}, o[d0], 0, 0, 0);   \
        o[d0] = __builtin_amdgcn_mfma_f32_32x32x16_bf16(pa2, (bf16x8){l2[0], l2[1], l2[2], l2[3], h2[0], h2[1], h2[2], h2[3]}, o[d0], 0, 0, 0);   \
        o[d0] = __builtin_amdgcn_mfma_f32_32x32x16_bf16(pa3, (bf16x8){l3[0], l3[1], l3[2], l3[3], h3[0], h3[1], h3[2], h3[3]}, o[d0], 0, 0, 0); } while (0)
    PV_D0(0); PV_D0(1); PV_D0(2); PV_D0(3);
#undef PV_D0
#undef TRRD
}
struct Stage { bf16x8 k0, k1, v0, v1; };
DI void sload(Stage& s, const bf16_t* Kp, const bf16_t* Vp, size_t tokbase, int k0, int sr, int hcol) {
    const size_t o0 = (tokbase + k0 + sr) * DM + hcol, o1 = o0 + (size_t)32 * DM;
    s.v0 = *(const bf16x8*)(Vp + o0); s.v1 = *(const bf16x8*)(Vp + o1); s.k0 = *(const bf16x8*)(Kp + o0); s.k1 = *(const bf16x8*)(Kp + o1);
}
DI void swrite(const Stage& s, LAS char* V_lds, LAS char* K_lds, int bf, int kws, int vst0, int vst1) {
    *(LAS bf16x8*)(V_lds + bf * SHM_V + vst0) = s.v0; *(LAS bf16x8*)(V_lds + bf * SHM_V + vst1) = s.v1;
    *(LAS bf16x8*)(K_lds + bf * SHM_K + kws) = s.k0; *(LAS bf16x8*)(K_lds + bf * SHM_K + kws + 32 * 256) = s.k1;
}
DI void store_o(const f32x16* o, const float* rli, bf16_t* Ow, int r32, int hi) {
#pragma unroll
    for (int r = 0; r < 16; ++r) { const int orow = crow(r, hi);
#pragma unroll
        for (int d0 = 0; d0 < 4; ++d0) { const float v = o[d0][r] * rli[r]; const float vn = __shfl_xor(v, 1);
            if ((r32 & 1) == 0) *(unsigned*)(Ow + (size_t)orow * DM + d0 * 32 + r32) = cvt_pk_bf16(v, vn); } }
}

DI void attnA_phase(const Frame& F) {
    const bf16_t* Q = (const bf16_t*)(F.ws + WS_R1); const bf16_t* Kt = Q + (size_t)NTOK * DM; const bf16_t* Vt = Kt + (size_t)NTOK * DM;
    bf16_t* O = (bf16_t*)(F.ws + WS_HF + 64 * MiB); const u64* MASK = (const u64*)(F.ws + WS_HF + HF_MASK);
    LAS char* V_lds = (LAS char*)F.lds; LAS char* K_lds = V_lds + 2 * SHM_V;
    const int tid = F.tid, wid = F.wave, lane = F.lane, r32 = lane & 31, hi = lane >> 5;
    LAS float* wsl = (LAS float*)(F.lds + 2 * SHM_V + 2 * SHM_K) + wid * 64; LAS float* li_l = wsl; LAS float* al_l = wsl + 32;
    const int sr = tid >> 4, sc = (tid & 15) * 8, vst0 = v_st(sr, sc), vst1 = v_st(32 + sr, sc), kws = KSWZ(sr, sc * 2);
    const int vb0 = (int)(uintptr_t)V_lds + v_rd_base(lane);
    constexpr int NITEM = NB * NH * 8;
    for (int it = F.bid; it < NITEM; it += F.G) {
        int bh, qb;
        if (F.G == 256) { const int pass = it >> 8, xcd = F.bid & 7, slot = F.bid >> 3, grp = slot >> 3, mem = slot & 7; bh = (pass * 4 + grp) * 8 + xcd; qb = (pass & 1) ? 7 - mem : mem; }
        else { bh = it >> 3; qb = it & 7; }
        const int b = bh >> 3, h = bh & 7, q0 = qb * QB, NT = 4 * (qb + 1);
        const size_t tokbase = (size_t)b * SEQ; const int hcol = h * HD + sc;
        const int qrow = q0 + wid * QBLK + r32, myc = (q0 + wid * QBLK) >> 6;
        bf16x8 qr[8];
#pragma unroll
        for (int d0 = 0; d0 < 8; ++d0) qr[d0] = *(const bf16x8*)(Q + (tokbase + qrow) * DM + h * HD + d0 * 16 + hi * 8);
        const u64* mrow = MASK + (tokbase + qrow) * 32;
        float m_reg = -1e30f, l_reg = 0.f; f32x16 o[4] = {};
        Stage st; sload(st, Kt, Vt, tokbase, 0, sr, hcol);
        u64 mw = mrow[0], mwn = mrow[1];
        asm volatile("s_waitcnt vmcnt(0)" ::: "memory");
        swrite(st, V_lds, K_lds, 0, kws, vst0, vst1);
        __syncthreads();
        f32x16 pA0, pA1, pB0, pB1; float mnA, mnB, alA = 1.f, alB = 1.f; bf16x8 pa0, pa1, pa2, pa3;
#define A_MSEL(P, M, BIT) do { const unsigned t_ = (unsigned)__builtin_amdgcn_sbfe((int)(M), (BIT), 1); P = __uint_as_float((__float_as_uint(P) & t_) | (__float_as_uint(ninf_) & ~t_)); } while (0)
#define A_MASK(P0, P1) do { const unsigned mlo = (unsigned)mw >> (4 * hi), mhi = (unsigned)(mw >> 32) >> (4 * hi); const float ninf_ = -__builtin_inff(); \
            _Pragma("unroll") for (int r = 0; r < 16; ++r) { A_MSEL(P0[r], mlo, (r & 3) + 8 * (r >> 2)); A_MSEL(P1[r], mhi, (r & 3) + 8 * (r >> 2)); } } while (0)
#define A_RESC(a) do { if (__any((a) < 1.f)) { if (hi == 0) al_l[r32] = (a); LDS_WAIT();                              \
                _Pragma("unroll") for (int d_ = 0; d_ < 4; ++d_) _Pragma("unroll") for (int r = 0; r < 16; ++r) o[d_][r] *= al_l[crow(r, hi)]; } } while (0)
        sload(st, Kt, Vt, tokbase, KVBLK, sr, hcol);
        qkt<0>(pA0, pA1, K_lds, r32, hi, qr);
        A_MASK(pA0, pA1); partialSM(pA0, pA1, m_reg, mnA, alA);
        asm volatile("s_waitcnt vmcnt(0)" ::: "memory"); swrite(st, V_lds, K_lds, 1, kws, vst0, vst1); mw = mwn;
        __syncthreads();
#define A_HALF(PX0, PX1, mnX, alX, PY0, PY1, alY, t, KB, VB, SB) do { const bool actT = (t) <= myc, actP = (t) - 1 <= myc, more = (t) + 1 < NT; \
        if (more) mwn = mrow[(t) + 1];                                                                              \
        SBAR(); if (actT) qkt<KB>(PX0, PX1, K_lds, r32, hi, qr);                                                    \
        if (actP) { finishSM(PY0, PY1, alY, l_reg, pa0, pa1, pa2, pa3); } SBAR();                                   \
        if (more) sload(st, Kt, Vt, tokbase, ((t) + 1) * KVBLK, sr, hcol);                                          \
        SBAR(); if (actP) pv_tile<VB>(o, vb0, pa0, pa1, pa2, pa3);                                                  \
        if (actT) { A_MASK(PX0, PX1); partialSM(PX0, PX1, m_reg, mnX, alX); }                                       \
        __syncthreads();                                                                                            \
        if (more) { asm volatile("s_waitcnt vmcnt(0)" ::: "memory"); swrite(st, V_lds, K_lds, SB, kws, vst0, vst1); } \
        mw = mwn;                                                                                                   \
        if (actT) A_RESC(alX);                                                                                      \
        __syncthreads(); } while (0)
        for (int t = 1; t + 1 < NT; t += 2) {
            A_HALF(pB0, pB1, mnB, alB, pA0, pA1, alA, t, 1, 0, 0);
            A_HALF(pA0, pA1, mnA, alA, pB0, pB1, alB, t + 1, 0, 1, 1);
        }
        { const bool actT = NT - 1 <= myc, actP = NT - 2 <= myc;
          SBAR(); if (actT) qkt<1>(pB0, pB1, K_lds, r32, hi, qr);
          if (actP) { finishSM(pA0, pA1, alA, l_reg, pa0, pa1, pa2, pa3); SBAR(); pv_tile<0>(o, vb0, pa0, pa1, pa2, pa3); }
          if (actT) { A_MASK(pB0, pB1); partialSM(pB0, pB1, m_reg, mnB, alB); A_RESC(alB);
                      finishSM(pB0, pB1, alB, l_reg, pa0, pa1, pa2, pa3); SBAR(); pv_tile<1>(o, vb0, pa0, pa1, pa2, pa3); } }
#undef A_HALF
#undef A_MASK
#undef A_MSEL
#undef A_RESC
        if (hi == 0) li_l[r32] = l_reg; LDS_WAIT();
        float rli[16];
#pragma unroll
        for (int r = 0; r < 16; ++r) rli[r] = __builtin_amdgcn_rcpf(li_l[crow(r, hi)]);
        store_o(o, rli, O + (tokbase + q0 + wid * QBLK) * DM + h * HD, r32, hi);
        __syncthreads();
    }
}

DI void attnB_phase(const Frame& F) {
    const bf16_t* Q = (const bf16_t*)(F.ws + WS_R1); const bf16_t* Kt = Q + (size_t)NTOK * DM; const bf16_t* Vt = Kt + (size_t)NTOK * DM;
    bf16_t* O = (bf16_t*)(F.ws + WS_HF + 64 * MiB);
    LAS char* V_lds = (LAS char*)F.lds; LAS char* K_lds = V_lds + 3 * SHM_V;
    const int tid = F.tid, wid = F.wave, lane = F.lane, r32 = lane & 31, hi = lane >> 5;
    LAS int* flags = (LAS int*)(F.lds + 3 * SHM_V + 3 * SHM_K);
    const int vb0 = (int)(uintptr_t)V_lds + v_rd_base(lane);
    unsigned offK[2], offV[2];
#pragma unroll
    for (int i = 0; i < 2; ++i) { const int p = i * 512 + wid * 64 + lane;
        { const int row = p >> 4, ch = (p & 15) ^ (row & 7); offK[i] = (unsigned)(row * DM + ch * 8) * 2u; }
        { const int sub = p >> 5, kk = (sub >> 2) * 8 + ((p & 31) >> 2), col = (sub & 3) * 32 + (p & 3) * 8, k = (kk & ~0xC) | ((kk & 4) << 1) | ((kk & 8) >> 1); offV[i] = (unsigned)(k * DM + col) * 2u; } }
    const unsigned ldsw = (unsigned)wid * 1024u;
    constexpr float C2 = 1.4426950408889634f * SCALE;
    constexpr int NITEM = NB * NH * 8;
    for (int it = F.bid; it < NITEM; it += F.G) {
        int bh, qb;
        if (F.G == 256) { const int pass = it >> 8, xcd = F.bid & 7, slot = F.bid >> 3, grp = slot >> 3, mem = slot & 7; bh = (pass * 4 + grp) * 8 + xcd; qb = (pass & 1) ? 7 - mem : mem; }
        else { bh = it >> 3; qb = it & 7; }
        const int b = bh >> 3, h = bh & 7, q0 = qb * QB;
        const size_t tokbase = (size_t)b * SEQ;
        const int qw0 = q0 + wid * QBLK, qrow = qw0 + r32, t_hi = 4 * (qb + 1) - 1, t_w = (qw0 + QBLK - 1) >> 6;
        const char* Kb = (const char*)(Kt + tokbase * DM + h * HD); const char* Vb = (const char*)(Vt + tokbase * DM + h * HD);
        bf16x8 qr[8];
#pragma unroll
        for (int d0 = 0; d0 < 8; ++d0) qr[d0] = *(const bf16x8*)(Q + (tokbase + qrow) * DM + h * HD + d0 * 16 + hi * 8);
        float carry = 1.f; int done_w = 0; f32x16 o[4] = {};
#define B_DMA(t_, SLOT) do { const size_t tb_ = (size_t)(t_) * KVBLK * DM * 2; _Pragma("unroll") for (int i = 0; i < 2; ++i) { \
            __builtin_amdgcn_global_load_lds((const unsigned*)(Kb + tb_ + offK[i]), (LAS unsigned*)(K_lds + (SLOT) * SHM_K + ldsw + i * 8192), 16, 0, 0); \
            __builtin_amdgcn_global_load_lds((const unsigned*)(Vb + tb_ + offV[i]), (LAS unsigned*)(V_lds + (SLOT) * SHM_V + ldsw + i * 8192), 16, 0, 0); } } while (0)
        asm volatile("s_waitcnt vmcnt(0)" ::: "memory");
        B_DMA(t_hi, 0); B_DMA(t_hi - 1, 1);
        asm volatile("s_waitcnt vmcnt(4)" ::: "memory");
        __builtin_amdgcn_s_barrier(); asm volatile("" ::: "memory");
        bool stop = false;
#define B_STEP(itn, SLOT, SLOTW) do { const int t = t_hi - (itn); const bool more = t > 0, more2 = t > 1;              \
        if (more2) B_DMA(t - 2, SLOTW);                                                                             \
        if (t <= t_w && !done_w) { f32x16 p0, p1, l0v, l1v; bf16x8 pa0, pa1, pa2, pa3;                               \
            qkt<SLOT>(p0, p1, K_lds, r32, hi, qr);                                                                  \
            const int dq = qrow - t * KVBLK - 4 * hi;                                                               \
              \
            _Pragma("unroll") for (int r = 0; r < 16; ++r) { const int cr = (r & 3) + 8 * (r >> 2);                 \
                const float e0 = __builtin_amdgcn_exp2f(-fmaxf(p0[r] * C2, -100.f)), e1 = __builtin_amdgcn_exp2f(-fmaxf(p1[r] * C2, -100.f)); \
                const float g0 = __builtin_amdgcn_rcpf(1.0f + e0), g1 = __builtin_amdgcn_rcpf(1.0f + e1);         \
                const bool v0 = cr < dq, v1 = cr + 32 < dq;                                                         \
                p0[r] = v0 ? g0 : 0.f; p1[r] = v1 ? g1 : 0.f;                                                       \
                l0v[r] = v0 ? e0 * g0 : 1.f; l1v[r] = v1 ? e1 * g1 : 1.f; }                                         \
            float gs[8];                                                                                            \
            _Pragma("unroll") for (int g = 0; g < 4; ++g) { gs[g] = (l0v[4 * g] * l0v[4 * g + 1]) * (l0v[4 * g + 2] * l0v[4 * g + 3]); \
                                                            gs[4 + g] = (l1v[4 * g] * l1v[4 * g + 1]) * (l1v[4 * g + 2] * l1v[4 * g + 3]); } \
            float acc = carry;                                                                                      \
            _Pragma("unroll") for (int g = 7; g >= 0; --g) {                                                        \
                auto rr = __builtin_amdgcn_permlane32_swap(__float_as_uint(gs[g]), __float_as_uint(gs[g]), false, false); \
                const float slo = __uint_as_float(rr[0]), shi = __uint_as_float(rr[1]);                             \
                float run = acc * (hi ? 1.f : shi);                                                                 \
                _Pragma("unroll") for (int j = 3; j >= 0; --j) { const int r = 4 * (g & 3) + j;                     \
                    if (g >= 4) { const float a_ = p1[r] * run; run *= l1v[r]; p1[r] = a_; }                        \
                    else        { const float a_ = p0[r] * run; run *= l0v[r]; p0[r] = a_; } }                      \
                acc *= slo * shi; }                                                                                 \
            carry = acc;                                                                                            \
            packP(p0, p1, pa0, pa1, pa2, pa3); SBAR();                                                              \
            pv_tile<SLOT>(o, vb0, pa0, pa1, pa2, pa3);                                                              \
            done_w = __all(carry < 1.0e-37f) ? 1 : 0; }                                                                     \
        if (lane == 0) flags[((itn) & 1) * 8 + wid] = done_w;                                                       \
        if (more2) asm volatile("s_waitcnt vmcnt(4)" ::: "memory"); else asm volatile("s_waitcnt vmcnt(0)" ::: "memory");     \
        LDS_WAIT(); __builtin_amdgcn_s_barrier(); asm volatile("" ::: "memory");                                    \
        { int alld = 1; _Pragma("unroll") for (int w = 0; w < 8; ++w) alld &= flags[((itn) & 1) * 8 + w]; stop = (alld != 0) || !more; } } while (0)
        for (int itn = 0;; itn += 3) { B_STEP(itn, 0, 2); if (stop) break; B_STEP(itn + 1, 1, 0); if (stop) break; B_STEP(itn + 2, 2, 1); if (stop) break; }
#undef B_STEP
#undef B_DMA
        asm volatile("s_waitcnt vmcnt(0)" ::: "memory");
        float rli[16];
#pragma unroll
        for (int r = 0; r < 16; ++r) rli[r] = 1.0f;
        store_o(o, rli, O + (tokbase + qw0) * DM + h * HD, r32, hi);
        __syncthreads();
    }
}
#undef PK4
}

DI void route16(const float (&lg)[16], const float (&bias)[16], int& e0, int& e1, float& w0, float& w1) {
    float mx = lg[0];
#pragma unroll
    for (int i = 1; i < 16; ++i) mx = fmaxf(mx, lg[i]);
    float pr[16], sum = 0.f;
#pragma unroll
    for (int i = 0; i < 16; ++i) { pr[i] = __builtin_amdgcn_exp2f((lg[i] - mx) * 1.4426950408889634f); sum += pr[i]; }
    float sel[16];
#pragma unroll
    for (int i = 0; i < 16; ++i) { pr[i] = pr[i] / sum; sel[i] = pr[i] + bias[i]; }
    float gsc[4];
#pragma unroll
    for (int g = 0; g < 4; ++g) { const float a = sel[4 * g], b = sel[4 * g + 1], c = sel[4 * g + 2], d = sel[4 * g + 3];
        gsc[g] = fmaxf(fmaxf(fmaxf(a + b, a + c), fmaxf(a + d, b + c)), fmaxf(b + d, c + d)); }
    int g = 0; float best = gsc[0];
#pragma unroll
    for (int i = 1; i < 4; ++i) if (gsc[i] > best) { best = gsc[i]; g = i; }
    float xs[4], ps[4];
#pragma unroll
    for (int j = 0; j < 4; ++j) { xs[j] = (g == 0) ? sel[j] : (g == 1) ? sel[4 + j] : (g == 2) ? sel[8 + j] : sel[12 + j];
                                  ps[j] = (g == 0) ? pr[j] : (g == 1) ? pr[4 + j] : (g == 2) ? pr[8 + j] : pr[12 + j]; }
    int i1 = 0; float b1 = xs[0];
#pragma unroll
    for (int j = 1; j < 4; ++j) if (xs[j] > b1) { b1 = xs[j]; i1 = j; }
    int i2 = -1; float b2 = -__builtin_inff();
#pragma unroll
    for (int j = 0; j < 4; ++j) if (j != i1 && (i2 < 0 || xs[j] > b2)) { b2 = xs[j]; i2 = j; }
    const float p1 = (i1 == 0) ? ps[0] : (i1 == 1) ? ps[1] : (i1 == 2) ? ps[2] : ps[3];
    const float p2 = (i2 == 0) ? ps[0] : (i2 == 1) ? ps[1] : (i2 == 2) ? ps[2] : ps[3];
    const float s = p1 + p2;
    e0 = 4 * g + i1; e1 = 4 * g + i2; w0 = p1 / s; w1 = p2 / s;
}

DI f32x4 bf4(u32x2 a) { f32x4 r; r[0] = __uint_as_float(a.x << 16); r[1] = __uint_as_float(a.x & 0xFFFF0000u); r[2] = __uint_as_float(a.y << 16); r[3] = __uint_as_float(a.y & 0xFFFF0000u); return r; }
struct LnRow { f32x4 hp[4]; u32x2 hb[4], ya[4], yb[4]; };
template <bool HPF, int NADD>
DI void ln_load(LnRow& R, size_t row, int lane, const void* hprev, const bf16_t* y0, const bf16_t* y1) {
#pragma unroll
    for (int i = 0; i < 4; ++i) { const size_t off = row * DM + 4 * lane + 256 * i;
        if (HPF) R.hp[i] = *(const f32x4*)((const float*)hprev + off); else R.hb[i] = *(const u32x2*)((const bf16_t*)hprev + off);
        R.ya[i] = *(const u32x2*)(y0 + off);
        if (NADD == 2) R.yb[i] = *(const u32x2*)(y1 + off); }
}
template <bool HPF, int NADD, bool OUTF>
DI float ln_row(LnRow& R, f32x4 (&v)[4], size_t row, int lane, const f32x4 (&g4)[4], const f32x4 (&b4)[4], void* out, signed char* out8, float* sc8) {
#pragma unroll
    for (int i = 0; i < 4; ++i) { f32x4 ad = bf4(R.ya[i]); if (NADD == 2) ad = ad + bf4(R.yb[i]);
        const f32x4 hp = HPF ? R.hp[i] : bf4(R.hb[i]);
        v[i] = hp * DN_ALPHA + ad; }
    float s = 0.f;
#pragma unroll
    for (int i = 0; i < 4; ++i) s += (v[i][0] + v[i][1]) + (v[i][2] + v[i][3]);
    const float mean = wave_sum(s) * (1.0f / DM);
    float q = 0.f;
#pragma unroll
    for (int i = 0; i < 4; ++i) { v[i] = v[i] - mean; q += (v[i][0] * v[i][0] + v[i][1] * v[i][1]) + (v[i][2] * v[i][2] + v[i][3] * v[i][3]); }
    const float rstd = __builtin_amdgcn_rsqf(wave_sum(q) * (1.0f / DM) + LN_EPS);
#pragma unroll
    for (int i = 0; i < 4; ++i) { v[i] = v[i] * rstd * g4[i] + b4[i]; const size_t off = row * DM + 4 * lane + 256 * i;
        if (OUTF) *(f32x4*)((float*)out + off) = v[i];
        else { u32x2 w; w.x = cvt_pk_bf16(v[i][0], v[i][1]); w.y = cvt_pk_bf16(v[i][2], v[i][3]); *(u32x2*)((bf16_t*)out + off) = w; } }
    return out8 ? quant_row(v, lane, out8 + row * DM, sc8 + row) : 0.f;
}
DI float tr_reduce16(float (&pe)[16], int lane) {
    float r8[8], r4[4], r2[2], r1;
#pragma unroll
    for (int k = 0; k < 8; ++k) { const bool od = lane & 1; const float keep = od ? pe[2 * k + 1] : pe[2 * k], send = od ? pe[2 * k] : pe[2 * k + 1]; r8[k] = keep + __shfl_xor(send, 1); }
#pragma unroll
    for (int k = 0; k < 4; ++k) { const bool od = lane & 2; const float keep = od ? r8[2 * k + 1] : r8[2 * k], send = od ? r8[2 * k] : r8[2 * k + 1]; r4[k] = keep + __shfl_xor(send, 2); }
#pragma unroll
    for (int k = 0; k < 2; ++k) { const bool od = lane & 4; const float keep = od ? r4[2 * k + 1] : r4[2 * k], send = od ? r4[2 * k] : r4[2 * k + 1]; r2[k] = keep + __shfl_xor(send, 4); }
    { const bool od = lane & 8; const float keep = od ? r2[1] : r2[0], send = od ? r2[0] : r2[1]; r1 = keep + __shfl_xor(send, 8); }
    r1 += __shfl_xor(r1, 16); r1 += __shfl_xor(r1, 32);
    return r1;
}
DI void router_rows2(const f32x4 (&va)[4], const f32x4 (&vb)[4], const LAS float* wrT, int lane, float& la, float& lb) {
    float pa[16], pb[16];
#pragma unroll
    for (int e = 0; e < 16; ++e) { float a = 0.f, b = 0.f;
#pragma unroll
        for (int i = 0; i < 4; ++i) { const f32x4 w = *(const LAS f32x4*)(wrT + e * DM + 4 * lane + 256 * i);
            a += (va[i][0] * w[0] + va[i][1] * w[1]) + (va[i][2] * w[2] + va[i][3] * w[3]);
            b += (vb[i][0] * w[0] + vb[i][1] * w[1]) + (vb[i][2] * w[2] + vb[i][3] * w[3]); }
        pa[e] = a; pb[e] = b; }
    la = tr_reduce16(pa, lane); lb = tr_reduce16(pb, lane);
}
template <bool HPF, int NADD, bool OUTF, bool ROUTER>
DI void ln_phase(const Frame& F, const void* hprev, const bf16_t* y0, const bf16_t* y1, const float* gam, const float* bet, void* out,
                 const float* router_w, const float* router_b, unsigned* cnt, int* list, float* gatew, signed char* out8 = nullptr, float* sc8 = nullptr, float* lscale = nullptr) {
    LAS float* wrT = (LAS float*)F.lds;
    LAS float* lsc = (LAS float*)(F.lds + 16 * DM * 4) + F.wave * 272;
    float rb[16];
    if (ROUTER) {
        { f32x4 rw[8];
#pragma unroll
          for (int i = 0; i < 8; ++i) rw[i] = *(const f32x4*)(router_w + (size_t)(F.tid + 512 * i) * 4);
#pragma unroll
          for (int i = 0; i < 8; ++i) { const int q = F.tid + 512 * i, c = q >> 2, e4 = (q & 3) * 4;
#pragma unroll
              for (int j = 0; j < 4; ++j) wrT[(e4 + j) * DM + c] = rw[i][j]; } }
#pragma unroll
        for (int e = 0; e < 16; ++e) rb[e] = router_b[e];
        __syncthreads();
    }
    const int lane = F.lane;
    f32x4 g4[4], b4[4];
#pragma unroll
    for (int i = 0; i < 4; ++i) { g4[i] = *(const f32x4*)(gam + 4 * lane + 256 * i); b4[i] = *(const f32x4*)(bet + 4 * lane + 256 * i); }
    for (int c0 = F.bid * 8; c0 < NTOK / 16; c0 += F.G * 8) {
        const int chunk = c0 + F.wave; const bool cvalid = chunk < NTOK / 16;
        const size_t row0 = (size_t)(cvalid ? chunk : 0) * 16;
        float my_sc = 0.f;
        if (cvalid) {
            LnRow RA, RB; f32x4 va[4], vb[4];
            ln_load<HPF, NADD>(RA, row0, lane, hprev, y0, y1);
#pragma unroll 1
            for (int ri = 0; ri < 16; ri += 2) {
                ln_load<HPF, NADD>(RB, row0 + ri + 1, lane, hprev, y0, y1);
                { const float rs_ = ln_row<HPF, NADD, OUTF>(RA, va, row0 + ri, lane, g4, b4, out, out8, sc8); my_sc = (lane == ri) ? rs_ : my_sc; }
                if (ri + 2 < 16) ln_load<HPF, NADD>(RA, row0 + ri + 2, lane, hprev, y0, y1);
                { const float rs_ = ln_row<HPF, NADD, OUTF>(RB, vb, row0 + ri + 1, lane, g4, b4, out, out8, sc8); my_sc = (lane == ri + 1) ? rs_ : my_sc; }
                if (ROUTER) { float la, lb; router_rows2(va, vb, wrT, lane, la, lb); if (lane < 16) { lsc[ri * 17 + lane] = la; lsc[(ri + 1) * 17 + lane] = lb; } }
            }
        }
        if (ROUTER) {
            LDS_WAIT();
            float lg[16];
#pragma unroll
            for (int e = 0; e < 16; ++e) lg[e] = lsc[(lane & 15) * 17 + e];
            LDS_WAIT();
            int my_e0, my_e1; float my_w0, my_w1; route16(lg, rb, my_e0, my_e1, my_w0, my_w1);
            const size_t row = row0 + lane; const bool act = lane < 16 && cvalid;
            const u64 ltmask = (1ull << lane) - 1ull;
            LAS unsigned* wcnt = (LAS unsigned*)(F.lds + 16 * DM * 4 + 8 * 272 * 4);
            LAS unsigned* wbase = wcnt + 128;
            unsigned mycnt = 0;
#pragma unroll
            for (int e = 0; e < NEXP; ++e) { const unsigned n = popc64(__ballot(act && my_e0 == e)) + popc64(__ballot(act && my_e1 == e)); mycnt = (lane == e) ? n : mycnt; }
            if (lane < 16) wcnt[F.wave * 16 + lane] = mycnt;
            __syncthreads();
            if (F.wave == 0 && lane < 16) { unsigned tot = 0, pre[8];
#pragma unroll
                for (int w = 0; w < 8; ++w) { pre[w] = tot; tot += wcnt[w * 16 + lane]; }
                const unsigned base = tot ? atomicAdd(cnt + 64 * lane, tot) : 0u;
#pragma unroll
                for (int w = 0; w < 8; ++w) wbase[w * 16 + lane] = base + pre[w]; }
            __syncthreads();
#pragma unroll 1
            for (int e = 0; e < NEXP; ++e) {
                const u64 m0 = __ballot(act && my_e0 == e), m1 = __ballot(act && my_e1 == e);
                const unsigned n0 = popc64(m0);
                if (m0 | m1) { const unsigned base = wbase[F.wave * 16 + e];
                    if (act && my_e0 == e) { const size_t p = (size_t)e * LISTCAP + base + popc64(m0 & ltmask); list[p] = (int)(row * 2); gatew[p] = my_w0; lscale[p] = my_sc; }
                    if (act && my_e1 == e) { const size_t p = (size_t)e * LISTCAP + base + n0 + popc64(m1 & ltmask); list[p] = (int)(row * 2 + 1); gatew[p] = my_w1; lscale[p] = my_sc; } }
            }
            __syncthreads();
        }
    }
    if (ROUTER) __syncthreads();
}

DI void moe_table(const Frame& F, const unsigned* cnt) {
    LAS int* tab = (LAS int*)(F.lds + MISC_OFF + 64);
    if (F.tid < NEXP) tab[17 + F.tid] = (int)__hip_atomic_load(cnt + 64 * F.tid, __ATOMIC_RELAXED, __HIP_MEMORY_SCOPE_AGENT);
    __syncthreads();
    if (F.tid == 0) { int acc = 0;
        for (int e = 0; e < NEXP; ++e) { tab[e] = acc; acc += (tab[17 + e] + 255) >> 8; }
        tab[16] = acc; }
    __syncthreads();
}

__global__ void __launch_bounds__(512, 2) yoco_fwd(Args args) {
    extern __shared__ __attribute__((aligned(16))) unsigned char lds_raw[];
    Frame F;
    F.lds = (LAS unsigned char*)lds_raw; F.tid = threadIdx.x; F.lane = F.tid & 63; F.wave = __builtin_amdgcn_readfirstlane(F.tid >> 6);
    F.G = gridDim.x; F.bid = blockIdx.x; F.ws = args.ws; F.ctl = (unsigned*)(args.ws + WS_CTL);
    volatile LAS unsigned* misc = (volatile LAS unsigned*)(F.lds + MISC_OFF);
    if (F.tid < 4) misc[F.tid] = 0u;
    __syncthreads();
    XcdBarrier bar; bar.bar = F.ctl + CW_BAR; bar.x = 0; bar.st = misc;
    const int lo = args.ph_lo, hi = args.ph_hi;
    if (hi - lo > 1) bar = xcd_barrier_post(F.ctl + CW_BAR, misc);
#define IN(k) (lo <= (k) && (k) < hi)
#define SEAM(k) do { if (IN(k) && IN((k) + 1)) xcd_barrier(bar); } while (0)
    unsigned char* ws = args.ws;
    bf16_t* XB = (bf16_t*)(ws + WS_XB);
    bf16_t* QKV = (bf16_t*)(ws + WS_R1); bf16_t* MIX = (bf16_t*)(ws + WS_R1); bf16_t* OB = (bf16_t*)(ws + WS_HF + 64 * MiB);
    bf16_t* Y = (bf16_t*)(ws + WS_R1); bf16_t* HE = (bf16_t*)(ws + WS_R1 + R1_HE);
    int* LIST = (int*)(ws + WS_MOE); float* GATEW = (float*)(ws + WS_MOE + 2 * MiB); float* LSCALE = (float*)(ws + WS_MOE + 4 * MiB);
    const float* ln_g = args.in[11]; const float* ln_b = args.in[12];
    LAS int* tab = (LAS int*)(F.lds + MISC_OFF + 64);

    if (IN(0)) { p0_prologue(F, args); } SEAM(0);
    if (IN(1)) {
        pg8::SchedDense S; S.init((const bf16_t*)(ws + WS_XB8), (const bf16_t*)(ws + WS_WAIN), NTOK, NIN, DM / 2, F.G, F.bid);
        S.sA = (const float*)(ws + WS_SCL + SCL_SA); S.sB = (const float*)(ws + WS_SCL + SCL_SBIN);
        pg8::EpiInProj E{QKV, (bf16_t*)(ws + WS_HF + HF_QI), (bf16_t*)(ws + WS_HF + HF_KI), (float*)(ws + WS_HF + HF_WI)};
        pg8::gemm_phase<pg8::EpiInProj, pg8::SchedDense, true>(F.lds, S, E);
        { int rank, n; idle_rank((NTOK / 256) * (NIN / 256), F.G, F.bid, rank, n); if (rank >= 0) bg_jobs(F, args, BG_H0, BG_H1, BG_G0, BG_G1, rank, n); }
    } SEAM(1);
    if (IN(2)) { indexer_phase(F); } SEAM(2);
    if (IN(3)) { att::attnA_phase(F); } SEAM(3);
    if (IN(4)) {
        pg8::SchedDense S; S.init(OB, (const bf16_t*)(ws + WS_WAOUT), NTOK, DM, DM, F.G, F.bid);
        pg8::EpiBf16Split E{MIX, DM, DM, 0}; pg8::gemm_phase(F.lds, S, E);
    } SEAM(4);
    if (IN(5)) { ln_phase<true, 1, false, true>(F, args.in[0], MIX, nullptr, ln_g, ln_b, XB, args.in[6], args.in[7], F.ctl + CW_CNT, LIST, GATEW, (signed char*)(ws + WS_XB8), (float*)(ws + WS_SCL + SCL_SA), LSCALE); } SEAM(5);
    if (IN(6)) {
        moe_table(F, F.ctl + CW_CNT);
        pg8::SchedMoe S{(const bf16_t*)(ws + WS_XB8), (const bf16_t*)(ws + WS_WGU), DM / 2, 2, (size_t)512 * DM, tab, LIST, 1, F.G, F.bid, (const float*)(ws + WS_SCL + SCL_SA), (const float*)(ws + WS_SCL + SCL_SBGU)}; S.lsc = LSCALE;
        pg8::EpiMoe1 E{HE}; pg8::gemm_phase<pg8::EpiMoe1, pg8::SchedMoe, true>(F.lds, S, E);
        { __syncthreads(); int rank, n; idle_rank(__builtin_amdgcn_readfirstlane(tab[16]) * 2, F.G, F.bid, rank, n); if (rank >= 0) bg_jobs(F, args, BG_H1, BG_H2, BG_G1, BG_G2, rank, n); }
    } SEAM(6);
    if (IN(7)) {
        moe_table(F, F.ctl + CW_CNT);
        pg8::SchedMoe S{HE, (const bf16_t*)(ws + WS_WD), FFE, 4, (size_t)DM * FFE * 2, tab, LIST, 0, F.G, F.bid}; S.gw = GATEW;
        pg8::EpiMoe2 E{Y, (const LAS float*)(F.lds + pg8::STAGE_BYTES), tab}; pg8::gemm_phase(F.lds, S, E);
        { __syncthreads(); int rank, n; idle_rank(__builtin_amdgcn_readfirstlane(tab[16]) * 4, F.G, F.bid, rank, n); if (rank >= 0) bg_jobs(F, args, BG_H2, NHV, BG_G2, NLG, rank, n); }
    } SEAM(7);
    if (IN(8)) { ln_phase<false, 2, false, false>(F, XB, Y, Y + (size_t)NTOK * DM, ln_g + DM, ln_b + DM, XB, nullptr, nullptr, nullptr, nullptr, nullptr, (signed char*)(ws + WS_XB8), (float*)(ws + WS_SCL + SCL_SA)); } SEAM(8);
    if (IN(9)) {
        pg8::SchedDense S; S.init((const bf16_t*)(ws + WS_XB8), (const bf16_t*)(ws + WS_WBQKV), NTOK, 3 * DM, DM / 2, F.G, F.bid);
        S.sA = (const float*)(ws + WS_SCL + SCL_SA); S.sB = (const float*)(ws + WS_SCL + SCL_SBQKV);
        pg8::EpiBf16Split E{QKV, DM, DM, (size_t)NTOK * DM}; pg8::gemm_phase<pg8::EpiBf16Split, pg8::SchedDense, true>(F.lds, S, E);
    } SEAM(9);
    if (IN(10)) { att::attnB_phase(F); } SEAM(10);
    if (IN(11)) {
        pg8::SchedDense S; S.init(OB, (const bf16_t*)(ws + WS_WBOUT), NTOK, DM, DM, F.G, F.bid);
        pg8::EpiBf16Split E{MIX, DM, DM, 0}; pg8::gemm_phase(F.lds, S, E);
    } SEAM(11);
    if (IN(12)) { ln_phase<false, 1, false, true>(F, XB, MIX, nullptr, ln_g + 2 * DM, ln_b + 2 * DM, XB, args.in[6], args.in[7], F.ctl + CW_CNT + 2048, LIST, GATEW, (signed char*)(ws + WS_XB8), (float*)(ws + WS_SCL + SCL_SA), LSCALE); } SEAM(12);
    if (IN(13)) {
        moe_table(F, F.ctl + CW_CNT + 2048);
        pg8::SchedMoe S{(const bf16_t*)(ws + WS_XB8), (const bf16_t*)((const signed char*)(ws + WS_WGU) + (size_t)NEXP * 512 * DM), DM / 2, 2, (size_t)512 * DM, tab, LIST, 1, F.G, F.bid, (const float*)(ws + WS_SCL + SCL_SA), (const float*)(ws + WS_SCL + SCL_SBGU) + NEXP * 512}; S.lsc = LSCALE;
        pg8::EpiMoe1 E{HE}; pg8::gemm_phase<pg8::EpiMoe1, pg8::SchedMoe, true>(F.lds, S, E);
    } SEAM(13);
    if (IN(14)) {
        moe_table(F, F.ctl + CW_CNT + 2048);
        pg8::SchedMoe S{HE, (const bf16_t*)(ws + WS_WD) + (size_t)NEXP * DM * FFE, FFE, 4, (size_t)DM * FFE * 2, tab, LIST, 0, F.G, F.bid}; S.gw = GATEW;
        pg8::EpiMoe2 E{Y, (const LAS float*)(F.lds + pg8::STAGE_BYTES), tab}; pg8::gemm_phase(F.lds, S, E);
    } SEAM(14);
    if (IN(15)) { ln_phase<false, 2, true, false>(F, XB, Y, Y + (size_t)NTOK * DM, ln_g + 3 * DM, ln_b + 3 * DM, args.out, nullptr, nullptr, nullptr, nullptr, nullptr); }
#undef IN
#undef SEAM
}


extern "C" void kernel_launch(void* const* d_in, const int* in_sizes, int n_in, void* d_out, int out_size, void* d_ws, size_t ws_size, hipStream_t stream) {
    static int grid = 0;
    if (grid == 0) {
        if (n_in != 13 || in_sizes[0] != NTOK * DM || out_size != NTOK * DM || ws_size < WS_END) {
            fprintf(stderr, "kernel_launch: unexpected shapes (n_in %d, in0 %d, out %d, ws %zu < %zu)\n", n_in, n_in > 0 ? in_sizes[0] : -1, out_size, ws_size, (size_t)WS_END); grid = -1; return; }
        int dev = 0, cus = 0, per_cu = 0;
        if (hipGetDevice(&dev) != hipSuccess || hipDeviceGetAttribute(&cus, hipDeviceAttributeMultiprocessorCount, dev) != hipSuccess) { grid = -1; return; }
        if (hipFuncSetAttribute((const void*)yoco_fwd, hipFuncAttributeMaxDynamicSharedMemorySize, LDS_BYTES) != hipSuccess) { fprintf(stderr, "kernel_launch: hipFuncSetAttribute failed\n"); grid = -1; return; }
        if (hipOccupancyMaxActiveBlocksPerMultiprocessor(&per_cu, (const void*)yoco_fwd, 512, LDS_BYTES) != hipSuccess || per_cu < 1)
            fprintf(stderr, "kernel_launch: occupancy query reports %d\n", per_cu);
        (void)hipGetLastError();
        grid = cus;
    }
    if (grid < 0) return;
    (void)hipMemsetAsync((char*)d_ws + WS_CTL, 0, CTL_BYTES, stream);
    Args a; memset(&a, 0, sizeof(a));
    for (int i = 0; i < 13; ++i) a.in[i] = (const float*)d_in[i];
    a.out = (float*)d_out; a.ws = (unsigned char*)d_ws;
#if MK_N_LAUNCHES == 1
    a.ph_lo = 0; a.ph_hi = NPH;
    hipLaunchKernelGGL(yoco_fwd, dim3(grid), dim3(512), LDS_BYTES, stream, a);
#else
    for (int p = 0; p < NPH; ++p) { a.ph_lo = p; a.ph_hi = p + 1; hipLaunchKernelGGL(yoco_fwd, dim3(grid), dim3(512), LDS_BYTES, stream, a);
#ifdef REPMASK
        if ((REPMASK >> p) & 1) hipLaunchKernelGGL(yoco_fwd, dim3(grid), dim3(512), LDS_BYTES, stream, a);
#endif
    }
#endif
}
```

```cpp
#include <hip/hip_runtime.h>
#include <cstdio>
#include <cstdint>
#include <cstring>

#ifndef MK_N_LAUNCHES
#define MK_N_LAUNCHES 1
#endif

#define LAS __attribute__((address_space(3)))
#define DI __device__ __forceinline__
typedef unsigned short bf16_t;
typedef short bf16x8 __attribute__((ext_vector_type(8)));
typedef short s16x4 __attribute__((ext_vector_type(4)));
typedef float f32x2 __attribute__((ext_vector_type(2)));
typedef float f32x4 __attribute__((ext_vector_type(4)));
typedef float f32x16 __attribute__((ext_vector_type(16)));
typedef unsigned u32x2 __attribute__((ext_vector_type(2)));
typedef unsigned u32x4 __attribute__((ext_vector_type(4)));
typedef unsigned long long u64;

constexpr int NB = 16, SEQ = 2048, DM = 1024, NTOK = NB * SEQ, NH = 8, HD = 128;
constexpr int AIN = 3656, NIN = 3840;
constexpr int NEXP = 16, FFE = 256, LISTCAP = NTOK;
constexpr int TOPK = 256;
constexpr float LN_EPS = 1e-5f;
constexpr float DN_ALPHA = 1.41421356237309515f;
constexpr int NPH = 16;
constexpr int LDS_BYTES = 160 * 1024;
constexpr int MISC_OFF = LDS_BYTES - 1024;

constexpr size_t MiB = 1u << 20;
constexpr size_t WS_CTL = 0, CTL_BYTES = 64 * 1024;
constexpr size_t WS_WAIN = 1 * MiB;
constexpr size_t WS_WAOUT = WS_WAIN + (size_t)NIN * DM * 2;
constexpr size_t WS_WBQKV = WS_WAOUT + 2 * MiB;
constexpr size_t WS_WBOUT = WS_WBQKV + 6 * MiB;
constexpr size_t WS_WGU = WS_WBOUT + 2 * MiB;
constexpr size_t WS_WD = WS_WGU + 32 * MiB;
constexpr size_t WS_ROPE = WS_WD + 16 * MiB;
constexpr size_t WS_MOE = WS_ROPE + 2 * MiB;
constexpr size_t WS_XB = WS_MOE + 6 * MiB;
constexpr size_t WS_R1 = WS_XB + 64 * MiB;
constexpr size_t WS_HF = WS_R1 + 192 * MiB;
constexpr size_t WS_XB8 = WS_HF + 128 * MiB;
constexpr size_t WS_END = WS_XB8 + 32 * MiB;
constexpr size_t WS_SCL = WS_ROPE + 1536 * 1024;
constexpr size_t SCL_SA = 0, SCL_SBIN = 128 * 1024, SCL_SBQKV = 144 * 1024, SCL_SBGU = 160 * 1024;
constexpr size_t R1_HE = 128 * MiB;
constexpr size_t HF_QI = 0, HF_KI = 32 * MiB, HF_WI = 36 * MiB, HF_MASK = 40 * MiB;
constexpr int CW_BAR = 0;
constexpr int CW_CNT = 4096;

DI unsigned cvt_pk_bf16(float lo, float hi) { unsigned r; asm volatile("v_cvt_pk_bf16_f32 %0, %1, %2" : "=v"(r) : "v"(lo), "v"(hi)); return r; }
DI float bf2f(bf16_t b) { return __uint_as_float(((unsigned)b) << 16); }
#define DPPF0(x, ctrl) __uint_as_float(__builtin_amdgcn_update_dpp(0u, __float_as_uint(x), ctrl, 0xf, 0xf, true))
DI float wave_sum(float v) {
    v += DPPF0(v, 0xB1); v += DPPF0(v, 0x4E); v += DPPF0(v, 0x141); v += DPPF0(v, 0x140);
    const float r0 = __uint_as_float(__builtin_amdgcn_readlane(__float_as_uint(v), 0)), r1 = __uint_as_float(__builtin_amdgcn_readlane(__float_as_uint(v), 16));
    const float r2 = __uint_as_float(__builtin_amdgcn_readlane(__float_as_uint(v), 32)), r3 = __uint_as_float(__builtin_amdgcn_readlane(__float_as_uint(v), 48));
    return (r0 + r1) + (r2 + r3);
}
DI float wave_max(float v) {
#pragma unroll
    for (int d = 32; d >= 1; d >>= 1) v = fmaxf(v, __shfl_xor(v, d));
    return v;
}
DI float wave_min(float v) {
#pragma unroll
    for (int d = 32; d >= 1; d >>= 1) v = fminf(v, __shfl_xor(v, d));
    return v;
}
#define LDS_WAIT() asm volatile("s_waitcnt lgkmcnt(0)" ::: "memory")

#define XB_TMO      128
#define XB_XCNT(j)  (256  + 64 * (j))
#define XB_XSUB(j)  (1280 + 64 * (j))
#define XB_XGEN(j)  (2304 + 64 * (j))
#define XB_TOP      3328
#define XB_TOPGEN   3392
#define XCD_BAR_WORDS 3456
#define XB_SPIN_CAP (1u << 22)

DI unsigned xb_ld(unsigned* p)              { return __hip_atomic_load(p, __ATOMIC_RELAXED, __HIP_MEMORY_SCOPE_AGENT); }
DI unsigned xb_add(unsigned* p, unsigned v) { return __hip_atomic_fetch_add(p, v, __ATOMIC_RELAXED, __HIP_MEMORY_SCOPE_AGENT); }
DI unsigned xb_xcc_id() { return (unsigned)__builtin_amdgcn_s_getreg((3 << 11) | 20) & 0xFu; }
#define XB_SPIN(cond, bar) do { unsigned _sp = 0; while (cond) { __builtin_amdgcn_s_sleep(1); \
    if ((++_sp & 255u) == 0u) { if (xb_ld(&(bar)[XB_TMO])) break; if (_sp > XB_SPIN_CAP) { atomicAdd(&(bar)[XB_TMO], 1u); break; } } } } while (0)

struct XcdBarrier { unsigned* bar; unsigned x; volatile LAS unsigned* st; };

DI XcdBarrier xcd_barrier_post(unsigned* bar, volatile LAS unsigned* st) {
    XcdBarrier b; b.bar = bar; b.x = xb_xcc_id(); b.st = st;
    if (threadIdx.x == 0) (void)xb_add(&bar[XB_XCNT(b.x)], 1u);
    return b;
}
DI void xcd_barrier_complete(unsigned* bar, unsigned x, unsigned& nloc, unsigned& nx) {
    const unsigned G = gridDim.x * gridDim.y * gridDim.z;
    unsigned sum, cnt, mine, sp = 0u;
    for (;;) {
        sum = 0u; cnt = 0u; mine = 0u;
#pragma unroll
        for (unsigned j = 0; j < 16; ++j) { const unsigned c = xb_ld(&bar[XB_XCNT(j)]); sum += c; cnt += (c > 0u) ? 1u : 0u; mine = (j == x) ? c : mine; }
        if (sum == G) break;
        __builtin_amdgcn_s_sleep(1);
        if ((++sp & 255u) == 0u) { if (xb_ld(&bar[XB_TMO])) break; if (sp > XB_SPIN_CAP) { atomicAdd(&bar[XB_TMO], 1u); break; } }
    }
    nloc = mine > 0u ? mine : 1u; nx = cnt > 0u ? cnt : 1u;
}
DI void xcd_barrier(const XcdBarrier& b) {
    asm volatile("s_waitcnt vmcnt(0)" ::: "memory");
    __syncthreads();
    if (threadIdx.x == 0) {
        unsigned* bar = b.bar;
        __builtin_amdgcn_s_waitcnt(0);
        unsigned nloc = b.st[0], nx = b.st[1];
        if (nloc == 0u) { xcd_barrier_complete(bar, b.x, nloc, nx); b.st[0] = nloc; b.st[1] = nx; }
        const unsigned old = xb_add(&bar[XB_XSUB(b.x)], 1u);
        const unsigned gen = old / nloc;
        if (old + 1u == (gen + 1u) * nloc) {
            __builtin_amdgcn_fence(__ATOMIC_RELEASE, "agent");
            asm volatile("s_waitcnt vmcnt(0)" ::: "memory");
            const unsigned og = xb_add(&bar[XB_TOP], 1u);
            const unsigned tg = og / nx;
            if (og + 1u == (tg + 1u) * nx) xb_add(&bar[XB_TOPGEN], 1u);
            else XB_SPIN(xb_ld(&bar[XB_TOPGEN]) == tg, bar);
            __builtin_amdgcn_fence(__ATOMIC_ACQUIRE, "agent");
            xb_add(&bar[XB_XGEN(b.x)], 1u);
            asm volatile("s_waitcnt vmcnt(0)" ::: "memory");
        } else {
            XB_SPIN(xb_ld(&bar[XB_XGEN(b.x)]) == gen, bar);
            __builtin_amdgcn_fence(__ATOMIC_ACQUIRE, "agent");
            asm volatile("s_waitcnt vmcnt(0)" ::: "memory");
        }
    }
    __syncthreads();
}

namespace pg8 {
constexpr int BM = 256, BK = 64, HALF = 128, HTB = HALF * BK * 2, STAGE_BYTES = 8 * HTB, NXCD = 8, WGM = 8;
DI int lds_byte(int r, int c) { const int st = (r >> 4) * 2 + (c >> 5), rr = r & 15, cc = c & 31, ob = rr * 64 + cc * 2; return st * 1024 + (ob ^ (((ob >> 9) & 1) << 5)); }
DI void stage_rc(int b, int& R, int& C) { const int st = b / 1024, sb = b % 1024, swz = sb ^ (((sb >> 9) & 1) << 5); R = (st >> 1) * 16 + swz / 64; C = (st & 1) * 32 + (swz % 64) / 2; }
DI int perm32(int rho) { const int n = rho >> 4, i = rho & 15; return 8 * (i >> 2) + 4 * n + (i & 3); }

struct Unit { int pm, pn, e, rb, par; };

DI int xcd_remap(int wgid, int nwg) { const int q = nwg / NXCD, r = nwg % NXCD, xcd = wgid % NXCD, off = wgid / NXCD; return (xcd < r ? xcd * (q + 1) : r * (q + 1) + (xcd - r) * q) + off; }

struct SchedDense {
    static constexpr bool GATHER = false;
    const bf16_t* A; const bf16_t* Bt; int K; int nM, nN, nwg, G, c; const float* sA = nullptr; const float* sB = nullptr;
    DI void init(const bf16_t* A_, const bf16_t* Bt_, int M, int N, int K_, int G_, int c_) { A = A_; Bt = Bt_; K = K_; nM = M / BM; nN = N / BM; nwg = nM * nN; G = G_; c = c_; }
    DI bool next(int i, Unit& u) const {
        const long L = (long)i * G + c; if (L >= nwg) return false;
        const int wgid = xcd_remap((int)L, nwg);
        const int nig = WGM * nN, gid = wgid / nig, fm = gid * WGM, gsz = (nM - fm) < WGM ? (nM - fm) : WGM;
        u.pm = fm + ((wgid % nig) % gsz); u.pn = (wgid % nig) / gsz; u.e = 0; u.rb = 0; return true;
    }
    DI const char* abase(const Unit& u) const { return (const char*)A + (size_t)u.pm * BM * K * 2; }
    DI const char* bbase(const Unit& u) const { return (const char*)Bt + (size_t)u.pn * BM * K * 2; }
    DI bool has_pref() const { return sA != nullptr; }
    DI const float* pref_ptr(const Unit& u, int tid) const { return tid < 256 ? sA + u.pm * BM + tid : sB + u.pn * BM + tid - 256; }
    DI void aoffs(const Unit&, int tid, unsigned (&v)[2][2]) const {
#pragma unroll
        for (int i = 0; i < 2; ++i) { int R, C; stage_rc(tid * 16 + i * 8192, R, C); v[0][i] = (unsigned)(R * K + C) * 2u; v[1][i] = v[0][i] + (unsigned)(HALF * K) * 2u; }
    }
};
struct SchedMoe {
    static constexpr bool GATHER = true;
    const bf16_t* A; const bf16_t* Bt; int K, nN; size_t bstride; const LAS int* tab; const int* list; int gather; int G, c; const float* sA = nullptr; const float* sB = nullptr;
    DI bool next(int i, Unit& u) const {
        const int total = tab[16] * nN; const long L = (long)i * G + c; if (L >= total) return false;
        const int wgid = xcd_remap((int)L, total);
        const int rt = wgid / nN; u.pn = wgid % nN; u.pm = rt;
        int e = 0;
#pragma unroll 1
        for (; e < 15; ++e) if (rt < tab[e + 1]) break;
        u.e = e; u.rb = (rt - tab[e]) * BM; return true;
    }
    DI const char* abase(const Unit& u) const { return gather ? (const char*)A : (const char*)A + (size_t)u.pm * BM * K * 2; }
    DI const char* bbase(const Unit& u) const { return (const char*)Bt + (size_t)u.e * bstride + (size_t)u.pn * BM * K * 2; }
    const float* gw = nullptr; const float* lsc = nullptr;
    DI bool has_pref() const { return true; }
    DI const float* pref_ptr(const Unit& u, int tid) const { const int cnt = tab[17 + u.e]; int rr = u.rb + (tid & 255); rr = rr < cnt ? rr : cnt - 1; const size_t li = (size_t)u.e * LISTCAP + rr;
        if (gather) return tid < 256 ? lsc + li : sB + u.e * 512 + u.pn * BM + tid - 256;
        return tid < 256 ? (const float*)(list + li) : gw + li; }
    DI void aoffs(const Unit& u, int tid, unsigned (&v)[2][2]) const {
        const int cnt = tab[17 + u.e];
#pragma unroll
        for (int i = 0; i < 2; ++i) { int R, C; stage_rc(tid * 16 + i * 8192, R, C);
#pragma unroll
            for (int h = 0; h < 2; ++h) {
                int row = R + h * HALF;
                if (gather) { int r = u.rb + row; r = r < cnt ? r : cnt - 1; row = list[(size_t)u.e * LISTCAP + r] >> 1; }
                v[h][i] = (unsigned)(row * K + C) * 2u; } }
    }
};

typedef int i32x4 __attribute__((ext_vector_type(4)));
template <class Epi, class Sched, bool INT8 = false>
DI void gemm_phase(LAS unsigned char* lds, const Sched& S, const Epi& E) {
    const int tid = threadIdx.x, wid = __builtin_amdgcn_readfirstlane(tid >> 6), lane = tid & 63, wr = wid >> 2, wc = wid & 3, fr = lane & 15, fq = lane >> 4;
    const int K = S.K, nt = K / BK;
    unsigned voffB[2], vA[2][2], vN[2][2];
#pragma unroll
    for (int i = 0; i < 2; ++i) { int R, C; stage_rc(tid * 16 + i * 8192, R, C); const int Rb = Epi::PERM ? ((R & ~31) + perm32(R & 31)) : R; voffB[i] = (unsigned)(Rb * K + C) * 2u; }
    const size_t kstep = (size_t)(BK * 2);
    const size_t hstep = (size_t)HALF * K * 2;
    const unsigned ldsw = (unsigned)wid * 1024u;
    const int aoff = lds_byte(wr * 64 + fr, fq * 8), boff = lds_byte(wc * 32 + fr, fq * 8);
#define PG8_SA(b, h) (((b) * 2 + (h)) * HTB)
#define PG8_SB(b, h) ((4 + (b) * 2 + (h)) * HTB)
#define PG8_STAGE(bufoff, gbase, voff) do { _Pragma("unroll") for (int _i = 0; _i < 2; ++_i) \
        __builtin_amdgcn_global_load_lds((const unsigned*)((const char*)(gbase) + (voff)[_i]), (LAS unsigned*)(lds + (bufoff) + ldsw + _i * 8192), 16, 0, 0); } while (0)
#define PG8_LDA(dst, b, h) do { _Pragma("unroll") for (int m = 0; m < 4; ++m) _Pragma("unroll") for (int k = 0; k < 2; ++k) dst[m][k] = *(const LAS bf16x8*)(lds + PG8_SA(b, h) + aoff + m * 2048 + k * 1024); } while (0)
#define PG8_LDB(dst, b, h) do { _Pragma("unroll") for (int n = 0; n < 2; ++n) _Pragma("unroll") for (int k = 0; k < 2; ++k) dst[n][k] = *(const LAS bf16x8*)(lds + PG8_SB(b, h) + boff + n * 2048 + k * 1024); } while (0)
#define PG8_MMA(ai, bj, At, Bt) do { __builtin_amdgcn_s_setprio(1); _Pragma("unroll") for (int m = 0; m < 4; ++m) _Pragma("unroll") for (int n = 0; n < 2; ++n) _Pragma("unroll") for (int k = 0; k < 2; ++k) { \
        if constexpr (INT8) acc[ai][bj][m][n] = __builtin_bit_cast(f32x4, __builtin_amdgcn_mfma_i32_16x16x64_i8(__builtin_bit_cast(i32x4, Bt[n][k]), __builtin_bit_cast(i32x4, At[m][k]), __builtin_bit_cast(i32x4, acc[ai][bj][m][n]), 0, 0, 0)); \
        else acc[ai][bj][m][n] = __builtin_amdgcn_mfma_f32_16x16x32_bf16(Bt[n][k], At[m][k], acc[ai][bj][m][n], 0, 0, 0); } __builtin_amdgcn_s_setprio(0); } while (0)
#define PG8_WAIT_V(n) asm volatile("s_waitcnt vmcnt(" #n ")" ::: "memory")
#define PG8_WAIT_L(n) asm volatile("s_waitcnt lgkmcnt(" #n ")" ::: "memory")
#define PG8_BAR __builtin_amdgcn_s_barrier()
#define PG8_SCHED __builtin_amdgcn_sched_barrier(0)
    LAS float* xl = (LAS float*)(lds + STAGE_BYTES);
    Unit cur, nxt; int ui = 0;
    if (!S.next(0, cur)) return;
    f32x4 acc[2][2][4][2];
#pragma unroll
    for (int a = 0; a < 2; ++a)
#pragma unroll
        for (int b = 0; b < 2; ++b)
#pragma unroll
            for (int m = 0; m < 4; ++m)
#pragma unroll
                for (int n = 0; n < 2; ++n) acc[a][b][m][n] = (f32x4){0.f, 0.f, 0.f, 0.f};
    bf16x8 At[4][2], B0[2][2], B1[2][2];
    const char* cA = S.abase(cur); const char* cB = S.bbase(cur);
    S.aoffs(cur, tid, vA);
    PG8_STAGE(PG8_SB(0, 0), cB, voffB); PG8_STAGE(PG8_SA(0, 0), cA, vA[0]); PG8_STAGE(PG8_SB(0, 1), cB + hstep, voffB); PG8_STAGE(PG8_SA(0, 1), cA, vA[1]);
    if (wr == 1) PG8_BAR;
    PG8_WAIT_V(4); PG8_BAR;
    PG8_STAGE(PG8_SB(1, 0), cB + kstep, voffB); PG8_STAGE(PG8_SA(1, 0), cA + kstep, vA[0]); PG8_STAGE(PG8_SB(1, 1), cB + hstep + kstep, voffB);
    PG8_WAIT_V(6); PG8_BAR;
    for (;;) {
        const bool has_next = S.next(ui + 1, nxt);
        if (S.has_pref()) __builtin_amdgcn_global_load_lds((const unsigned*)S.pref_ptr(cur, tid), (LAS unsigned*)(xl + (ui & 1) * 512 + wid * 64), 4, 0, 0);
        const char* nA = has_next ? S.abase(nxt) : cA; const char* nB = has_next ? S.bbase(nxt) : cB;
        if (Sched::GATHER) { if (has_next) S.aoffs(nxt, tid, vN); else { vN[0][0] = vA[0][0]; vN[0][1] = vA[0][1]; vN[1][0] = vA[1][0]; vN[1][1] = vA[1][1]; } }
        for (int t = 0; t < nt; t += 2) {
            const bool last = (t == nt - 2);
            const char* a1 = cA + (size_t)(t + 1) * kstep;
            const char* a2 = last ? nA : cA + (size_t)(t + 2) * kstep; const char* b2 = last ? nB : cB + (size_t)(t + 2) * kstep;
            const char* a3 = a2 + kstep; const char* b3 = b2 + kstep;
            unsigned o2[2][2];
#pragma unroll
            for (int h = 0; h < 2; ++h)
#pragma unroll
                for (int i = 0; i < 2; ++i) o2[h][i] = (Sched::GATHER && last) ? vN[h][i] : vA[h][i];
            PG8_LDB(B0, 0, 0); PG8_SCHED; PG8_LDA(At, 0, 0); PG8_STAGE(PG8_SA(1, 1), a1, vA[1]);
            PG8_WAIT_L(8); PG8_BAR; PG8_WAIT_L(0); PG8_MMA(0, 0, At, B0); PG8_BAR; PG8_SCHED;
            PG8_LDB(B1, 0, 1); PG8_STAGE(PG8_SB(0, 0), b2, voffB);
            PG8_BAR; PG8_WAIT_L(0); PG8_MMA(0, 1, At, B1); PG8_BAR;
            PG8_LDA(At, 0, 1); PG8_STAGE(PG8_SA(0, 0), a2, o2[0]);
            PG8_BAR; PG8_WAIT_L(0); PG8_MMA(1, 0, At, B0); PG8_BAR; PG8_SCHED;
            PG8_STAGE(PG8_SB(0, 1), b2 + hstep, voffB);
            PG8_WAIT_V(6); PG8_BAR; PG8_MMA(1, 1, At, B1); PG8_BAR;
            PG8_LDB(B0, 1, 0); PG8_SCHED; PG8_LDA(At, 1, 0); PG8_STAGE(PG8_SA(0, 1), a2, o2[1]);
            PG8_WAIT_L(8); PG8_BAR; PG8_WAIT_L(0); PG8_MMA(0, 0, At, B0); PG8_BAR; PG8_SCHED;
            PG8_LDB(B1, 1, 1); PG8_STAGE(PG8_SB(1, 0), b3, voffB);
            PG8_BAR; PG8_WAIT_L(0); PG8_MMA(0, 1, At, B1); PG8_BAR;
            PG8_LDA(At, 1, 1); PG8_STAGE(PG8_SA(1, 0), a3, o2[0]);
            PG8_BAR; PG8_WAIT_L(0); PG8_MMA(1, 0, At, B0); PG8_BAR; PG8_SCHED;
            PG8_STAGE(PG8_SB(1, 1), b3 + hstep, voffB);
            PG8_WAIT_V(6); PG8_BAR; PG8_MMA(1, 1, At, B1); PG8_BAR;
        }
        if constexpr (INT8) {
            const int rb_ = wr * 64 + fr, cb_ = wc * 32 + (Epi::PERM ? 8 * fq : 4 * fq);
            float ra[2][4]; f32x4 cs[2][2];
#pragma unroll
            for (int a = 0; a < 2; ++a)
#pragma unroll
                for (int m = 0; m < 4; ++m) ra[a][m] = xl[(ui & 1) * 512 + rb_ + a * HALF + m * 16];
#pragma unroll
            for (int b = 0; b < 2; ++b)
#pragma unroll
                for (int n = 0; n < 2; ++n) cs[b][n] = *(const LAS f32x4*)(xl + (ui & 1) * 512 + 256 + cb_ + b * HALF + (Epi::PERM ? 4 * n : 16 * n));
#pragma unroll
            for (int a = 0; a < 2; ++a)
#pragma unroll
                for (int b = 0; b < 2; ++b)
#pragma unroll
                    for (int m = 0; m < 4; ++m)
#pragma unroll
                        for (int n = 0; n < 2; ++n) { const i32x4 v_ = __builtin_bit_cast(i32x4, acc[a][b][m][n]);
                            acc[a][b][m][n] = (f32x4){(float)v_[0], (float)v_[1], (float)v_[2], (float)v_[3]} * ra[a][m] * cs[b][n]; }
        }
        cur.par = ui & 1;
        E(acc, cur, wr, wc, fr, fq);
        if (!has_next) break;
#pragma unroll
        for (int a = 0; a < 2; ++a)
#pragma unroll
            for (int b = 0; b < 2; ++b)
#pragma unroll
                for (int m = 0; m < 4; ++m)
#pragma unroll
                    for (int n = 0; n < 2; ++n) acc[a][b][m][n] = (f32x4){0.f, 0.f, 0.f, 0.f};
        cur = nxt; cA = nA; cB = nB; ++ui;
        if (Sched::GATHER) { vA[0][0] = vN[0][0]; vA[0][1] = vN[0][1]; vA[1][0] = vN[1][0]; vA[1][1] = vN[1][1]; }
    }
    PG8_WAIT_V(0);
    if (wr == 0) PG8_BAR;
    PG8_BAR;
#undef PG8_SA
#undef PG8_SB
#undef PG8_STAGE
#undef PG8_LDA
#undef PG8_LDB
#undef PG8_MMA
#undef PG8_WAIT_V
#undef PG8_WAIT_L
#undef PG8_BAR
#undef PG8_SCHED
}

DI u32x4 pack8(f32x4 a, f32x4 b) { u32x4 w; w.x = cvt_pk_bf16(a[0], a[1]); w.y = cvt_pk_bf16(a[2], a[3]); w.z = cvt_pk_bf16(b[0], b[1]); w.w = cvt_pk_bf16(b[2], b[3]); return w; }

struct EpiF32 {
    static constexpr bool PERM = false;
    float* C; int ldc;
    DI void operator()(const f32x4 (&acc)[2][2][4][2], const Unit& u, int wr, int wc, int fr, int fq) const {
        const int row0 = u.pm * BM + wr * 64 + fr, col0 = u.pn * BM + wc * 32 + 4 * fq;
#pragma unroll
        for (int ai = 0; ai < 2; ++ai)
#pragma unroll
            for (int m = 0; m < 4; ++m) { float* rowp = C + (size_t)(row0 + ai * HALF + m * 16) * ldc + col0;
#pragma unroll
                for (int bj = 0; bj < 2; ++bj)
#pragma unroll
                    for (int n = 0; n < 2; ++n) *(f32x4*)(rowp + bj * HALF + n * 16) = acc[ai][bj][m][n]; }
    }
};
struct EpiBf16Split {
    static constexpr bool PERM = true;
    bf16_t* O; int ldc; int split_cols; size_t split_stride;
    DI void operator()(const f32x4 (&acc)[2][2][4][2], const Unit& u, int wr, int wc, int fr, int fq) const {
        const int row0 = u.pm * BM + wr * 64 + fr; int colt = u.pn * BM; bf16_t* base = O;
        { const int t = colt / split_cols; base += (size_t)t * split_stride; colt -= t * split_cols; }
        const int col0 = colt + wc * 32 + 8 * fq;
#pragma unroll
        for (int ai = 0; ai < 2; ++ai)
#pragma unroll
            for (int m = 0; m < 4; ++m) { bf16_t* rowp = base + (size_t)(row0 + ai * HALF + m * 16) * ldc + col0;
#pragma unroll
                for (int bj = 0; bj < 2; ++bj) *(u32x4*)(rowp + bj * HALF) = pack8(acc[ai][bj][m][0], acc[ai][bj][m][1]); }
    }
};
template <int HALFD>
DI void rope4(int t, int dp, f32x4& c4, f32x4& s4) {
#pragma unroll
    for (int j = 0; j < 4; ++j) { const float inv2pi = __builtin_amdgcn_exp2f((float)(dp + j) * (-13.287712379549449f / HALFD)) * 0.15915494309189535f;
        const float x = __builtin_amdgcn_fractf((float)t * inv2pi); c4[j] = __builtin_amdgcn_cosf(x); s4[j] = __builtin_amdgcn_sinf(x); }
}
struct EpiInProj {
    static constexpr bool PERM = true;
    bf16_t* QKV; bf16_t* QI; bf16_t* KI; float* WI;
    DI void operator()(const f32x4 (&acc)[2][2][4][2], const Unit& u, int wr, int wc, int fr, int fq) const {
        const int row0 = u.pm * BM + wr * 64 + fr;
        if (u.pn < 8) {
            bf16_t* base = QKV + (size_t)(u.pn >> 2) * NTOK * DM; const int col0 = (u.pn & 3) * BM + wc * 32 + 8 * fq, dp = 16 * wc + 4 * fq;
#pragma unroll
            for (int ai = 0; ai < 2; ++ai)
#pragma unroll
                for (int m = 0; m < 4; ++m) { const int row = row0 + ai * HALF + m * 16, t = row & (SEQ - 1);
                    f32x4 c4, s4; rope4<64>(t, dp, c4, s4);
#pragma unroll
                    for (int bj = 0; bj < 2; ++bj) { const f32x4 x1 = acc[ai][bj][m][0], x2 = acc[ai][bj][m][1];
                        *(u32x4*)(base + (size_t)row * DM + col0 + bj * HALF) = pack8(x1 * c4 - x2 * s4, x1 * s4 + x2 * c4); } }
        } else if (u.pn < 12) {
            bf16_t* base = QKV + (size_t)2 * NTOK * DM; const int col0 = (u.pn - 8) * BM + wc * 32 + 8 * fq;
#pragma unroll
            for (int ai = 0; ai < 2; ++ai)
#pragma unroll
                for (int m = 0; m < 4; ++m) { const int row = row0 + ai * HALF + m * 16;
#pragma unroll
                    for (int bj = 0; bj < 2; ++bj) *(u32x4*)(base + (size_t)row * DM + col0 + bj * HALF) = pack8(acc[ai][bj][m][0], acc[ai][bj][m][1]); }
        } else if (u.pn < 14) {
            const int col0 = (u.pn - 12) * BM + wc * 32 + 8 * fq, dp = 16 * (wc & 1) + 4 * fq;
#pragma unroll
            for (int ai = 0; ai < 2; ++ai)
#pragma unroll
                for (int m = 0; m < 4; ++m) { const int row = row0 + ai * HALF + m * 16, t = row & (SEQ - 1);
                    f32x4 c4, s4; rope4<32>(t, dp, c4, s4);
#pragma unroll
                    for (int bj = 0; bj < 2; ++bj) { const f32x4 x1 = acc[ai][bj][m][0], x2 = acc[ai][bj][m][1];
                        *(u32x4*)(QI + (size_t)row * 512 + col0 + bj * HALF) = pack8(x1 * c4 - x2 * s4, x1 * s4 + x2 * c4); } }
        } else {
            if (wc < 2) { const int col0 = wc * 32 + 8 * fq, dp = 16 * wc + 4 * fq;
#pragma unroll
                for (int ai = 0; ai < 2; ++ai)
#pragma unroll
                    for (int m = 0; m < 4; ++m) { const int row = row0 + ai * HALF + m * 16, t = row & (SEQ - 1);
                        f32x4 c4, s4; rope4<32>(t, dp, c4, s4);
                        const f32x4 x1 = acc[ai][0][m][0], x2 = acc[ai][0][m][1];
                        *(u32x4*)(KI + (size_t)row * 64 + col0) = pack8(x1 * c4 - x2 * s4, x1 * s4 + x2 * c4); }
            } else if (wc == 2 && fq == 0) {
                const float sc = 0.35355339059327373f;
#pragma unroll
                for (int ai = 0; ai < 2; ++ai)
#pragma unroll
                    for (int m = 0; m < 4; ++m) { const int row = row0 + ai * HALF + m * 16;
                        *(f32x4*)(WI + (size_t)row * 8) = acc[ai][0][m][0] * sc; *(f32x4*)(WI + (size_t)row * 8 + 4) = acc[ai][0][m][1] * sc; }
            }
        }
    }
};
struct EpiMoe1 {
    static constexpr bool PERM = true;
    bf16_t* HE;
    DI void operator()(const f32x4 (&acc)[2][2][4][2], const Unit& u, int wr, int wc, int fr, int fq) const {
        const int row0 = u.pm * BM + wr * 64 + fr, hc0 = 128 * u.pn + 16 * wc + 4 * fq;
#pragma unroll
        for (int ai = 0; ai < 2; ++ai)
#pragma unroll
            for (int m = 0; m < 4; ++m) { const int row = row0 + ai * HALF + m * 16;
#pragma unroll
                for (int bj = 0; bj < 2; ++bj) { const f32x4 g = acc[ai][bj][m][0], up = acc[ai][bj][m][1]; f32x4 h;
#pragma unroll
                    for (int j = 0; j < 4; ++j) h[j] = g[j] * __builtin_amdgcn_rcpf(1.0f + __builtin_amdgcn_exp2f(-1.4426950408889634f * g[j])) * up[j];
                    u32x2 w; w.x = cvt_pk_bf16(h[0], h[1]); w.y = cvt_pk_bf16(h[2], h[3]);
                    *(u32x2*)(HE + (size_t)row * FFE + hc0 + 64 * bj) = w; } }
    }
};
struct EpiMoe2 {
    static constexpr bool PERM = true;
    bf16_t* Y; const LAS float* xl; const LAS int* tab;
    DI void operator()(const f32x4 (&acc)[2][2][4][2], const Unit& u, int wr, int wc, int fr, int fq) const {
        const int cnt = tab[17 + u.e], col0 = u.pn * BM + wc * 32 + 8 * fq;
        int ent[8]; float gw[8];
#pragma unroll
        for (int i = 0; i < 8; ++i) { const int rl = u.par * 512 + (i >> 2) * HALF + wr * 64 + (i & 3) * 16 + fr; ent[i] = __float_as_int(xl[rl]); gw[i] = xl[256 + rl]; }
#pragma unroll
        for (int i = 0; i < 8; ++i) { const int ai = i >> 2, m = i & 3, r = u.rb + ai * HALF + wr * 64 + m * 16 + fr;
            if (r < cnt) { bf16_t* dst = Y + ((size_t)(ent[i] & 1) * NTOK + (size_t)(ent[i] >> 1)) * DM + col0;
#pragma unroll
                for (int bj = 0; bj < 2; ++bj) *(u32x4*)(dst + bj * HALF) = pack8(acc[ai][bj][m][0] * gw[i], acc[ai][bj][m][1] * gw[i]); } }
    }
};
}

struct Args { const float* in[13]; float* out; unsigned char* ws; int ph_lo, ph_hi; };
struct Frame {
    LAS unsigned char* lds; int tid, lane, wave, G, bid;
    unsigned char* ws; unsigned* ctl;
};

DI int src_col(int mode, int p) {
    if (mode == 0) return p;
    if (mode == 1) {
        if (p < 2048) { const int hd = p >> 7, pp = p & 127; return (hd << 7) + ((pp >> 3) << 2) + (pp & 3) + 64 * ((pp >> 2) & 1); }
        if (p < 3072) return p;
        if (p < 3648) { const int q = p - 3072, hd = q >> 6, pp = q & 63; return 3072 + (hd << 6) + ((pp >> 3) << 2) + (pp & 3) + 32 * ((pp >> 2) & 1); }
        if (p < AIN) return p;
        return -1; }
    return ((p >> 3) << 2) + (p & 3);
}
DI float dpp_wave_max_f(float v);
DI float quant_row(const f32x4 (&v)[4], int lane, signed char* dst, float* sdst) {
    float mx = 0.f;
#pragma unroll
    for (int i = 0; i < 4; ++i) mx = fmaxf(mx, fmaxf(fmaxf(fabsf(v[i][0]), fabsf(v[i][1])), fmaxf(fabsf(v[i][2]), fabsf(v[i][3]))));
    mx = dpp_wave_max_f(mx);
    const float inv = mx > 0.f ? 127.0f / mx : 0.f;
#pragma unroll
    for (int i = 0; i < 4; ++i) { const int q0 = (int)__builtin_rintf(v[i][0] * inv), q1 = (int)__builtin_rintf(v[i][1] * inv), q2 = (int)__builtin_rintf(v[i][2] * inv), q3 = (int)__builtin_rintf(v[i][3] * inv);
        *(int*)(dst + 4 * lane + 256 * i) = (q0 & 0xFF) | ((q1 & 0xFF) << 8) | ((q2 & 0xFF) << 16) | (q3 << 24); }
    if (lane == 0) *sdst = mx * (1.0f / 127.0f);
    return mx * (1.0f / 127.0f);
}
DI void wq8_unit(const Frame& F, const float* W0, const float* W2, int ldw, int mode, signed char* Bt8, float* sB, int n0) {
    LAS float* T = (LAS float*)F.lds;
    LAS unsigned* cmax = (LAS unsigned*)(F.lds + 1024 * 33 * 4);
    const int n4 = (F.tid & 7) * 4, src = src_col(mode, n0 + n4); const float* W = (mode == 2 && (((n0 + n4) >> 2) & 1)) ? W2 : W0;
    if (F.tid < 32) cmax[F.tid] = 0u;
    __syncthreads();
    f32x4 m4 = {0.f, 0.f, 0.f, 0.f}, vv[16];
#pragma unroll
    for (int i = 0; i < 16; ++i) vv[i] = src >= 0 ? *(const f32x4*)(W + (size_t)((F.tid >> 3) + 64 * i) * ldw + src) : (f32x4){0.f, 0.f, 0.f, 0.f};
#pragma unroll
    for (int i = 0; i < 16; ++i) { const int kk = (F.tid >> 3) + 64 * i; const f32x4 v = vv[i];
        m4[0] = fmaxf(m4[0], fabsf(v[0])); m4[1] = fmaxf(m4[1], fabsf(v[1])); m4[2] = fmaxf(m4[2], fabsf(v[2])); m4[3] = fmaxf(m4[3], fabsf(v[3]));
        T[kk * 33 + n4] = v[0]; T[kk * 33 + n4 + 1] = v[1]; T[kk * 33 + n4 + 2] = v[2]; T[kk * 33 + n4 + 3] = v[3]; }
#pragma unroll
    for (int j = 0; j < 4; ++j) { float m = m4[j];
        m = fmaxf(m, __uint_as_float((unsigned)__builtin_amdgcn_update_dpp(0, (int)__float_as_uint(m), 0x128, 0xf, 0xf, false)));
        m = fmaxf(m, __shfl_xor(m, 16)); m = fmaxf(m, __shfl_xor(m, 32)); m4[j] = m; }
    if (F.lane < 8) {
#pragma unroll
        for (int j = 0; j < 4; ++j) __hip_atomic_fetch_max(cmax + n4 + j, __float_as_uint(m4[j]), __ATOMIC_RELAXED, __HIP_MEMORY_SCOPE_WORKGROUP); }
    __syncthreads();
    if (F.tid < 32) sB[n0 + F.tid] = __uint_as_float(cmax[F.tid]) * (1.0f / 127.0f);
    { const int nl = F.tid & 31, kb = (F.tid >> 5) * 64; const float mx = __uint_as_float(cmax[nl]), inv = mx > 0.f ? 127.0f / mx : 0.f;
#pragma unroll 2
      for (int k16 = 0; k16 < 64; k16 += 16) { int q[16];
#pragma unroll
          for (int j = 0; j < 16; ++j) q[j] = (int)__builtin_rintf(T[(kb + k16 + j) * 33 + nl] * inv);
          u32x4 w;
#pragma unroll
          for (int d = 0; d < 4; ++d) w[d] = (unsigned)((q[4 * d] & 0xFF) | ((q[4 * d + 1] & 0xFF) << 8) | ((q[4 * d + 2] & 0xFF) << 16) | (q[4 * d + 3] << 24));
          *(u32x4*)(Bt8 + (size_t)(n0 + nl) * DM + kb + k16) = w; } }
    __syncthreads();
}
constexpr int T_SQ = 256, T_GU = 512 / 32, T_DN = 64, U_IN = NIN / 32, U_Q = DM / 32, U_KV = 2 * DM / 32, HO1 = U_IN, HO2 = HO1 + U_Q, HO3 = HO2 + U_KV;
DI void heavy_job(const Frame& F, const Args& a, int tile) {
    float* SBIN = (float*)(F.ws + WS_SCL + SCL_SBIN); float* SBQKV = (float*)(F.ws + WS_SCL + SCL_SBQKV);
    if (tile < HO1) wq8_unit(F, a.in[1], nullptr, AIN, 1, (signed char*)(F.ws + WS_WAIN), SBIN, tile * 32);
    else if (tile < HO2) wq8_unit(F, a.in[3], nullptr, DM, 0, (signed char*)(F.ws + WS_WBQKV), SBQKV, (tile - HO1) * 32);
    else if (tile < HO3) wq8_unit(F, a.in[4], nullptr, 2 * DM, 0, (signed char*)(F.ws + WS_WBQKV) + (size_t)DM * DM, SBQKV + DM, (tile - HO2) * 32);
    else { const int t = tile - HO3, le = t >> 4, tt = t & 15;
        wq8_unit(F, a.in[8] + (size_t)le * DM * FFE, a.in[9] + (size_t)le * DM * FFE, FFE, 2, (signed char*)(F.ws + WS_WGU) + (size_t)le * 512 * DM, (float*)(F.ws + WS_SCL + SCL_SBGU) + le * 512, tt * 32); }
}
DI void light_group(const Frame& F, const Args& a, int L0, int L1, int L2, int L3) {
    LAS float* T = (LAS float*)F.lds;
    const float* Wp[4]; bf16_t* Bp[4]; int ldw[4], Kk[4], k0[4], n0[4];
#pragma unroll
    for (int u = 0; u < 4; ++u) { const int L = u == 0 ? L0 : u == 1 ? L1 : u == 2 ? L2 : L3;
        if (L < T_SQ) { Wp[u] = a.in[2]; Bp[u] = (bf16_t*)(F.ws + WS_WAOUT); ldw[u] = DM; Kk[u] = DM; k0[u] = (L & 15) * 64; n0[u] = (L >> 4) * 64; }
        else if (L < 2 * T_SQ) { const int t = L - T_SQ; Wp[u] = a.in[5]; Bp[u] = (bf16_t*)(F.ws + WS_WBOUT); ldw[u] = DM; Kk[u] = DM; k0[u] = (t & 15) * 64; n0[u] = (t >> 4) * 64; }
        else { const int t = L - 2 * T_SQ, le = t >> 6, tt = t & 63; Wp[u] = a.in[10] + (size_t)le * FFE * DM; Bp[u] = (bf16_t*)(F.ws + WS_WD) + (size_t)le * DM * FFE; ldw[u] = DM; Kk[u] = FFE; k0[u] = (tt & 3) * 64; n0[u] = (tt >> 2) * 64; } }
    f32x4 v[4][2];
    { const int n4 = (F.tid & 15) * 4;
#pragma unroll
      for (int u = 0; u < 4; ++u)
#pragma unroll
          for (int i = 0; i < 2; ++i) v[u][i] = *(const f32x4*)(Wp[u] + (size_t)(k0[u] + (F.tid >> 4) + 32 * i) * ldw[u] + n0[u] + n4);
#pragma unroll
      for (int u = 0; u < 4; ++u)
#pragma unroll
          for (int i = 0; i < 2; ++i) { const int kl = (F.tid >> 4) + 32 * i; LAS float* Tu = T + u * 64 * 65;
              Tu[kl * 65 + n4] = v[u][i][0]; Tu[kl * 65 + n4 + 1] = v[u][i][1]; Tu[kl * 65 + n4 + 2] = v[u][i][2]; Tu[kl * 65 + n4 + 3] = v[u][i][3]; } }
    __syncthreads();
    { const int nl = F.tid >> 3, kl = (F.tid & 7) * 8;
#pragma unroll
      for (int u = 0; u < 4; ++u) { const LAS float* Tu = T + u * 64 * 65; float w8[8];
#pragma unroll
          for (int j = 0; j < 8; ++j) w8[j] = Tu[(kl + j) * 65 + nl];
          u32x4 w; w.x = cvt_pk_bf16(w8[0], w8[1]); w.y = cvt_pk_bf16(w8[2], w8[3]); w.z = cvt_pk_bf16(w8[4], w8[5]); w.w = cvt_pk_bf16(w8[6], w8[7]);
          *(u32x4*)(Bp[u] + (size_t)(n0[u] + nl) * Kk[u] + k0[u] + kl) = w; } }
    __syncthreads();
}
constexpr int NHV = U_IN + U_Q + U_KV + 32 * T_GU, NLG = (2 * T_SQ + 32 * T_DN) / 4;
DI void bg_jobs(const Frame& F, const Args& a, int hlo, int hhi, int glo, int ghi, int rank, int n) {
    for (int h = hlo + rank; h < hhi; h += n)
        heavy_job(F, a, h < U_IN ? h : h < U_IN + 16 * T_GU ? HO3 + (h - U_IN) : h < U_IN + 16 * T_GU + U_Q + U_KV ? HO1 + (h - U_IN - 16 * T_GU) : HO3 + 16 * T_GU + (h - U_IN - 16 * T_GU - U_Q - U_KV));
    for (int g = glo + (n - 1 - rank); g < ghi; g += n) { int L[4];
#pragma unroll
        for (int u = 0; u < 4; ++u) { const int q = 4 * g + u;
            L[u] = q < T_SQ ? q : q < T_SQ + 16 * T_DN ? 2 * T_SQ + (q - T_SQ) : q < 2 * T_SQ + 16 * T_DN ? T_SQ + (q - T_SQ - 16 * T_DN) : 2 * T_SQ + 16 * T_DN + (q - 2 * T_SQ - 16 * T_DN); }
        light_group(F, a, L[0], L[1], L[2], L[3]); }
}
constexpr int BG_H0 = 256, BG_H1 = U_IN + 16 * T_GU, BG_H2 = BG_H1 + 240, BG_G0 = 64, BG_G1 = 320, BG_G2 = 560;
DI void idle_rank(int total, int G, int c, int& rank, int& n) { const int r = total % G; if (r == 0) { rank = c; n = G; } else { rank = c - r; n = G - r; } }
DI void p0_prologue(const Frame& F, const Args& a) {
    const size_t gtid = (size_t)F.bid * 512 + F.tid, gthreads = (size_t)F.G * 512;
    { signed char* xq = (signed char*)(F.ws + WS_XB8); float* SA = (float*)(F.ws + WS_SCL + SCL_SA);
      const int gw = F.bid * 8 + F.wave, nw = F.G * 8, lane = F.lane;
      f32x4 rr[4][4];
#define XQ_LOAD(slot, r_) do { const int r2_ = (r_) < NTOK ? (r_) : gw; _Pragma("unroll") for (int i = 0; i < 4; ++i) rr[slot][i] = *(const f32x4*)(a.in[0] + (size_t)r2_ * DM + 4 * lane + 256 * i); } while (0)
      XQ_LOAD(0, gw); XQ_LOAD(1, gw + nw); XQ_LOAD(2, gw + 2 * nw);
      for (int row = gw; row < NTOK; row += 4 * nw) {
          XQ_LOAD(3, row + 3 * nw);
          quant_row(rr[0], lane, xq + (size_t)row * DM, SA + row);
          XQ_LOAD(0, row + 4 * nw);
          if (row + nw < NTOK) quant_row(rr[1], lane, xq + (size_t)(row + nw) * DM, SA + row + nw);
          XQ_LOAD(1, row + 5 * nw);
          if (row + 2 * nw < NTOK) quant_row(rr[2], lane, xq + (size_t)(row + 2 * nw) * DM, SA + row + 2 * nw);
          XQ_LOAD(2, row + 6 * nw);
          if (row + 3 * nw < NTOK) quant_row(rr[3], lane, xq + (size_t)(row + 3 * nw) * DM, SA + row + 3 * nw);
      }
#undef XQ_LOAD
    }
    bg_jobs(F, a, 0, BG_H0, 0, BG_G0, F.bid, F.G);
}

constexpr int SCP = 2064;
DI unsigned ord_key(float v) { const unsigned b = __float_as_uint(v); return b ^ (((int)b >> 31) | 0x80000000u); }
DI unsigned popc64(u64 m) { return (unsigned)__builtin_popcountll(m); }

#define DPPF(x, ctrl) __uint_as_float(__builtin_amdgcn_update_dpp(0u, __float_as_uint(x), ctrl, 0xf, 0xf, true))
DI float dpp_wave_max(float v) {
    v = fmaxf(v, DPPF(v, 0xB1)); v = fmaxf(v, DPPF(v, 0x4E)); v = fmaxf(v, DPPF(v, 0x141)); v = fmaxf(v, DPPF(v, 0x140));
    const float r0 = __uint_as_float(__builtin_amdgcn_readlane(__float_as_uint(v), 0)), r1 = __uint_as_float(__builtin_amdgcn_readlane(__float_as_uint(v), 16));
    const float r2 = __uint_as_float(__builtin_amdgcn_readlane(__float_as_uint(v), 32)), r3 = __uint_as_float(__builtin_amdgcn_readlane(__float_as_uint(v), 48));
    return fmaxf(fmaxf(r0, r1), fmaxf(r2, r3));
}
DI float dpp_wave_max_f(float v) { return dpp_wave_max(v); }
DI float dpp_wave_min(float v) {
    v = fminf(v, DPPF(v, 0xB1)); v = fminf(v, DPPF(v, 0x4E)); v = fminf(v, DPPF(v, 0x141)); v = fminf(v, DPPF(v, 0x140));
    const float r0 = __uint_as_float(__builtin_amdgcn_readlane(__float_as_uint(v), 0)), r1 = __uint_as_float(__builtin_amdgcn_readlane(__float_as_uint(v), 16));
    const float r2 = __uint_as_float(__builtin_amdgcn_readlane(__float_as_uint(v), 32)), r3 = __uint_as_float(__builtin_amdgcn_readlane(__float_as_uint(v), 48));
    return fminf(fminf(r0, r1), fminf(r2, r3));
}
DI unsigned dpp_scan_add(unsigned v) {
    v += (unsigned)__builtin_amdgcn_update_dpp(0, (int)v, 0x111, 0xf, 0xf, false);
    v += (unsigned)__builtin_amdgcn_update_dpp(0, (int)v, 0x112, 0xf, 0xf, false);
    v += (unsigned)__builtin_amdgcn_update_dpp(0, (int)v, 0x114, 0xf, 0xf, false);
    v += (unsigned)__builtin_amdgcn_update_dpp(0, (int)v, 0x118, 0xf, 0xf, false);
    v += (unsigned)__builtin_amdgcn_update_dpp(0, (int)v, 0x142, 0xa, 0xf, false);
    v += (unsigned)__builtin_amdgcn_update_dpp(0, (int)v, 0x143, 0xc, 0xf, false);
    return v;
}
DI void select_topk(const LAS float* srow, int nj, LAS unsigned* hist, LAS unsigned* cand, LAS unsigned* ccnt, int lane, u64* mrow) {
    const LAS float* sp = srow + lane;
    float v[32];
#pragma unroll
    for (int g = 0; g < 4; ++g) { if (8 * g < nj) {
#pragma unroll
        for (int j = 8 * g; j < 8 * g + 8; ++j) v[j] = sp[j * 64]; } else {
#pragma unroll
        for (int j = 8 * g; j < 8 * g + 8; ++j) v[j] = -__builtin_inff(); } }
    int njv = nj; asm volatile("" : "+v"(njv));
#pragma unroll
    for (int j = 0; j < 32; ++j) v[j] = (j < njv) ? v[j] : -__builtin_inff();
    float vmx = v[0], vmn = v[0];
#pragma unroll
    for (int j = 1; j < 32; ++j) { vmx = fmaxf(vmx, v[j]); vmn = fminf(vmn, v[j] > -3.0e38f ? v[j] : vmn); }
    vmx = dpp_wave_max(vmx); vmn = dpp_wave_min(vmn);
    unsigned T = 0u, n_gt = 0u, n_ge = 0u;
    bool fast = false;
    if (vmx > vmn) {
        const float scale = 256.0f / (vmx - vmn);
        *(LAS u32x4*)(hist + 4 * lane) = (u32x4){0u, 0u, 0u, 0u};
        if (lane == 0) *ccnt = 0u;
        LDS_WAIT();
#pragma unroll
        for (int j = 0; j < 32; ++j) if (j < njv) { int b = (int)((v[j] - vmn) * scale); b = b > 255 ? 255 : b; __hip_atomic_fetch_add(hist + b, 1u, __ATOMIC_RELAXED, __HIP_MEMORY_SCOPE_WORKGROUP); }
        LDS_WAIT();
        const u32x4 h4 = *(const LAS u32x4*)(hist + 4 * (63 - lane));
        const unsigned c4 = h4.x + h4.y + h4.z + h4.w;
        const unsigned P = dpp_scan_add(c4);
        const u64 bal = __ballot(P >= (unsigned)TOPK);
        const int Ls = __builtin_ctzll(bal);
        const unsigned P_L = __builtin_amdgcn_readlane(P, Ls), c_L = __builtin_amdgcn_readlane(c4, Ls);
        const unsigned hb0 = __builtin_amdgcn_readlane(h4.x, Ls), hb1 = __builtin_amdgcn_readlane(h4.y, Ls), hb2 = __builtin_amdgcn_readlane(h4.z, Ls), hb3 = __builtin_amdgcn_readlane(h4.w, Ls);
        const int bin0 = 4 * (63 - Ls);
        unsigned cum = P_L - c_L; int bstar; unsigned mc;
        if (cum + hb3 >= (unsigned)TOPK) { bstar = bin0 + 3; mc = hb3; }
        else { cum += hb3; if (cum + hb2 >= (unsigned)TOPK) { bstar = bin0 + 2; mc = hb2; }
        else { cum += hb2; if (cum + hb1 >= (unsigned)TOPK) { bstar = bin0 + 1; mc = hb1; }
        else { cum += hb1; bstar = bin0; mc = hb0; } } }
        if (mc <= 256u) {
            fast = true;
            unsigned cbase = 0;
#pragma unroll
            for (int j = 0; j < 32; ++j) { int b = (int)((v[j] - vmn) * scale); b = b > 255 ? 255 : b;
                const u64 m = __ballot(b == bstar);
                if (m) { if (b == bstar) cand[(cbase + __builtin_amdgcn_mbcnt_hi((unsigned)(m >> 32), __builtin_amdgcn_mbcnt_lo((unsigned)m, 0u))) & 255u] = ord_key(v[j]); cbase += popc64(m); } }
            LDS_WAIT();
            const unsigned r = (unsigned)TOPK - cum;
            if (mc <= 64u) {
                const unsigned cu = ((unsigned)lane < mc) ? cand[lane] : 0u;
#pragma unroll 1
                for (int bit = 31; bit >= 0; --bit) { const unsigned ct = T | (1u << bit); if (popc64(__ballot(cu >= ct)) >= r) T = ct; }
                n_gt = cum + popc64(__ballot(cu > T)); n_ge = cum + popc64(__ballot(cu >= T));
            } else {
                unsigned cu[4];
#pragma unroll
                for (int ch = 0; ch < 4; ++ch) cu[ch] = ((unsigned)(lane + 64 * ch) < mc) ? cand[lane + 64 * ch] : 0u;
#pragma unroll 1
                for (int bit = 31; bit >= 0; --bit) { const unsigned ct = T | (1u << bit); unsigned cnt = 0;
#pragma unroll
                    for (int ch = 0; ch < 4; ++ch) cnt += popc64(__ballot(cu[ch] >= ct));
                    if (cnt >= r) T = ct; }
                unsigned cge = 0, cgt = 0;
#pragma unroll
                for (int ch = 0; ch < 4; ++ch) { cge += popc64(__ballot(cu[ch] >= T)); cgt += popc64(__ballot(cu[ch] > T)); }
                n_gt = cum + cgt; n_ge = cum + cge;
            }
        }
    }
    if (!fast) {
#pragma unroll 1
        for (int bit = 31; bit >= 0; --bit) { const unsigned ct = T | (1u << bit); unsigned cnt = 0;
#pragma unroll
            for (int j = 0; j < 32; ++j) cnt += popc64(__ballot(j < njv && ord_key(v[j]) >= ct));
            if (cnt >= (unsigned)TOPK) T = ct; }
        n_gt = 0; n_ge = 0;
#pragma unroll
        for (int j = 0; j < 32; ++j) { const unsigned u = ord_key(v[j]); n_ge += popc64(__ballot(j < njv && u >= T)); n_gt += popc64(__ballot(j < njv && u > T)); }
    }
    const unsigned mneed = (unsigned)TOPK - n_gt, n_eq = n_ge - n_gt;
    u64 myword = 0ull;
    if (n_eq == mneed) {
#pragma unroll
        for (int j = 0; j < 32; ++j) { const u64 w = __ballot(ord_key(v[j]) >= T); myword = (lane == j) ? w : myword; }
    } else {
        unsigned running = 0; const u64 ltmask = (1ull << lane) - 1ull;
#pragma unroll
        for (int j = 0; j < 32; ++j) { const unsigned u = ord_key(v[j]); const u64 eqm = __ballot(u == T); const unsigned pre = running + popc64(eqm & ltmask);
            const u64 w = __ballot(u > T || (u == T && pre < mneed)); running += popc64(eqm); myword = (lane == j) ? w : myword; }
    }
    if (lane < 32) mrow[lane] = myword;
}

DI void indexer_phase(const Frame& F) {
    const bf16_t* QI = (const bf16_t*)(F.ws + WS_HF + HF_QI); const bf16_t* KI = (const bf16_t*)(F.ws + WS_HF + HF_KI);
    const float* WI = (const float*)(F.ws + WS_HF + HF_WI); u64* MASK = (u64*)(F.ws + WS_HF + HF_MASK);
    LAS float* sc = (LAS float*)F.lds;
    LAS unsigned* hist = (LAS unsigned*)(F.lds + 16 * SCP * 4) + F.wave * 256;
    LAS unsigned* cand = (LAS unsigned*)(F.lds + 16 * SCP * 4 + 8192) + F.wave * 256;
    LAS unsigned* ccnt = (LAS unsigned*)(F.lds + 16 * SCP * 4 + 16384) + F.wave * 16;
    const int lane = F.lane, fr = lane & 15, fq = lane >> 4;
    constexpr int NITEM = NB * 32 * 4;
    bf16x8 qa[8][2]; f32x4 wq[4][2];
#define IDX_ITEM(i_, c_, b_, tok0_) const int L_##i_ = (i_) * F.G + (((i_) & 1) ? (F.G - 1 - F.bid) : F.bid); const int c_ = 31 - L_##i_ / 64, b_ = (L_##i_ % 64) >> 2, tok0_ = b_ * SEQ + c_ * 64 + ((L_##i_ % 64) & 3) * 16
#define IDX_LOADQ(tok0_) do { _Pragma("unroll") for (int h = 0; h < 8; ++h) _Pragma("unroll") for (int ks = 0; ks < 2; ++ks) qa[h][ks] = *(const bf16x8*)(QI + (size_t)((tok0_) + fr) * 512 + h * 64 + ks * 32 + fq * 8); \
        _Pragma("unroll") for (int j = 0; j < 4; ++j) { wq[j][0] = *(const f32x4*)(WI + (size_t)((tok0_) + 4 * fq + j) * 8); wq[j][1] = *(const f32x4*)(WI + (size_t)((tok0_) + 4 * fq + j) * 8 + 4); } } while (0)
    { IDX_ITEM(0, c0, b0, t0); (void)b0; if (F.bid < NITEM && c0 >= 4) IDX_LOADQ(t0); }
    for (int i = 0;; ++i) {
        const int L = i * F.G + ((i & 1) ? (F.G - 1 - F.bid) : F.bid); if (L >= NITEM) break;
        const int c = 31 - L / 64, rr = L % 64, b = rr >> 2, g4 = rr & 3;
        const int tok0 = b * SEQ + c * 64 + g4 * 16, nk = 64 * (c + 1);
        const int Ln = (i + 1) * F.G + (((i + 1) & 1) ? (F.G - 1 - F.bid) : F.bid);
        const int cn = 31 - Ln / 64, tokn = ((Ln % 64) >> 2) * SEQ + cn * 64 + ((Ln % 64) & 3) * 16; const bool pre = Ln < NITEM && cn >= 4;
        if (c >= 4) {
            const int ntile = nk / 16, ntw = (ntile - F.wave + 7) >> 3;
            const bf16_t* kbase = KI + (size_t)(b * SEQ + fr) * 64 + fq * 8;
            bf16x8 kA[4][2], kB[4][2];
#define IDX_LOAD(dst, i0) do { _Pragma("unroll") for (int u = 0; u < 4; ++u) { int i_ = (i0) + u; i_ = i_ < ntw ? i_ : ntw - 1; const bf16_t* kp = kbase + (size_t)(F.wave + 8 * i_) * 16 * 64; \
                dst[u][0] = *(const bf16x8*)kp; dst[u][1] = *(const bf16x8*)(kp + 32); } } while (0)
#define IDX_COMP(srcb, i0) do { _Pragma("unroll") for (int u = 0; u < 4; ++u) { const int i_ = (i0) + u; if (i_ < ntw) { const int kt = F.wave + 8 * i_; f32x4 s = {0.f, 0.f, 0.f, 0.f}; \
                _Pragma("unroll") for (int h = 0; h < 8; ++h) { f32x4 acc = {0.f, 0.f, 0.f, 0.f}; \
                    acc = __builtin_amdgcn_mfma_f32_16x16x32_bf16(qa[h][0], srcb[u][0], acc, 0, 0, 0); \
                    acc = __builtin_amdgcn_mfma_f32_16x16x32_bf16(qa[h][1], srcb[u][1], acc, 0, 0, 0); \
                    _Pragma("unroll") for (int j = 0; j < 4; ++j) s[j] += wq[j][h >> 2][h & 3] * fmaxf(acc[j], 0.f); } \
                _Pragma("unroll") for (int j = 0; j < 4; ++j) sc[(4 * fq + j) * SCP + kt * 16 + fr] = s[j]; } } } while (0)
            IDX_LOAD(kA, 0);
            for (int i0 = 0; i0 < ntw; i0 += 8) {
                IDX_LOAD(kB, i0 + 4);
                IDX_COMP(kA, i0);
                IDX_LOAD(kA, i0 + 8);
                IDX_COMP(kB, i0 + 4);
            }
#undef IDX_LOAD
#undef IDX_COMP
            __syncthreads();
            if (pre) IDX_LOADQ(tokn);
#pragma unroll 1
            for (int qq = 0; qq < 2; ++qq) { const int ql = 2 * F.wave + qq;
                select_topk(sc + ql * SCP, c + 1, hist, cand, ccnt, lane, MASK + (size_t)(tok0 + ql) * 32); }
            __syncthreads();
        } else {
            const int q = F.tid >> 5, w = F.tid & 31;
            MASK[(size_t)(tok0 + q) * 32 + w] = (w <= c) ? ~0ull : 0ull;
            if (pre) IDX_LOADQ(tokn);
        }
    }
#undef IDX_ITEM
#undef IDX_LOADQ
}

namespace att {
constexpr float SCALE = 0.08838834764831845f;
constexpr float THR = 8.f;
constexpr int NW = 8, QBLK = 32, KVBLK = 64, QB = NW * QBLK;
constexpr int SHM_V = KVBLK * HD * 2, SHM_K = KVBLK * HD * 2;
#define KSWZ(row, colB) ((row) * 256 + ((colB) ^ (((row) & 7) << 4)))
#define SBAR() __builtin_amdgcn_sched_barrier(0)
DI int v_st(int k, int c) { const int kk = (k & ~0xC) | ((k & 4) << 1) | ((k & 8) >> 1); return ((kk >> 3) * 4 + (c >> 5)) * 512 + ((kk & 7) * 32 + (c & 31)) * 2; }
DI int v_rd_base(int lane) { return ((lane & 3) << 3) | (((lane >> 2) & 3) << 6) | (((lane >> 4) & 1) << 5) | (((lane >> 5) & 1) << 8); }
constexpr int v_rd_off(int d0, int ks, int half) { return d0 * 512 + ks * 4096 + half * 2048; }
DI int crow(int r, int hi) { return (r & 3) + 8 * (r >> 2) + 4 * hi; }

DI void partialSM(f32x16& p0, f32x16& p1, float& m_reg, float& mn, float& alpha) {
    float pmax = p0[0];
#pragma unroll
    for (int r = 1; r < 16; ++r) pmax = fmaxf(pmax, p0[r]);
#pragma unroll
    for (int r = 0; r < 16; ++r) pmax = fmaxf(pmax, p1[r]);
    { auto rr = __builtin_amdgcn_permlane32_swap(__float_as_uint(pmax), __float_as_uint(pmax), false, false);
      pmax = fmaxf(__uint_as_float(rr[0]), __uint_as_float(rr[1])); }
    constexpr float C2 = 1.4426950408889634f * SCALE;
    if (__builtin_expect(__all((pmax - m_reg) * SCALE <= THR), 1)) { mn = m_reg; alpha = 1.f; }
    else { mn = fmaxf(m_reg, pmax); alpha = __builtin_amdgcn_exp2f((m_reg - mn) * C2); m_reg = mn; }
    const float mnL = -mn * C2;
#pragma unroll
    for (int r = 0; r < 16; ++r) p0[r] = fmaf(p0[r], C2, mnL);
#pragma unroll
    for (int r = 0; r < 16; ++r) p1[r] = fmaf(p1[r], C2, mnL);
#pragma unroll
    for (int r = 0; r < 16; ++r) p0[r] = __builtin_amdgcn_exp2f(p0[r]);
}
#define PK4(P, B_, OUT) do { unsigned a0 = cvt_pk_bf16(P[B_+0], P[B_+1]), a1 = cvt_pk_bf16(P[B_+2], P[B_+3]);                          \
        unsigned b0 = cvt_pk_bf16(P[B_+4], P[B_+5]), b1 = cvt_pk_bf16(P[B_+6], P[B_+7]);                                             \
        auto r0 = __builtin_amdgcn_permlane32_swap(a0, b0, false, false); auto r1 = __builtin_amdgcn_permlane32_swap(a1, b1, false, false); \
        u32x4 w = {r0[0], r1[0], r0[1], r1[1]}; OUT = *reinterpret_cast<bf16x8*>(&w); } while (0)
DI void finishSM(f32x16& p0, f32x16& p1, float alpha, float& l_reg, bf16x8& pa0, bf16x8& pa1, bf16x8& pa2, bf16x8& pa3) {
#pragma unroll
    for (int r = 0; r < 16; ++r) p1[r] = __builtin_amdgcn_exp2f(p1[r]);
    float ps = 0;
#pragma unroll
    for (int r = 0; r < 16; ++r) ps += p0[r];
#pragma unroll
    for (int r = 0; r < 16; ++r) ps += p1[r];
    { auto rr = __builtin_amdgcn_permlane32_swap(__float_as_uint(ps), __float_as_uint(ps), false, false);
      ps = __uint_as_float(rr[0]) + __uint_as_float(rr[1]); }
    l_reg = l_reg * alpha + ps;
    PK4(p0, 0, pa0); PK4(p0, 8, pa1); PK4(p1, 0, pa2); PK4(p1, 8, pa3);
}
DI void packP(const f32x16& p0, const f32x16& p1, bf16x8& pa0, bf16x8& pa1, bf16x8& pa2, bf16x8& pa3) {
    PK4(p0, 0, pa0); PK4(p0, 8, pa1); PK4(p1, 0, pa2); PK4(p1, 8, pa3);
}
template <int KB>
DI void qkt(f32x16& p0, f32x16& p1, const LAS char* K_lds, int r32, int hi, const bf16x8* qr) {
    p0 = f32x16{}; p1 = f32x16{};
    const LAS char* kb[4];
#pragma unroll
    for (int dd = 0; dd < 4; ++dd) kb[dd] = K_lds + KB * SHM_K + KSWZ(r32, (dd * 16 + hi * 8) * 2);
#pragma unroll
    for (int d0 = 0; d0 < 8; ++d0) { const LAS char* a = kb[d0 & 3] + (d0 >> 2) * 128;
        bf16x8 b0 = *reinterpret_cast<const LAS bf16x8*>(a);
        bf16x8 b1 = *reinterpret_cast<const LAS bf16x8*>(a + 32 * 256);
        p0 = __builtin_amdgcn_mfma_f32_32x32x16_bf16(b0, qr[d0], p0, 0, 0, 0);
        p1 = __builtin_amdgcn_mfma_f32_32x32x16_bf16(b1, qr[d0], p1, 0, 0, 0); }
}
template <int VB>
DI void pv_tile(f32x16* o, int vb0, bf16x8 pa0, bf16x8 pa1, bf16x8 pa2, bf16x8 pa3) {
#define TRRD(dst, off) asm volatile("ds_read_b64_tr_b16 %0, %1 offset:%2" : "=&v"(dst) : "v"(vb0), "i"(off) : "memory")
#define PV_D0(d0) do { s16x4 l0, l1, l2, l3, h0, h1, h2, h3; constexpr int b_ = VB * SHM_V + v_rd_off(d0, 0, 0);   \
        TRRD(l0, b_); TRRD(h0, b_ + 2048); TRRD(l1, b_ + 4096); TRRD(h1, b_ + 6144); TRRD(l2, b_ + 8192); TRRD(h2, b_ + 10240); TRRD(l3, b_ + 12288); TRRD(h3, b_ + 14336); \
        asm volatile("s_waitcnt lgkmcnt(0)" ::: "memory"); SBAR();   \
        o[d0] = __builtin_amdgcn_mfma_f32_32x32x16_bf16(pa0, (bf16x8){l0[0], l0[1], l0[2], l0[3], h0[0], h0[1], h0[2], h0[3]}, o[d0], 0, 0, 0);   \
        o[d0] = __builtin_amdgcn_mfma_f32_32x32x16_bf16(pa1, (bf16x8){l1[0], l1[1], l1[2], l1[3], h1[0], h1[1], h1[2], h1[3]}, o[d0], 0, 0, 0);   \
        o[d0] = __builtin_amdgcn_mfma_f32_32x32x16_bf16(pa2, (bf16x8){l2[0], l2[1], l2[2], l2[3], h2[0], h2[1], h2[2], h2[3]}, o[d0], 0, 0, 0);   \
        o[d0] = __builtin_amdgcn_mfma_f32_32x32x16_bf16(pa3, (bf16x8){l3[0], l3[1], l3[2], l3[3], h3[0], h3[1], h3[2], h3[3]}, o[d0], 0, 0, 0); } while (0)
    PV_D0(0); PV_D0(1); PV_D0(2); PV_D0(3);
#undef PV_D0
#undef TRRD
}
struct Stage { bf16x8 k0, k1, v0, v1; };
DI void sload(Stage& s, const bf16_t* Kp, const bf16_t* Vp, size_t tokbase, int k0, int sr, int hcol) {
    const size_t o0 = (tokbase + k0 + sr) * DM + hcol, o1 = o0 + (size_t)32 * DM;
    s.v0 = *(const bf16x8*)(Vp + o0); s.v1 = *(const bf16x8*)(Vp + o1); s.k0 = *(const bf16x8*)(Kp + o0); s.k1 = *(const bf16x8*)(Kp + o1);
}
DI void swrite(const Stage& s, LAS char* V_lds, LAS char* K_lds, int bf, int kws, int vst0, int vst1) {
    *(LAS bf16x8*)(V_lds + bf * SHM_V + vst0) = s.v0; *(LAS bf16x8*)(V_lds + bf * SHM_V + vst1) = s.v1;
    *(LAS bf16x8*)(K_lds + bf * SHM_K + kws) = s.k0; *(LAS bf16x8*)(K_lds + bf * SHM_K + kws + 32 * 256) = s.k1;
}
DI void store_o(const f32x16* o, const float* rli, bf16_t* Ow, int r32, int hi) {
#pragma unroll
    for (int r = 0; r < 16; ++r) { const int orow = crow(r, hi);
#pragma unroll
        for (int d0 = 0; d0 < 4; ++d0) { const float v = o[d0][r] * rli[r]; const float vn = __shfl_xor(v, 1);
            if ((r32 & 1) == 0) *(unsigned*)(Ow + (size_t)orow * DM + d0 * 32 + r32) = cvt_pk_bf16(v, vn); } }
}

DI void attnA_phase(const Frame& F) {
    const bf16_t* Q = (const bf16_t*)(F.ws + WS_R1); const bf16_t* Kt = Q + (size_t)NTOK * DM; const bf16_t* Vt = Kt + (size_t)NTOK * DM;
    bf16_t* O = (bf16_t*)(F.ws + WS_HF + 64 * MiB); const u64* MASK = (const u64*)(F.ws + WS_HF + HF_MASK);
    LAS char* V_lds = (LAS char*)F.lds; LAS char* K_lds = V_lds + 2 * SHM_V;
    const int tid = F.tid, wid = F.wave, lane = F.lane, r32 = lane & 31, hi = lane >> 5;
    LAS float* wsl = (LAS float*)(F.lds + 2 * SHM_V + 2 * SHM_K) + wid * 64; LAS float* li_l = wsl; LAS float* al_l = wsl + 32;
    const int sr = tid >> 4, sc = (tid & 15) * 8, vst0 = v_st(sr, sc), vst1 = v_st(32 + sr, sc), kws = KSWZ(sr, sc * 2);
    const int vb0 = (int)(uintptr_t)V_lds + v_rd_base(lane);
    constexpr int NITEM = NB * NH * 8;
    for (int it = F.bid; it < NITEM; it += F.G) {
        int bh, qb;
        if (F.G == 256) { const int pass = it >> 8, xcd = F.bid & 7, slot = F.bid >> 3, grp = slot >> 3, mem = slot & 7; bh = (pass * 4 + grp) * 8 + xcd; qb = (pass & 1) ? 7 - mem : mem; }
        else { bh = it >> 3; qb = it & 7; }
        const int b = bh >> 3, h = bh & 7, q0 = qb * QB, NT = 4 * (qb + 1);
        const size_t tokbase = (size_t)b * SEQ; const int hcol = h * HD + sc;
        const int qrow = q0 + wid * QBLK + r32, myc = (q0 + wid * QBLK) >> 6;
        bf16x8 qr[8];
#pragma unroll
        for (int d0 = 0; d0 < 8; ++d0) qr[d0] = *(const bf16x8*)(Q + (tokbase + qrow) * DM + h * HD + d0 * 16 + hi * 8);
        const u64* mrow = MASK + (tokbase + qrow) * 32;
        float m_reg = -1e30f, l_reg = 0.f; f32x16 o[4] = {};
        Stage st; sload(st, Kt, Vt, tokbase, 0, sr, hcol);
        u64 mw = mrow[0], mwn = mrow[1];
        asm volatile("s_waitcnt vmcnt(0)" ::: "memory");
        swrite(st, V_lds, K_lds, 0, kws, vst0, vst1);
        __syncthreads();
        f32x16 pA0, pA1, pB0, pB1; float mnA, mnB, alA = 1.f, alB = 1.f; bf16x8 pa0, pa1, pa2, pa3;
#define A_MSEL(P, M, BIT) do { const unsigned t_ = (unsigned)__builtin_amdgcn_sbfe((int)(M), (BIT), 1); P = __uint_as_float((__float_as_uint(P) & t_) | (__float_as_uint(ninf_) & ~t_)); } while (0)
#define A_MASK(P0, P1) do { const unsigned mlo = (unsigned)mw >> (4 * hi), mhi = (unsigned)(mw >> 32) >> (4 * hi); const float ninf_ = -__builtin_inff(); \
            _Pragma("unroll") for (int r = 0; r < 16; ++r) { A_MSEL(P0[r], mlo, (r & 3) + 8 * (r >> 2)); A_MSEL(P1[r], mhi, (r & 3) + 8 * (r >> 2)); } } while (0)
#define A_RESC(a) do { if (__any((a) < 1.f)) { if (hi == 0) al_l[r32] = (a); LDS_WAIT();                              \
                _Pragma("unroll") for (int d_ = 0; d_ < 4; ++d_) _Pragma("unroll") for (int r = 0; r < 16; ++r) o[d_][r] *= al_l[crow(r, hi)]; } } while (0)
        sload(st, Kt, Vt, tokbase, KVBLK, sr, hcol);
        qkt<0>(pA0, pA1, K_lds, r32, hi, qr);
        A_MASK(pA0, pA1); partialSM(pA0, pA1, m_reg, mnA, alA);
        asm volatile("s_waitcnt vmcnt(0)" ::: "memory"); swrite(st, V_lds, K_lds, 1, kws, vst0, vst1); mw = mwn;
        __syncthreads();
#define A_HALF(PX0, PX1, mnX, alX, PY0, PY1, alY, t, KB, VB, SB) do { const bool actT = (t) <= myc, actP = (t) - 1 <= myc, more = (t) + 1 < NT; \
        if (more) mwn = mrow[(t) + 1];                                                                              \
        SBAR(); if (actT) qkt<KB>(PX0, PX1, K_lds, r32, hi, qr);                                                    \
        if (actP) { finishSM(PY0, PY1, alY, l_reg, pa0, pa1, pa2, pa3); } SBAR();                                   \
        if (more) sload(st, Kt, Vt, tokbase, ((t) + 1) * KVBLK, sr, hcol);                                          \
        SBAR(); if (actP) pv_tile<VB>(o, vb0, pa0, pa1, pa2, pa3);                                                  \
        if (actT) { A_MASK(PX0, PX1); partialSM(PX0, PX1, m_reg, mnX, alX); }                                       \
        __syncthreads();                                                                                            \
        if (more) { asm volatile("s_waitcnt vmcnt(0)" ::: "memory"); swrite(st, V_lds, K_lds, SB, kws, vst0, vst1); } \
        mw = mwn;                                                                                                   \
        if (actT) A_RESC(alX);                                                                                      \
        __syncthreads(); } while (0)
        for (int t = 1; t + 1 < NT; t += 2) {
            A_HALF(pB0, pB1, mnB, alB, pA0, pA1, alA, t, 1, 0, 0);
            A_HALF(pA0, pA1, mnA, alA, pB0, pB1, alB, t + 1, 0, 1, 1);
        }
        { const bool actT = NT - 1 <= myc, actP = NT - 2 <= myc;
          SBAR(); if (actT) qkt<1>(pB0, pB1, K_lds, r32, hi, qr);
          if (actP) { finishSM(pA0, pA1, alA, l_reg, pa0, pa1, pa2, pa3); SBAR(); pv_tile<0>(o, vb0, pa0, pa1, pa2, pa3); }
          if (actT) { A_MASK(pB0, pB1); partialSM(pB0, pB1, m_reg, mnB, alB); A_RESC(alB);
                      finishSM(pB0, pB1, alB, l_reg, pa0, pa1, pa2, pa3); SBAR(); pv_tile<1>(o, vb0, pa0, pa1, pa2, pa3); } }
#undef A_HALF
#undef A_MASK
#undef A_MSEL
#undef A_RESC
        if (hi == 0) li_l[r32] = l_reg; LDS_WAIT();
        float rli[16];
#pragma unroll
        for (int r = 0; r < 16; ++r) rli[r] = __builtin_amdgcn_rcpf(li_l[crow(r, hi)]);
        store_o(o, rli, O + (tokbase + q0 + wid * QBLK) * DM + h * HD, r32, hi);
        __syncthreads();
    }
}

DI void attnB_phase(const Frame& F) {
    const bf16_t* Q = (const bf16_t*)(F.ws + WS_R1); const bf16_t* Kt = Q + (size_t)NTOK * DM; const bf16_t* Vt = Kt + (size_t)NTOK * DM;
    bf16_t* O = (bf16_t*)(F.ws + WS_HF + 64 * MiB);
    LAS char* V_lds = (LAS char*)F.lds; LAS char* K_lds = V_lds + 3 * SHM_V;
    const int tid = F.tid, wid = F.wave, lane = F.lane, r32 = lane & 31, hi = lane >> 5;
    LAS int* flags = (LAS int*)(F.lds + 3 * SHM_V + 3 * SHM_K);
    const int vb0 = (int)(uintptr_t)V_lds + v_rd_base(lane);
    unsigned offK[2], offV[2];
#pragma unroll
    for (int i = 0; i < 2; ++i) { const int p = i * 512 + wid * 64 + lane;
        { const int row = p >> 4, ch = (p & 15) ^ (row & 7); offK[i] = (unsigned)(row * DM + ch * 8) * 2u; }
        { const int sub = p >> 5, kk = (sub >> 2) * 8 + ((p & 31) >> 2), col = (sub & 3) * 32 + (p & 3) * 8, k = (kk & ~0xC) | ((kk & 4) << 1) | ((kk & 8) >> 1); offV[i] = (unsigned)(k * DM + col) * 2u; } }
    const unsigned ldsw = (unsigned)wid * 1024u;
    constexpr float C2 = 1.4426950408889634f * SCALE;
    constexpr int NITEM = NB * NH * 8;
    for (int it = F.bid; it < NITEM; it += F.G) {
        int bh, qb;
        if (F.G == 256) { const int pass = it >> 8, xcd = F.bid & 7, slot = F.bid >> 3, grp = slot >> 3, mem = slot & 7; bh = (pass * 4 + grp) * 8 + xcd; qb = (pass & 1) ? 7 - mem : mem; }
        else { bh = it >> 3; qb = it & 7; }
        const int b = bh >> 3, h = bh & 7, q0 = qb * QB;
        const size_t tokbase = (size_t)b * SEQ;
        const int qw0 = q0 + wid * QBLK, qrow = qw0 + r32, t_hi = 4 * (qb + 1) - 1, t_w = (qw0 + QBLK - 1) >> 6;
        const char* Kb = (const char*)(Kt + tokbase * DM + h * HD); const char* Vb = (const char*)(Vt + tokbase * DM + h * HD);
        bf16x8 qr[8];
#pragma unroll
        for (int d0 = 0; d0 < 8; ++d0) qr[d0] = *(const bf16x8*)(Q + (tokbase + qrow) * DM + h * HD + d0 * 16 + hi * 8);
        float carry = 1.f; int done_w = 0; f32x16 o[4] = {};
#define B_DMA(t_, SLOT) do { const size_t tb_ = (size_t)(t_) * KVBLK * DM * 2; _Pragma("unroll") for (int i = 0; i < 2; ++i) { \
            __builtin_amdgcn_global_load_lds((const unsigned*)(Kb + tb_ + offK[i]), (LAS unsigned*)(K_lds + (SLOT) * SHM_K + ldsw + i * 8192), 16, 0, 0); \
            __builtin_amdgcn_global_load_lds((const unsigned*)(Vb + tb_ + offV[i]), (LAS unsigned*)(V_lds + (SLOT) * SHM_V + ldsw + i * 8192), 16, 0, 0); } } while (0)
        asm volatile("s_waitcnt vmcnt(0)" ::: "memory");
        B_DMA(t_hi, 0); B_DMA(t_hi - 1, 1);
        asm volatile("s_waitcnt vmcnt(4)" ::: "memory");
        __builtin_amdgcn_s_barrier(); asm volatile("" ::: "memory");
        bool stop = false;
#define B_STEP(itn, SLOT, SLOTW) do { const int t = t_hi - (itn); const bool more = t > 0, more2 = t > 1;              \
        if (more2) B_DMA(t - 2, SLOTW);                                                                             \
        if (t <= t_w && !done_w) { f32x16 p0, p1, l0v, l1v; bf16x8 pa0, pa1, pa2, pa3;                               \
            qkt<SLOT>(p0, p1, K_lds, r32, hi, qr);                                                                  \
            const int dq = qrow - t * KVBLK - 4 * hi;                                                               \
              \
            _Pragma("unroll") for (int r = 0; r < 16; ++r) { const int cr = (r & 3) + 8 * (r >> 2);                 \
                const float e0 = __builtin_amdgcn_exp2f(-fmaxf(p0[r] * C2, -100.f)), e1 = __builtin_amdgcn_exp2f(-fmaxf(p1[r] * C2, -100.f)); \
                const float g0 = __builtin_amdgcn_rcpf(1.0f + e0), g1 = __builtin_amdgcn_rcpf(1.0f + e1);         \
                const bool v0 = cr < dq, v1 = cr + 32 < dq;                                                         \
                p0[r] = v0 ? g0 : 0.f; p1[r] = v1 ? g1 : 0.f;                                                       \
                l0v[r] = v0 ? e0 * g0 : 1.f; l1v[r] = v1 ? e1 * g1 : 1.f; }                                         \
            float gs[8];                                                                                            \
            _Pragma("unroll") for (int g = 0; g < 4; ++g) { gs[g] = (l0v[4 * g] * l0v[4 * g + 1]) * (l0v[4 * g + 2] * l0v[4 * g + 3]); \
                                                            gs[4 + g] = (l1v[4 * g] * l1v[4 * g + 1]) * (l1v[4 * g + 2] * l1v[4 * g + 3]); } \
            float acc = carry;                                                                                      \
            _Pragma("unroll") for (int g = 7; g >= 0; --g) {                                                        \
                auto rr = __builtin_amdgcn_permlane32_swap(__float_as_uint(gs[g]), __float_as_uint(gs[g]), false, false); \
                const float slo = __uint_as_float(rr[0]), shi = __uint_as_float(rr[1]);                             \
                float run = acc * (hi ? 1.f : shi);                                                                 \
                _Pragma("unroll") for (int j = 3; j >= 0; --j) { const int r = 4 * (g & 3) + j;                     \
                    if (g >= 4) { const float a_ = p1[r] * run; run *= l1v[r]; p1[r] = a_; }                        \
                    else        { const float a_ = p0[r] * run; run *= l0v[r]; p0[r] = a_; } }                      \
                acc *= slo * shi; }                                                                                 \
            carry = acc;                                                                                            \
            packP(p0, p1, pa0, pa1, pa2, pa3); SBAR();                                                              \
            pv_tile<SLOT>(o, vb0, pa0, pa1, pa2, pa3);                                                              \
            done_w = __all(carry < 1.0e-37f) ? 1 : 0; }                                                                     \
        if (lane == 0) flags[((itn) & 1) * 8 + wid] = done_w;                                                       \
        if (more2) asm volatile("s_waitcnt vmcnt(4)" ::: "memory"); else asm volatile("s_waitcnt vmcnt(0)" ::: "memory");     \
        LDS_WAIT(); __builtin_amdgcn_s_barrier(); asm volatile("" ::: "memory");                                    \
        { int alld = 1; _Pragma("unroll") for (int w = 0; w < 8; ++w) alld &= flags[((itn) & 1) * 8 + w]; stop = (alld != 0) || !more; } } while (0)
        for (int itn = 0;; itn += 3) { B_STEP(itn, 0, 2); if (stop) break; B_STEP(itn + 1, 1, 0); if (stop) break; B_STEP(itn + 2, 2, 1); if (stop) break; }
#undef B_STEP
#undef B_DMA
        asm volatile("s_waitcnt vmcnt(0)" ::: "memory");
        float rli[16];
#pragma unroll
        for (int r = 0; r < 16; ++r) rli[r] = 1.0f;
        store_o(o, rli, O + (tokbase + qw0) * DM + h * HD, r32, hi);
        __syncthreads();
    }
}
#undef PK4
}

DI void route16(const float (&lg)[16], const float (&bias)[16], int& e0, int& e1, float& w0, float& w1) {
    float mx = lg[0];
#pragma unroll
    for (int i = 1; i < 16; ++i) mx = fmaxf(mx, lg[i]);
    float pr[16], sum = 0.f;
#pragma unroll
    for (int i = 0; i < 16; ++i) { pr[i] = __builtin_amdgcn_exp2f((lg[i] - mx) * 1.4426950408889634f); sum += pr[i]; }
    float sel[16];
#pragma unroll
    for (int i = 0; i < 16; ++i) { pr[i] = pr[i] / sum; sel[i] = pr[i] + bias[i]; }
    float gsc[4];
#pragma unroll
    for (int g = 0; g < 4; ++g) { const float a = sel[4 * g], b = sel[4 * g + 1], c = sel[4 * g + 2], d = sel[4 * g + 3];
        gsc[g] = fmaxf(fmaxf(fmaxf(a + b, a + c), fmaxf(a + d, b + c)), fmaxf(b + d, c + d)); }
    int g = 0; float best = gsc[0];
#pragma unroll
    for (int i = 1; i < 4; ++i) if (gsc[i] > best) { best = gsc[i]; g = i; }
    float xs[4], ps[4];
#pragma unroll
    for (int j = 0; j < 4; ++j) { xs[j] = (g == 0) ? sel[j] : (g == 1) ? sel[4 + j] : (g == 2) ? sel[8 + j] : sel[12 + j];
                                  ps[j] = (g == 0) ? pr[j] : (g == 1) ? pr[4 + j] : (g == 2) ? pr[8 + j] : pr[12 + j]; }
    int i1 = 0; float b1 = xs[0];
#pragma unroll
    for (int j = 1; j < 4; ++j) if (xs[j] > b1) { b1 = xs[j]; i1 = j; }
    int i2 = -1; float b2 = -__builtin_inff();
#pragma unroll
    for (int j = 0; j < 4; ++j) if (j != i1 && (i2 < 0 || xs[j] > b2)) { b2 = xs[j]; i2 = j; }
    const float p1 = (i1 == 0) ? ps[0] : (i1 == 1) ? ps[1] : (i1 == 2) ? ps[2] : ps[3];
    const float p2 = (i2 == 0) ? ps[0] : (i2 == 1) ? ps[1] : (i2 == 2) ? ps[2] : ps[3];
    const float s = p1 + p2;
    e0 = 4 * g + i1; e1 = 4 * g + i2; w0 = p1 / s; w1 = p2 / s;
}

DI f32x4 bf4(u32x2 a) { f32x4 r; r[0] = __uint_as_float(a.x << 16); r[1] = __uint_as_float(a.x & 0xFFFF0000u); r[2] = __uint_as_float(a.y << 16); r[3] = __uint_as_float(a.y & 0xFFFF0000u); return r; }
struct LnRow { f32x4 hp[4]; u32x2 hb[4], ya[4], yb[4]; };
template <bool HPF, int NADD>
DI void ln_load(LnRow& R, size_t row, int lane, const void* hprev, const bf16_t* y0, const bf16_t* y1) {
#pragma unroll
    for (int i = 0; i < 4; ++i) { const size_t off = row * DM + 4 * lane + 256 * i;
        if (HPF) R.hp[i] = *(const f32x4*)((const float*)hprev + off); else R.hb[i] = *(const u32x2*)((const bf16_t*)hprev + off);
        R.ya[i] = *(const u32x2*)(y0 + off);
        if (NADD == 2) R.yb[i] = *(const u32x2*)(y1 + off); }
}
template <bool HPF, int NADD, bool OUTF>
DI float ln_row(LnRow& R, f32x4 (&v)[4], size_t row, int lane, const f32x4 (&g4)[4], const f32x4 (&b4)[4], void* out, signed char* out8, float* sc8) {
#pragma unroll
    for (int i = 0; i < 4; ++i) { f32x4 ad = bf4(R.ya[i]); if (NADD == 2) ad = ad + bf4(R.yb[i]);
        const f32x4 hp = HPF ? R.hp[i] : bf4(R.hb[i]);
        v[i] = hp * DN_ALPHA + ad; }
    float s = 0.f;
#pragma unroll
    for (int i = 0; i < 4; ++i) s += (v[i][0] + v[i][1]) + (v[i][2] + v[i][3]);
    const float mean = wave_sum(s) * (1.0f / DM);
    float q = 0.f;
#pragma unroll
    for (int i = 0; i < 4; ++i) { v[i] = v[i] - mean; q += (v[i][0] * v[i][0] + v[i][1] * v[i][1]) + (v[i][2] * v[i][2] + v[i][3] * v[i][3]); }
    const float rstd = __builtin_amdgcn_rsqf(wave_sum(q) * (1.0f / DM) + LN_EPS);
#pragma unroll
    for (int i = 0; i < 4; ++i) { v[i] = v[i] * rstd * g4[i] + b4[i]; const size_t off = row * DM + 4 * lane + 256 * i;
        if (OUTF) *(f32x4*)((float*)out + off) = v[i];
        else { u32x2 w; w.x = cvt_pk_bf16(v[i][0], v[i][1]); w.y = cvt_pk_bf16(v[i][2], v[i][3]); *(u32x2*)((bf16_t*)out + off) = w; } }
    return out8 ? quant_row(v, lane, out8 + row * DM, sc8 + row) : 0.f;
}
DI float tr_reduce16(float (&pe)[16], int lane) {
    float r8[8], r4[4], r2[2], r1;
#pragma unroll
    for (int k = 0; k < 8; ++k) { const bool od = lane & 1; const float keep = od ? pe[2 * k + 1] : pe[2 * k], send = od ? pe[2 * k] : pe[2 * k + 1]; r8[k] = keep + __shfl_xor(send, 1); }
#pragma unroll
    for (int k = 0; k < 4; ++k) { const bool od = lane & 2; const float keep = od ? r8[2 * k + 1] : r8[2 * k], send = od ? r8[2 * k] : r8[2 * k + 1]; r4[k] = keep + __shfl_xor(send, 2); }
#pragma unroll
    for (int k = 0; k < 2; ++k) { const bool od = lane & 4; const float keep = od ? r4[2 * k + 1] : r4[2 * k], send = od ? r4[2 * k] : r4[2 * k + 1]; r2[k] = keep + __shfl_xor(send, 4); }
    { const bool od = lane & 8; const float keep = od ? r2[1] : r2[0], send = od ? r2[0] : r2[1]; r1 = keep + __shfl_xor(send, 8); }
    r1 += __shfl_xor(r1, 16); r1 += __shfl_xor(r1, 32);
    return r1;
}
DI void router_rows2(const f32x4 (&va)[4], const f32x4 (&vb)[4], const LAS float* wrT, int lane, float& la, float& lb) {
    float pa[16], pb[16];
#pragma unroll
    for (int e = 0; e < 16; ++e) { float a = 0.f, b = 0.f;
#pragma unroll
        for (int i = 0; i < 4; ++i) { const f32x4 w = *(const LAS f32x4*)(wrT + e * DM + 4 * lane + 256 * i);
            a += (va[i][0] * w[0] + va[i][1] * w[1]) + (va[i][2] * w[2] + va[i][3] * w[3]);
            b += (vb[i][0] * w[0] + vb[i][1] * w[1]) + (vb[i][2] * w[2] + vb[i][3] * w[3]); }
        pa[e] = a; pb[e] = b; }
    la = tr_reduce16(pa, lane); lb = tr_reduce16(pb, lane);
}
template <bool HPF, int NADD, bool OUTF, bool ROUTER>
DI void ln_phase(const Frame& F, const void* hprev, const bf16_t* y0, const bf16_t* y1, const float* gam, const float* bet, void* out,
                 const float* router_w, const float* router_b, unsigned* cnt, int* list, float* gatew, signed char* out8 = nullptr, float* sc8 = nullptr, float* lscale = nullptr) {
    LAS float* wrT = (LAS float*)F.lds;
    LAS float* lsc = (LAS float*)(F.lds + 16 * DM * 4) + F.wave * 272;
    float rb[16];
    if (ROUTER) {
        { f32x4 rw[8];
#pragma unroll
          for (int i = 0; i < 8; ++i) rw[i] = *(const f32x4*)(router_w + (size_t)(F.tid + 512 * i) * 4);
#pragma unroll
          for (int i = 0; i < 8; ++i) { const int q = F.tid + 512 * i, c = q >> 2, e4 = (q & 3) * 4;
#pragma unroll
              for (int j = 0; j < 4; ++j) wrT[(e4 + j) * DM + c] = rw[i][j]; } }
#pragma unroll
        for (int e = 0; e < 16; ++e) rb[e] = router_b[e];
        __syncthreads();
    }
    const int lane = F.lane;
    f32x4 g4[4], b4[4];
#pragma unroll
    for (int i = 0; i < 4; ++i) { g4[i] = *(const f32x4*)(gam + 4 * lane + 256 * i); b4[i] = *(const f32x4*)(bet + 4 * lane + 256 * i); }
    for (int c0 = F.bid * 8; c0 < NTOK / 16; c0 += F.G * 8) {
        const int chunk = c0 + F.wave; const bool cvalid = chunk < NTOK / 16;
        const size_t row0 = (size_t)(cvalid ? chunk : 0) * 16;
        float my_sc = 0.f;
        if (cvalid) {
            LnRow RA, RB; f32x4 va[4], vb[4];
            ln_load<HPF, NADD>(RA, row0, lane, hprev, y0, y1);
#pragma unroll 1
            for (int ri = 0; ri < 16; ri += 2) {
                ln_load<HPF, NADD>(RB, row0 + ri + 1, lane, hprev, y0, y1);
                { const float rs_ = ln_row<HPF, NADD, OUTF>(RA, va, row0 + ri, lane, g4, b4, out, out8, sc8); my_sc = (lane == ri) ? rs_ : my_sc; }
                if (ri + 2 < 16) ln_load<HPF, NADD>(RA, row0 + ri + 2, lane, hprev, y0, y1);
                { const float rs_ = ln_row<HPF, NADD, OUTF>(RB, vb, row0 + ri + 1, lane, g4, b4, out, out8, sc8); my_sc = (lane == ri + 1) ? rs_ : my_sc; }
                if (ROUTER) { float la, lb; router_rows2(va, vb, wrT, lane, la, lb); if (lane < 16) { lsc[ri * 17 + lane] = la; lsc[(ri + 1) * 17 + lane] = lb; } }
            }
        }
        if (ROUTER) {
            LDS_WAIT();
            float lg[16];
#pragma unroll
            for (int e = 0; e < 16; ++e) lg[e] = lsc[(lane & 15) * 17 + e];
            LDS_WAIT();
            int my_e0, my_e1; float my_w0, my_w1; route16(lg, rb, my_e0, my_e1, my_w0, my_w1);
            const size_t row = row0 + lane; const bool act = lane < 16 && cvalid;
            const u64 ltmask = (1ull << lane) - 1ull;
            LAS unsigned* wcnt = (LAS unsigned*)(F.lds + 16 * DM * 4 + 8 * 272 * 4);
            LAS unsigned* wbase = wcnt + 128;
            unsigned mycnt = 0;
#pragma unroll
            for (int e = 0; e < NEXP; ++e) { const unsigned n = popc64(__ballot(act && my_e0 == e)) + popc64(__ballot(act && my_e1 == e)); mycnt = (lane == e) ? n : mycnt; }
            if (lane < 16) wcnt[F.wave * 16 + lane] = mycnt;
            __syncthreads();
            if (F.wave == 0 && lane < 16) { unsigned tot = 0, pre[8];
#pragma unroll
                for (int w = 0; w < 8; ++w) { pre[w] = tot; tot += wcnt[w * 16 + lane]; }
                const unsigned base = tot ? atomicAdd(cnt + 64 * lane, tot) : 0u;
#pragma unroll
                for (int w = 0; w < 8; ++w) wbase[w * 16 + lane] = base + pre[w]; }
            __syncthreads();
#pragma unroll 1
            for (int e = 0; e < NEXP; ++e) {
                const u64 m0 = __ballot(act && my_e0 == e), m1 = __ballot(act && my_e1 == e);
                const unsigned n0 = popc64(m0);
                if (m0 | m1) { const unsigned base = wbase[F.wave * 16 + e];
                    if (act && my_e0 == e) { const size_t p = (size_t)e * LISTCAP + base + popc64(m0 & ltmask); list[p] = (int)(row * 2); gatew[p] = my_w0; lscale[p] = my_sc; }
                    if (act && my_e1 == e) { const size_t p = (size_t)e * LISTCAP + base + n0 + popc64(m1 & ltmask); list[p] = (int)(row * 2 + 1); gatew[p] = my_w1; lscale[p] = my_sc; } }
            }
            __syncthreads();
        }
    }
    if (ROUTER) __syncthreads();
}

DI void unpk8(u32x4 w, float (&f)[8]) {
#pragma unroll
    for (int d = 0; d < 4; ++d) { f[2 * d] = __uint_as_float(w[d] << 16); f[2 * d + 1] = __uint_as_float(w[d] & 0xFFFF0000u); } }
DI u32x4 pk8(const float (&f)[8]) { u32x4 w; w.x = cvt_pk_bf16(f[0], f[1]); w.y = cvt_pk_bf16(f[2], f[3]); w.z = cvt_pk_bf16(f[4], f[5]); w.w = cvt_pk_bf16(f[6], f[7]); return w; }
template <bool HPF>
DI void ln_router_phase(const Frame& F, const void* hprev, const bf16_t* y0, const float* gam, const float* bet, bf16_t* out,
                        const float* router_w, const float* router_b, unsigned* cnt, int* list, float* gatew, signed char* out8, float* sc8, float* lscale) {
    constexpr int WSTR = 2064;
    LAS char* Whi = (LAS char*)F.lds; LAS char* Wlo = Whi + 16 * WSTR;
    LAS float* gL = (LAS float*)(F.lds + 2 * 16 * WSTR); LAS float* bL = gL + DM;
    LAS float* lsc = bL + DM + F.wave * 272;
    LAS unsigned* wcnt = (LAS unsigned*)(bL + DM + 8 * 272); LAS unsigned* wbase = wcnt + 128;
    LAS float* rbL = (LAS float*)(wbase + 128);
    { f32x4 rw[8];
#pragma unroll
      for (int i = 0; i < 8; ++i) rw[i] = *(const f32x4*)(router_w + (size_t)(F.tid + 512 * i) * 4);
#pragma unroll
      for (int i = 0; i < 8; ++i) { const int q = F.tid + 512 * i, c = q >> 2, e4 = (q & 3) * 4;
#pragma unroll
          for (int j = 0; j < 4; ++j) { const float w = rw[i][j]; const unsigned hb = cvt_pk_bf16(w, 0.f) & 0xFFFFu; const unsigned lb = cvt_pk_bf16(w - __uint_as_float(hb << 16), 0.f) & 0xFFFFu;
              *(LAS unsigned short*)(Whi + (e4 + j) * WSTR + c * 2) = (unsigned short)hb; *(LAS unsigned short*)(Wlo + (e4 + j) * WSTR + c * 2) = (unsigned short)lb; } }
      gL[F.tid] = gam[F.tid]; gL[F.tid + 512] = gam[F.tid + 512]; bL[F.tid] = bet[F.tid]; bL[F.tid + 512] = bet[F.tid + 512];
      if (F.tid < 16) rbL[F.tid] = router_b[F.tid];
      __syncthreads(); }
    for (int c0 = F.bid * 8; c0 < NTOK / 16; c0 += F.G * 8) {
        int lane = F.lane; asm volatile("" : "+v"(lane));
        const int r = lane & 15, kq = lane >> 4;
        const int chunk = c0 + F.wave; const bool cvalid = chunk < NTOK / 16;
        const size_t row0 = (size_t)(cvalid ? chunk : 0) * 16;
        float my_sc = 0.f;
        if (cvalid) {
            const size_t rbase = (row0 + r) * DM + 8 * kq;
            u32x4 P[16][2];
            float s1 = 0.f, s2 = 0.f;
            constexpr int NPRE = HPF ? 3 : 4;
            f32x4 Rx[NPRE][2][2]; u32x4 Rb[NPRE][2], Ry[NPRE][2];
            const float* xpf = (const float*)hprev + rbase; const bf16_t* xpb = (const bf16_t*)hprev + rbase; const bf16_t* ypb = y0 + rbase; bf16_t* opb = out + rbase;
#define LNT_LOAD(sl, c) do { _Pragma("unroll") for (int g = 0; g < 2; ++g) { \
                if (HPF) { Rx[sl][g][0] = *(const f32x4*)(xpf + (64 * (c) + 32 * g)); Rx[sl][g][1] = *(const f32x4*)(xpf + (64 * (c) + 32 * g + 4)); } \
                else Rb[sl][g] = *(const u32x4*)(xpb + (64 * (c) + 32 * g)); \
                Ry[sl][g] = *(const u32x4*)(ypb + (64 * (c) + 32 * g)); } } while (0)
#pragma unroll
            for (int c = 0; c < NPRE; ++c) LNT_LOAD(c, c);
#pragma unroll
            for (int c = 0; c < 16; ++c) { constexpr int dummy = 0; (void)dummy; const int sl = c % NPRE;
#pragma unroll
                for (int g = 0; g < 2; ++g) { float h[8], ya[8]; unpk8(Ry[sl][g], ya);
                    if (HPF) {
#pragma unroll
                        for (int j = 0; j < 8; ++j) h[j] = Rx[sl][g][j >> 2][j & 3] * DN_ALPHA + ya[j];
                    } else { float xb[8]; unpk8(Rb[sl][g], xb);
#pragma unroll
                        for (int j = 0; j < 8; ++j) h[j] = xb[j] * DN_ALPHA + ya[j]; }
#pragma unroll
                    for (int j = 0; j < 8; ++j) { s1 += h[j]; s2 += h[j] * h[j]; }
                    P[c][g] = pk8(h); }
                if (c + NPRE < 16) LNT_LOAD(sl, c + NPRE);
                __builtin_amdgcn_sched_barrier(0); }
#undef LNT_LOAD
            s1 += __shfl_xor(s1, 16); s1 += __shfl_xor(s1, 32); s2 += __shfl_xor(s2, 16); s2 += __shfl_xor(s2, 32);
            const float mean = s1 * (1.0f / DM), var = fmaxf(s2 * (1.0f / DM) - mean * mean, 0.f), rstd = __builtin_amdgcn_rsqf(var + LN_EPS), nb = -mean * rstd;
            f32x4 D0 = {0.f, 0.f, 0.f, 0.f}, D1 = D0, D2 = D0; float amax = 0.f;
            unsigned gLo = (unsigned)(size_t)(gL + 8 * kq), bLo = (unsigned)(size_t)(bL + 8 * kq), whO = (unsigned)(size_t)(Whi + r * WSTR + 16 * kq), wlO = (unsigned)(size_t)(Wlo + r * WSTR + 16 * kq);
            asm volatile("" : "+v"(gLo), "+v"(bLo), "+v"(whO), "+v"(wlO));
#pragma unroll
            for (int c = 0; c < 16; ++c)
#pragma unroll
                for (int g = 0; g < 2; ++g) { const int cc = 64 * c + 32 * g; float h[8], y[8], yr[8];
                    unpk8(P[c][g], h);
                    const f32x4 ga = *(const LAS f32x4*)(gLo + cc * 4), gb = *(const LAS f32x4*)(gLo + cc * 4 + 16), ba = *(const LAS f32x4*)(bLo + cc * 4), bb = *(const LAS f32x4*)(bLo + cc * 4 + 16);
#pragma unroll
                    for (int j = 0; j < 8; ++j) { y[j] = (h[j] * rstd + nb) * (j < 4 ? ga[j & 3] : gb[j & 3]) + (j < 4 ? ba[j & 3] : bb[j & 3]); amax = fmaxf(amax, fabsf(y[j])); }
                    const u32x4 yp = pk8(y); P[c][g] = yp;
                    *(u32x4*)(opb + (64 * c + 32 * g)) = yp;
                    unpk8(yp, yr);
#pragma unroll
                    for (int j = 0; j < 8; ++j) yr[j] = y[j] - yr[j];
                    const u32x4 lp = pk8(yr);
                    const bf16x8 wh = *(const LAS bf16x8*)(whO + cc * 2), wl = *(const LAS bf16x8*)(wlO + cc * 2);
                    D0 = __builtin_amdgcn_mfma_f32_16x16x32_bf16(wh, __builtin_bit_cast(bf16x8, yp), D0, 0, 0, 0);
                    D1 = __builtin_amdgcn_mfma_f32_16x16x32_bf16(wl, __builtin_bit_cast(bf16x8, yp), D1, 0, 0, 0);
                    D2 = __builtin_amdgcn_mfma_f32_16x16x32_bf16(wh, __builtin_bit_cast(bf16x8, lp), D2, 0, 0, 0);
                    __builtin_amdgcn_sched_barrier(0); }
            amax = fmaxf(amax, __shfl_xor(amax, 16)); amax = fmaxf(amax, __shfl_xor(amax, 32));
            const float inv = amax > 0.f ? 127.0f / amax : 0.f; my_sc = amax * (1.0f / 127.0f);
            if (kq == 0) sc8[row0 + r] = my_sc;
            { const f32x4 Ds = D0 + (D1 + D2);
#pragma unroll
              for (int v = 0; v < 4; ++v) lsc[r * 17 + 4 * kq + v] = Ds[v]; }
            signed char* o8 = out8 + (row0 + r) * DM + ((kq & 1) ? 32 + 8 * (kq - 1) : 8 * kq);
#pragma unroll
            for (int c = 0; c < 16; ++c) { u32x2 pc[2];
#pragma unroll
                for (int g = 0; g < 2; ++g) { float y[8]; u32x4 pw = P[c][g]; asm volatile("" : "+v"(pw)); unpk8(pw, y); int q[8];
#pragma unroll
                    for (int j = 0; j < 8; ++j) q[j] = (int)__builtin_rintf(y[j] * inv);
                    pc[g].x = (unsigned)((q[0] & 0xFF) | ((q[1] & 0xFF) << 8) | ((q[2] & 0xFF) << 16) | (q[3] << 24)); pc[g].y = (unsigned)((q[4] & 0xFF) | ((q[5] & 0xFF) << 8) | ((q[6] & 0xFF) << 16) | (q[7] << 24)); }
                const bool od = kq & 1; const u32x2 snd = od ? pc[0] : pc[1]; u32x2 rcv;
                rcv.x = (unsigned)__shfl_xor((int)snd.x, 16); rcv.y = (unsigned)__shfl_xor((int)snd.y, 16);
                u32x4 w; if (od) { w.x = rcv.x; w.y = rcv.y; w.z = pc[1].x; w.w = pc[1].y; } else { w.x = pc[0].x; w.y = pc[0].y; w.z = rcv.x; w.w = rcv.y; }
                *(u32x4*)(o8 + 64 * c) = w;
                __builtin_amdgcn_sched_barrier(0); }
        }
        {
            LDS_WAIT();
            float lg[16], rb[16];
#pragma unroll
            for (int e = 0; e < 16; ++e) { lg[e] = lsc[(lane & 15) * 17 + e]; rb[e] = rbL[e]; }
            LDS_WAIT();
            int my_e0, my_e1; float my_w0, my_w1; route16(lg, rb, my_e0, my_e1, my_w0, my_w1);
            const size_t row = row0 + lane; const bool act = lane < 16 && cvalid;
            const u64 ltmask = (1ull << lane) - 1ull;
            unsigned mycnt = 0;
#pragma unroll
            for (int e = 0; e < NEXP; ++e) { const unsigned n = popc64(__ballot(act && my_e0 == e)) + popc64(__ballot(act && my_e1 == e)); mycnt = (lane == e) ? n : mycnt; }
            if (lane < 16) wcnt[F.wave * 16 + lane] = mycnt;
            __syncthreads();
            if (F.wave == 0 && lane < 16) { unsigned tot = 0, pre[8];
#pragma unroll
                for (int w = 0; w < 8; ++w) { pre[w] = tot; tot += wcnt[w * 16 + lane]; }
                const unsigned base = tot ? atomicAdd(cnt + 64 * lane, tot) : 0u;
#pragma unroll
                for (int w = 0; w < 8; ++w) wbase[w * 16 + lane] = base + pre[w]; }
            __syncthreads();
#pragma unroll 1
            for (int e = 0; e < NEXP; ++e) {
                const u64 m0 = __ballot(act && my_e0 == e), m1 = __ballot(act && my_e1 == e);
                const unsigned n0 = popc64(m0);
                if (m0 | m1) { const unsigned base = wbase[F.wave * 16 + e];
                    if (act && my_e0 == e) { const size_t p = (size_t)e * LISTCAP + base + popc64(m0 & ltmask); list[p] = (int)(row * 2); gatew[p] = my_w0; lscale[p] = my_sc; }
                    if (act && my_e1 == e) { const size_t p = (size_t)e * LISTCAP + base + n0 + popc64(m1 & ltmask); list[p] = (int)(row * 2 + 1); gatew[p] = my_w1; lscale[p] = my_sc; } }
            }
            __syncthreads();
        }
    }
    __syncthreads();
}

DI void moe_table(const Frame& F, const unsigned* cnt) {
    LAS int* tab = (LAS int*)(F.lds + MISC_OFF + 64);
    if (F.tid < NEXP) tab[17 + F.tid] = (int)__hip_atomic_load(cnt + 64 * F.tid, __ATOMIC_RELAXED, __HIP_MEMORY_SCOPE_AGENT);
    __syncthreads();
    if (F.tid == 0) { int acc = 0;
        for (int e = 0; e < NEXP; ++e) { tab[e] = acc; acc += (tab[17 + e] + 255) >> 8; }
        tab[16] = acc; }
    __syncthreads();
}

__global__ void __launch_bounds__(512, 2) yoco_fwd(Args args) {
    extern __shared__ __attribute__((aligned(16))) unsigned char lds_raw[];
    Frame F;
    F.lds = (LAS unsigned char*)lds_raw; F.tid = threadIdx.x; F.lane = F.tid & 63; F.wave = __builtin_amdgcn_readfirstlane(F.tid >> 6);
    F.G = gridDim.x; F.bid = blockIdx.x; F.ws = args.ws; F.ctl = (unsigned*)(args.ws + WS_CTL);
    volatile LAS unsigned* misc = (volatile LAS unsigned*)(F.lds + MISC_OFF);
    if (F.tid < 4) misc[F.tid] = 0u;
    __syncthreads();
    XcdBarrier bar; bar.bar = F.ctl + CW_BAR; bar.x = 0; bar.st = misc;
    const int lo = args.ph_lo, hi = args.ph_hi;
    if (hi - lo > 1) bar = xcd_barrier_post(F.ctl + CW_BAR, misc);
#define IN(k) (lo <= (k) && (k) < hi)
#define SEAM(k) do { if (IN(k) && IN((k) + 1)) xcd_barrier(bar); } while (0)
    unsigned char* ws = args.ws;
    bf16_t* XB = (bf16_t*)(ws + WS_XB);
    bf16_t* QKV = (bf16_t*)(ws + WS_R1); bf16_t* MIX = (bf16_t*)(ws + WS_R1); bf16_t* OB = (bf16_t*)(ws + WS_HF + 64 * MiB);
    bf16_t* Y = (bf16_t*)(ws + WS_R1); bf16_t* HE = (bf16_t*)(ws + WS_R1 + R1_HE);
    int* LIST = (int*)(ws + WS_MOE); float* GATEW = (float*)(ws + WS_MOE + 2 * MiB); float* LSCALE = (float*)(ws + WS_MOE + 4 * MiB);
    const float* ln_g = args.in[11]; const float* ln_b = args.in[12];
    LAS int* tab = (LAS int*)(F.lds + MISC_OFF + 64);

    if (IN(0)) { p0_prologue(F, args); } SEAM(0);
    if (IN(1)) {
        pg8::SchedDense S; S.init((const bf16_t*)(ws + WS_XB8), (const bf16_t*)(ws + WS_WAIN), NTOK, NIN, DM / 2, F.G, F.bid);
        S.sA = (const float*)(ws + WS_SCL + SCL_SA); S.sB = (const float*)(ws + WS_SCL + SCL_SBIN);
        pg8::EpiInProj E{QKV, (bf16_t*)(ws + WS_HF + HF_QI), (bf16_t*)(ws + WS_HF + HF_KI), (float*)(ws + WS_HF + HF_WI)};
        pg8::gemm_phase<pg8::EpiInProj, pg8::SchedDense, true>(F.lds, S, E);
        { int rank, n; idle_rank((NTOK / 256) * (NIN / 256), F.G, F.bid, rank, n); if (rank >= 0) bg_jobs(F, args, BG_H0, BG_H1, BG_G0, BG_G1, rank, n); }
    } SEAM(1);
    if (IN(2)) { indexer_phase(F); } SEAM(2);
    if (IN(3)) { att::attnA_phase(F); } SEAM(3);
    if (IN(4)) {
        pg8::SchedDense S; S.init(OB, (const bf16_t*)(ws + WS_WAOUT), NTOK, DM, DM, F.G, F.bid);
        pg8::EpiBf16Split E{MIX, DM, DM, 0}; pg8::gemm_phase(F.lds, S, E);
    } SEAM(4);
    if (IN(5)) { ln_router_phase<true>(F, args.in[0], MIX, ln_g, ln_b, XB, args.in[6], args.in[7], F.ctl + CW_CNT, LIST, GATEW, (signed char*)(ws + WS_XB8), (float*)(ws + WS_SCL + SCL_SA), LSCALE); } SEAM(5);
    if (IN(6)) {
        moe_table(F, F.ctl + CW_CNT);
        pg8::SchedMoe S{(const bf16_t*)(ws + WS_XB8), (const bf16_t*)(ws + WS_WGU), DM / 2, 2, (size_t)512 * DM, tab, LIST, 1, F.G, F.bid, (const float*)(ws + WS_SCL + SCL_SA), (const float*)(ws + WS_SCL + SCL_SBGU)}; S.lsc = LSCALE;
        pg8::EpiMoe1 E{HE}; pg8::gemm_phase<pg8::EpiMoe1, pg8::SchedMoe, true>(F.lds, S, E);
        { __syncthreads(); int rank, n; idle_rank(__builtin_amdgcn_readfirstlane(tab[16]) * 2, F.G, F.bid, rank, n); if (rank >= 0) bg_jobs(F, args, BG_H1, BG_H2, BG_G1, BG_G2, rank, n); }
    } SEAM(6);
    if (IN(7)) {
        moe_table(F, F.ctl + CW_CNT);
        pg8::SchedMoe S{HE, (const bf16_t*)(ws + WS_WD), FFE, 4, (size_t)DM * FFE * 2, tab, LIST, 0, F.G, F.bid}; S.gw = GATEW;
        pg8::EpiMoe2 E{Y, (const LAS float*)(F.lds + pg8::STAGE_BYTES), tab}; pg8::gemm_phase(F.lds, S, E);
        { __syncthreads(); int rank, n; idle_rank(__builtin_amdgcn_readfirstlane(tab[16]) * 4, F.G, F.bid, rank, n); if (rank >= 0) bg_jobs(F, args, BG_H2, NHV, BG_G2, NLG, rank, n); }
    } SEAM(7);
    if (IN(8)) { ln_phase<false, 2, false, false>(F, XB, Y, Y + (size_t)NTOK * DM, ln_g + DM, ln_b + DM, XB, nullptr, nullptr, nullptr, nullptr, nullptr, (signed char*)(ws + WS_XB8), (float*)(ws + WS_SCL + SCL_SA)); } SEAM(8);
    if (IN(9)) {
        pg8::SchedDense S; S.init((const bf16_t*)(ws + WS_XB8), (const bf16_t*)(ws + WS_WBQKV), NTOK, 3 * DM, DM / 2, F.G, F.bid);
        S.sA = (const float*)(ws + WS_SCL + SCL_SA); S.sB = (const float*)(ws + WS_SCL + SCL_SBQKV);
        pg8::EpiBf16Split E{QKV, DM, DM, (size_t)NTOK * DM}; pg8::gemm_phase<pg8::EpiBf16Split, pg8::SchedDense, true>(F.lds, S, E);
    } SEAM(9);
    if (IN(10)) { att::attnB_phase(F); } SEAM(10);
    if (IN(11)) {
        pg8::SchedDense S; S.init(OB, (const bf16_t*)(ws + WS_WBOUT), NTOK, DM, DM, F.G, F.bid);
        pg8::EpiBf16Split E{MIX, DM, DM, 0}; pg8::gemm_phase(F.lds, S, E);
    } SEAM(11);
    if (IN(12)) { ln_router_phase<false>(F, XB, MIX, ln_g + 2 * DM, ln_b + 2 * DM, XB, args.in[6], args.in[7], F.ctl + CW_CNT + 2048, LIST, GATEW, (signed char*)(ws + WS_XB8), (float*)(ws + WS_SCL + SCL_SA), LSCALE); } SEAM(12);
    if (IN(13)) {
        moe_table(F, F.ctl + CW_CNT + 2048);
        pg8::SchedMoe S{(const bf16_t*)(ws + WS_XB8), (const bf16_t*)((const signed char*)(ws + WS_WGU) + (size_t)NEXP * 512 * DM), DM / 2, 2, (size_t)512 * DM, tab, LIST, 1, F.G, F.bid, (const float*)(ws + WS_SCL + SCL_SA), (const float*)(ws + WS_SCL + SCL_SBGU) + NEXP * 512}; S.lsc = LSCALE;
        pg8::EpiMoe1 E{HE}; pg8::gemm_phase<pg8::EpiMoe1, pg8::SchedMoe, true>(F.lds, S, E);
    } SEAM(13);
    if (IN(14)) {
        moe_table(F, F.ctl + CW_CNT + 2048);
        pg8::SchedMoe S{HE, (const bf16_t*)(ws + WS_WD) + (size_t)NEXP * DM * FFE, FFE, 4, (size_t)DM * FFE * 2, tab, LIST, 0, F.G, F.bid}; S.gw = GATEW;
        pg8::EpiMoe2 E{Y, (const LAS float*)(F.lds + pg8::STAGE_BYTES), tab}; pg8::gemm_phase(F.lds, S, E);
    } SEAM(14);
    if (IN(15)) { ln_phase<false, 2, true, false>(F, XB, Y, Y + (size_t)NTOK * DM, ln_g + 3 * DM, ln_b + 3 * DM, args.out, nullptr, nullptr, nullptr, nullptr, nullptr); }
#undef IN
#undef SEAM
}


extern "C" void kernel_launch(void* const* d_in, const int* in_sizes, int n_in, void* d_out, int out_size, void* d_ws, size_t ws_size, hipStream_t stream) {
    static int grid = 0;
    if (grid == 0) {
        if (n_in != 13 || in_sizes[0] != NTOK * DM || out_size != NTOK * DM || ws_size < WS_END) {
            fprintf(stderr, "kernel_launch: unexpected shapes (n_in %d, in0 %d, out %d, ws %zu < %zu)\n", n_in, n_in > 0 ? in_sizes[0] : -1, out_size, ws_size, (size_t)WS_END); grid = -1; return; }
        int dev = 0, cus = 0, per_cu = 0;
        if (hipGetDevice(&dev) != hipSuccess || hipDeviceGetAttribute(&cus, hipDeviceAttributeMultiprocessorCount, dev) != hipSuccess) { grid = -1; return; }
        if (hipFuncSetAttribute((const void*)yoco_fwd, hipFuncAttributeMaxDynamicSharedMemorySize, LDS_BYTES) != hipSuccess) { fprintf(stderr, "kernel_launch: hipFuncSetAttribute failed\n"); grid = -1; return; }
        if (hipOccupancyMaxActiveBlocksPerMultiprocessor(&per_cu, (const void*)yoco_fwd, 512, LDS_BYTES) != hipSuccess || per_cu < 1)
            fprintf(stderr, "kernel_launch: occupancy query reports %d\n", per_cu);
        (void)hipGetLastError();
        grid = cus;
    }
    if (grid < 0) return;
    (void)hipMemsetAsync((char*)d_ws + WS_CTL, 0, CTL_BYTES, stream);
    Args a; memset(&a, 0, sizeof(a));
    for (int i = 0; i < 13; ++i) a.in[i] = (const float*)d_in[i];
    a.out = (float*)d_out; a.ws = (unsigned char*)d_ws;
#if MK_N_LAUNCHES == 1
    a.ph_lo = 0; a.ph_hi = NPH;
    hipLaunchKernelGGL(yoco_fwd, dim3(grid), dim3(512), LDS_BYTES, stream, a);
#else
    for (int p = 0; p < NPH; ++p) { a.ph_lo = p; a.ph_hi = p + 1; hipLaunchKernelGGL(yoco_fwd, dim3(grid), dim3(512), LDS_BYTES, stream, a);
#ifdef REPMASK
        if ((REPMASK >> p) & 1) hipLaunchKernelGGL(yoco_fwd, dim3(grid), dim3(512), LDS_BYTES, stream, a);
#endif
    }
#endif
}
```
